# Optimizing an MI355X kernel written in HIP

```python
import jax
import jax.numpy as jnp
from jax import lax
import numpy as np


D_MODEL = 1024
BATCH = 8
SEQ = 2048
DEPTH = 4

GRID_W = 64
CTX_LEN = 256

A_HEADS = 4
A_DQK = 128
A_DV = 256
A_QK = A_HEADS * A_DQK
A_V = A_HEADS * A_DV
A_CHUNK = 64
A_CONV = 3
ROPE_BASE = 10000.0

B_HEADS = 16
B_DH = 64
B_W = B_HEADS * B_DH
NA_ROWS = 8
NA_COLS = 16
NA_QBR = 2
NA_QBC = 32

D_FF = 2816
N_EXPERTS = 8
TOP_K = 2
D_FF_EXPERT = 3584

EPS = 1e-6

IN_SPLITS = (A_QK, A_QK, A_V, A_V, 4 * A_HEADS, B_W, B_W, B_W, D_MODEL, D_MODEL)
D_IN = sum(IN_SPLITS)

kernel_name = 'hybrid_mlstm_natten_moe_dit'


def rms_norm(x, g):
    x32 = x.astype(jnp.float32)
    y = x32 * lax.rsqrt(jnp.mean(x32 * x32, axis=-1, keepdims=True) + EPS)
    return (y * g.astype(jnp.float32)).astype(x.dtype)


def split_cols(p):
    idx = np.cumsum(IN_SPLITS)[:-1].tolist()
    return jnp.split(p, idx, axis=-1)


def centred_dwconv(u, w):
    kw = w.shape[0]
    return lax.conv_general_dilated(u, w[:, None, :].astype(u.dtype), window_strides=(1,),
                                    padding=[(kw // 2, kw - 1 - kw // 2)],
                                    dimension_numbers=('NWC', 'WIO', 'NWC'),
                                    feature_group_count=u.shape[-1])


def axial_rope(x):
    t, d = x.shape[1], x.shape[-1]
    pos = jnp.arange(t)
    rows = (pos // GRID_W).astype(jnp.float32)
    cols = (pos % GRID_W).astype(jnp.float32)
    quarter = d // 4
    inv = 1.0 / (ROPE_BASE ** (jnp.arange(quarter, dtype=jnp.float32) / quarter))

    def rot(xp, p):
        ang = p[:, None] * inv[None, :]
        cos = jnp.cos(ang)[None, :, None, :]
        sin = jnp.sin(ang)[None, :, None, :]
        x1, x2 = xp[..., :quarter], xp[..., quarter:]
        return jnp.concatenate([x1 * cos - x2 * sin, x1 * sin + x2 * cos], axis=-1)

    xf = x.astype(jnp.float32)
    out = jnp.concatenate([rot(xf[..., :d // 2], rows), rot(xf[..., d // 2:], cols)], axis=-1)
    return out.astype(x.dtype)


def mlstm_chunkwise(q, k, v, log_i, log_f, state):
    b_, h, t, dk = q.shape
    dv = v.shape[-1]
    nc = t // A_CHUNK

    def chunks(a):
        return jnp.moveaxis(a.reshape(b_, h, nc, A_CHUNK, *a.shape[3:]), 2, 0)

    causal = jnp.tril(jnp.ones((A_CHUNK, A_CHUNK), dtype=bool))

    def step(carry, inp):
        c_mat, n_vec, m = carry
        qc, kc, vc, ic, fc = inp
        b = jnp.cumsum(fc, axis=-1)
        d_mat = jnp.where(causal, b[..., :, None] - b[..., None, :] + ic[..., None, :], -jnp.inf)
        inter = b + m[..., None]
        m_row = jnp.maximum(inter, jnp.max(d_mat, axis=-1))
        s = jnp.einsum('bhld,bhsd->bhls', qc, kc) * jnp.exp(d_mat - m_row[..., None])
        w_int = jnp.exp(inter - m_row)
        num = jnp.einsum('bhls,bhsv->bhlv', s, vc) + w_int[..., None] * jnp.einsum('bhvd,bhld->bhlv', c_mat, qc)
        den = jnp.sum(s, axis=-1) + w_int * jnp.einsum('bhd,bhld->bhl', n_vec, qc)
        h_out = num / jnp.maximum(jnp.abs(den), jnp.exp(-m_row))[..., None]
        b_last = b[..., -1]
        g = b_last[..., None] - b + ic
        m_new = jnp.maximum(b_last + m, jnp.max(g, axis=-1))
        w_k = jnp.exp(g - m_new[..., None])
        decay = jnp.exp(b_last + m - m_new)
        c_new = decay[..., None, None] * c_mat + jnp.einsum('bhlv,bhld->bhvd', w_k[..., None] * vc, kc)
        n_new = decay[..., None] * n_vec + jnp.einsum('bhl,bhld->bhd', w_k, kc)
        return (c_new, n_new, m_new), h_out

    state, hs = lax.scan(step, state, (chunks(q), chunks(k), chunks(v), chunks(log_i), chunks(log_f)))
    hs = jnp.moveaxis(hs, 0, 2).reshape(b_, h, t, dv)
    return hs, state


def head_layer_norm(h, g):
    mu = jnp.mean(h, axis=-1, keepdims=True)
    var = jnp.mean(jnp.square(h - mu), axis=-1, keepdims=True)
    y = (h - mu) * lax.rsqrt(var + EPS)
    y = y.transpose(0, 2, 1, 3).reshape(h.shape[0], h.shape[2], -1)
    return y * g.astype(jnp.float32)


def na_latent(q, k, v, k_ctx, v_ctx, rpb):
    b_, t, h, d = q.shape
    rows = t // GRID_W
    wr = min(NA_ROWS, rows)
    wc = NA_COLS
    qbr, qbc = NA_QBR, NA_QBC
    kbr = min(qbr + wr - 1, rows)
    kbc = min(qbc + wc - 1, GRID_W)
    nbr, nbc = rows // qbr, GRID_W // qbc
    nq, nk = qbr * qbc, kbr * kbc
    r = np.arange(rows)
    col = np.arange(GRID_W)
    rs = np.clip(r - wr // 2, 0, rows - wr)
    cs = np.clip(col - wc // 2, 0, GRID_W - wc)
    key_r = np.minimum(rs[::qbr], rows - kbr)[:, None] + np.arange(kbr)
    key_c = np.minimum(cs[::qbc], GRID_W - kbc)[:, None] + np.arange(kbc)
    full = (nbr, nbc, qbr, qbc, kbr, kbc)
    qr = r.reshape(nbr, qbr)[:, None, :, None, None, None]
    qcl = col.reshape(nbc, qbc)[None, :, None, :, None, None]
    kr = key_r[:, None, None, None, :, None]
    kcl = key_c[None, :, None, None, None, :]
    valid = (kr >= rs[qr]) & (kr < rs[qr] + wr) & (kcl >= cs[qcl]) & (kcl < cs[qcl] + wc)
    valid = np.broadcast_to(valid, full).reshape(nbr, nbc, nq, nk)
    dr = np.broadcast_to(np.clip(kr - qr + NA_ROWS - 1, 0, 2 * NA_ROWS - 2), full).reshape(nbr, nbc, nq, nk)
    dc = np.broadcast_to(np.clip(kcl - qcl + NA_COLS - 1, 0, 2 * NA_COLS - 2), full).reshape(nbr, nbc, nq, nk)
    key_idx = (key_r[:, None, :, None] * GRID_W + key_c[None, :, None, :]).reshape(-1)
    bias = jnp.moveaxis(rpb.astype(jnp.float32)[:, dr, dc], 0, 2)
    bias = jnp.where(valid[:, :, None], bias, -jnp.inf)
    qb = q.reshape(b_, nbr, qbr, nbc, qbc, h, d).transpose(0, 1, 3, 2, 4, 5, 6).reshape(b_, nbr, nbc, nq, h, d)
    kg = jnp.take(k, key_idx, axis=1).reshape(b_, nbr, nbc, nk, h, d)
    vg = jnp.take(v, key_idx, axis=1).reshape(b_, nbr, nbc, nk, h, d)
    s_loc = jnp.einsum('bijqhd,bijkhd->bijhqk', qb, kg).astype(jnp.float32) + bias
    s_ctx = jnp.einsum('bijqhd,bchd->bijhqc', qb, k_ctx).astype(jnp.float32)
    p = jax.nn.softmax(jnp.concatenate([s_loc, s_ctx], axis=-1), axis=-1).astype(v.dtype)
    o = (jnp.einsum('bijhqk,bijkhd->bijqhd', p[..., :nk], vg)
         + jnp.einsum('bijhqc,bchd->bijqhd', p[..., nk:], v_ctx))
    o = o.reshape(b_, nbr, nbc, qbr, qbc, h, d).transpose(0, 1, 3, 2, 4, 5, 6)
    return o.reshape(b_, t, h * d)


def ctx_attention(q, k, v):
    s = jnp.einsum('bqhd,bkhd->bhqk', q, k).astype(jnp.float32)
    p = jax.nn.softmax(s, axis=-1).astype(v.dtype)
    o = jnp.einsum('bhqk,bkhd->bqhd', p, v)
    return o.reshape(o.shape[0], o.shape[1], -1)


def mixer(hx, hc, w_in, a_conv, a_gate_b, a_hnorm_g, na_rpb, w_br_a, w_br_b, w_out, ctx_out):
    b_ = hx.shape[0]
    px = split_cols(hx @ w_in)
    pc = split_cols(hc @ w_in)

    def mlstm_inputs(p, rope):
        q_pre, k_pre, v, o_pre, gates = p[0], p[1], p[2], p[3], p[4]
        bb, tt = v.shape[0], v.shape[1]
        qk = jax.nn.silu(centred_dwconv(jnp.concatenate([q_pre, k_pre], axis=-1), a_conv))
        q = qk[..., :A_QK].reshape(bb, tt, A_HEADS, A_DQK)
        k = qk[..., A_QK:].reshape(bb, tt, A_HEADS, A_DQK)
        if rope:
            q, k = axial_rope(q), axial_rope(k)
        q = q.transpose(0, 2, 1, 3).astype(jnp.float32)
        k = k.transpose(0, 2, 1, 3).astype(jnp.float32) * (A_DQK ** -0.5)
        v = v.reshape(bb, tt, A_HEADS, A_DV).transpose(0, 2, 1, 3).astype(jnp.float32)
        g = (gates + a_gate_b).astype(jnp.float32).reshape(bb, tt, 4, A_HEADS).transpose(2, 0, 3, 1)
        fwd = (g[0], jax.nn.log_sigmoid(g[1]))
        bwd = (g[2], jax.nn.log_sigmoid(g[3]))
        return q, k, v, fwd, bwd, o_pre

    def rev(a):
        return jnp.flip(a, axis=2)

    qca, kca, vca, gcf, gcb, oc = mlstm_inputs(pc, False)
    qxa, kxa, vxa, gxf, gxb, ox = mlstm_inputs(px, True)
    zero = (jnp.zeros((b_, A_HEADS, A_DV, A_DQK), jnp.float32),
            jnp.zeros((b_, A_HEADS, A_DQK), jnp.float32),
            jnp.zeros((b_, A_HEADS), jnp.float32))
    hcf, st_cf = mlstm_chunkwise(qca, kca, vca, gcf[0], gcf[1], zero)
    hxf, _ = mlstm_chunkwise(qxa, kxa, vxa, gxf[0], gxf[1], st_cf)
    hcb, st_cb = mlstm_chunkwise(rev(qca), rev(kca), rev(vca), rev(gcb[0]), rev(gcb[1]), zero)
    hxb, _ = mlstm_chunkwise(rev(qxa), rev(kxa), rev(vxa), rev(gxb[0]), rev(gxb[1]), st_cb)
    ha_x = (head_layer_norm(hxf + rev(hxb), a_hnorm_g) * jax.nn.sigmoid(ox.astype(jnp.float32))).astype(hx.dtype)

    def na_heads(a):
        return a.reshape(a.shape[0], a.shape[1], B_HEADS, B_DH)

    qxb, kxb, vxb = na_heads(px[5]) * (B_DH ** -0.5), na_heads(px[6]), na_heads(px[7])
    qcb, kcb, vcb = na_heads(pc[5]) * (B_DH ** -0.5), na_heads(pc[6]), na_heads(pc[7])
    hb_x = na_latent(qxb, kxb, vxb, kcb, vcb, na_rpb)

    def merge(p, ha, hb):
        return (jax.nn.sigmoid(p[8]) * (ha @ w_br_a) + jax.nn.sigmoid(p[9]) * (hb @ w_br_b)) @ w_out

    yx = merge(px, ha_x, hb_x)
    if ctx_out:
        ha_c = (head_layer_norm(hcf + rev(hcb), a_hnorm_g) * jax.nn.sigmoid(oc.astype(jnp.float32))).astype(hc.dtype)
        hb_c = ctx_attention(qcb, kcb, vcb)
        yc = merge(pc, ha_c, hb_c)
    else:
        yc = None
    return yx, yc


def swiglu(h, w1, w3, w2):
    return (jax.nn.silu(h @ w1) * (h @ w3)) @ w2


def moe_swiglu(h, router, w1, w3, w2):
    logits = (h @ router).astype(jnp.float32)
    top_v, top_i = lax.top_k(logits, TOP_K)
    top_w = jax.nn.softmax(top_v, axis=-1)
    gates = jnp.sum(jax.nn.one_hot(top_i, N_EXPERTS, dtype=jnp.float32) * top_w[..., None], axis=-2)
    out = jnp.zeros_like(h)
    for e in range(N_EXPERTS):
        out = out + gates[..., e:e + 1].astype(h.dtype) * swiglu(h, w1[e], w3[e], w2[e])
    return out


def setup_inputs(seed: int = 0) -> dict:
    key = jax.random.key(seed)
    ks = jax.random.split(key, 24)
    f32 = jnp.float32

    def nrm(k, shape, s):
        return jax.random.normal(k, shape, f32) * s

    nl = DEPTH
    nd = (DEPTH + 1) // 2
    nm = DEPTH // 2
    gate_base = jnp.repeat(jnp.array([0.0, 3.0, 0.0, 3.0], f32), A_HEADS)[None, :]
    return {
        'x': nrm(ks[0], (BATCH, SEQ, D_MODEL), 1.0),
        'c': nrm(ks[1], (BATCH, D_MODEL), 1.0),
        'ctx': nrm(ks[2], (BATCH, CTX_LEN, D_MODEL), 1.0),
        'c_ctx': nrm(ks[3], (D_MODEL,), 1.0),
        'w_mod': nrm(ks[4], (nl, D_MODEL, 6 * D_MODEL), 0.5 * D_MODEL ** -0.5),
        'b_mod': nrm(ks[5], (nl, 6 * D_MODEL), 0.02),
        'g_norm1': 1.0 + nrm(ks[6], (nl, D_MODEL), 0.02),
        'g_norm2': 1.0 + nrm(ks[7], (nl, D_MODEL), 0.02),
        'w_in': nrm(ks[8], (nl, D_MODEL, D_IN), D_MODEL ** -0.5),
        'a_conv': nrm(ks[9], (nl, A_CONV, 2 * A_QK), A_CONV ** -0.5),
        'a_gate_b': gate_base + nrm(ks[10], (nl, 4 * A_HEADS), 0.1),
        'a_hnorm_g': 1.0 + nrm(ks[11], (nl, A_V), 0.02),
        'na_rpb': nrm(ks[12], (nl, B_HEADS, 2 * NA_ROWS - 1, 2 * NA_COLS - 1), 0.1),
        'w_br_a': nrm(ks[13], (nl, A_V, D_MODEL), A_V ** -0.5),
        'w_br_b': nrm(ks[14], (nl, B_W, D_MODEL), B_W ** -0.5),
        'w_out': nrm(ks[15], (nl, D_MODEL, D_MODEL), D_MODEL ** -0.5),
        'ffn_w1': nrm(ks[16], (nd, D_MODEL, D_FF), D_MODEL ** -0.5),
        'ffn_w3': nrm(ks[17], (nd, D_MODEL, D_FF), D_MODEL ** -0.5),
        'ffn_w2': nrm(ks[18], (nd, D_FF, D_MODEL), D_FF ** -0.5),
        'moe_router': nrm(ks[19], (nm, D_MODEL, N_EXPERTS), D_MODEL ** -0.5),
        'moe_w1': nrm(ks[20], (nm, N_EXPERTS, D_MODEL, D_FF_EXPERT), D_MODEL ** -0.5),
        'moe_w3': nrm(ks[21], (nm, N_EXPERTS, D_MODEL, D_FF_EXPERT), D_MODEL ** -0.5),
        'moe_w2': nrm(ks[22], (nm, N_EXPERTS, D_FF_EXPERT, D_MODEL), D_FF_EXPERT ** -0.5),
        'g_final': 1.0 + nrm(ks[23], (D_MODEL,), 0.02),
    }


def reference(x, c, ctx, c_ctx, w_mod, b_mod, g_norm1, g_norm2, w_in, a_conv, a_gate_b, a_hnorm_g,
              na_rpb, w_br_a, w_br_b, w_out, ffn_w1, ffn_w3, ffn_w2, moe_router, moe_w1, moe_w3,
              moe_w2, g_final):
    s_lat = jax.nn.silu(c)
    s_ctx = jax.nn.silu(c_ctx)
    xc = ctx
    for l in range(DEPTH):
        last = l == DEPTH - 1
        mod_x = (s_lat @ w_mod[l] + b_mod[l])[:, None, :]
        mod_c = s_ctx @ w_mod[l] + b_mod[l]
        shx1, scx1, gx1, shx2, scx2, gx2 = jnp.split(mod_x, 6, axis=-1)
        shc1, scc1, gc1, shc2, scc2, gc2 = jnp.split(mod_c, 6, axis=-1)

        hx = rms_norm(x, g_norm1[l]) * (1.0 + scx1) + shx1
        hc = rms_norm(xc, g_norm1[l]) * (1.0 + scc1) + shc1
        yx, yc = mixer(hx, hc, w_in[l], a_conv[l], a_gate_b[l], a_hnorm_g[l], na_rpb[l],
                       w_br_a[l], w_br_b[l], w_out[l], not last)
        x = x + gx1 * yx
        if not last:
            xc = xc + gc1 * yc

        if l % 2 == 0:
            j = l // 2

            def ffn(h, j=j):
                return swiglu(h, ffn_w1[j], ffn_w3[j], ffn_w2[j])
        else:
            j = l // 2

            def ffn(h, j=j):
                return moe_swiglu(h, moe_router[j], moe_w1[j], moe_w3[j], moe_w2[j])
        x = x + gx2 * ffn(rms_norm(x, g_norm2[l]) * (1.0 + scx2) + shx2)
        if not last:
            xc = xc + gc2 * ffn(rms_norm(xc, g_norm2[l]) * (1.0 + scc2) + shc2)
    return rms_norm(x, g_final)
```

```cpp
#include <hip/hip_runtime.h>
#include <cstdio>
#include <cstdint>

#ifndef MK_PER_PHASE
#define MK_PER_PHASE 1
#endif

#define LAS __attribute__((address_space(3)))
typedef unsigned short bf16;
typedef short bf16x8 __attribute__((ext_vector_type(8)));
typedef float f32x4 __attribute__((ext_vector_type(4)));
typedef float f32x2 __attribute__((ext_vector_type(2)));
typedef unsigned u32x4 __attribute__((ext_vector_type(4)));
typedef unsigned u32x2 __attribute__((ext_vector_type(2)));

constexpr int D = 1024, NB = 8, TL = 2048, TC = 256, DEPTH = 4;
constexpr int ML = NB * TL, MC = NB * TC, MROWS = ML + MC;
constexpr int DIN = 8208, NP = 8192;
constexpr int PC_Q = 0, PC_K = 512, PC_V = 1024, PC_O = 2048, PC_NQ = 3072, PC_NK = 4096, PC_NV = 5120, PC_GA = 6144, PC_GB = 7168;
constexpr int FF = 2816, FFE = 3584, NE = 8;
constexpr int ECAP = MROWS;
constexpr int MOE_ROWS = 38912;
constexpr float EPS = 1e-6f;

constexpr size_t MiB = 1u << 20;
constexpr size_t WS_CTL = 0, CTL_ZERO_BYTES = 1 * MiB;
constexpr size_t WS_MOD = 1 * MiB;
constexpr size_t WS_RTI = 2 * MiB;
constexpr size_t WS_RTW = 2 * MiB + 512 * 1024;
constexpr size_t WS_GPRE = 3 * MiB;
constexpr size_t WS_XR = 5 * MiB;
constexpr size_t WS_H = 77 * MiB;
constexpr size_t WS_WIN = 113 * MiB;
constexpr size_t WS_WBRA = 129 * MiB, WS_WBRB = 131 * MiB, WS_WOUT = 133 * MiB;
constexpr size_t WS_W13 = 135 * MiB;
constexpr size_t WS_W2 = 247 * MiB;
constexpr size_t WS_GA = 303 * MiB;
constexpr size_t WS_P = WS_GA;
constexpr size_t WS_QK = WS_GA + 288 * MiB;
constexpr size_t WS_HS = WS_GA + 324 * MiB;
constexpr size_t WS_HB = WS_GA + 468 * MiB;
constexpr size_t WS_HA = WS_GA + 504 * MiB;
constexpr size_t WS_T32 = WS_GA + 540 * MiB;
constexpr size_t WS_U = WS_GA + 612 * MiB;
constexpr size_t WS_ACT = WS_GA;
constexpr size_t WS_H2S = WS_GA + 266 * MiB;
constexpr size_t WS_YS = WS_GA + 554 * MiB;
constexpr size_t WS_END = WS_GA + 706 * MiB;
static_assert((size_t)MOE_ROWS * FFE * 2 <= 266 * MiB && (size_t)NE * ECAP * D * 2 <= 288 * MiB && (size_t)MOE_ROWS * D * 4 <= 152 * MiB, "ffn view");

constexpr int CW_BAR = 4096;
constexpr int CW_CNT = 16384;

constexpr int RING_BYTES = 131072;
constexpr int MISC_OFF = RING_BYTES + 320;
constexpr int LDS_BYTES = 147456;

__device__ __forceinline__ unsigned f2bf(float f) { unsigned u = __builtin_bit_cast(unsigned, f); return (u + 0x7fffu + ((u >> 16) & 1u)) >> 16; }
__device__ __forceinline__ unsigned pk2(float lo, float hi) { return f2bf(lo) | (f2bf(hi) << 16); }
__device__ __forceinline__ float bf2f(unsigned b) { return __builtin_bit_cast(float, b << 16); }
__device__ __forceinline__ float bflo(unsigned w) { return __builtin_bit_cast(float, w << 16); }
__device__ __forceinline__ float bfhi(unsigned w) { return __builtin_bit_cast(float, w & 0xffff0000u); }
__device__ __forceinline__ float sigmoidf_(float x) { return 1.f / (1.f + __expf(-x)); }
__device__ __forceinline__ float wave_sum(float v) {
#pragma unroll
    for (int o = 1; o < 64; o <<= 1) v += __shfl_xor(v, o);
    return v;
}
__device__ __forceinline__ float wave_max(float v) {
#pragma unroll
    for (int o = 1; o < 64; o <<= 1) v = fmaxf(v, __shfl_xor(v, o));
    return v;
}
__device__ __forceinline__ int TID() { int t = threadIdx.x; asm volatile("" : "+v"(t)); return t; }
__device__ __forceinline__ int BID() { int b = blockIdx.x; asm volatile("" : "+s"(b)); return b; }
__device__ __forceinline__ int GRD() { int g = gridDim.x; asm volatile("" : "+s"(g)); return g; }
#define LDS_WAIT() asm volatile("s_waitcnt lgkmcnt(0)" ::: "memory")

namespace pg8 {
constexpr int BM = 256, BK = 64, HALF = 128, HTB = HALF * BK * 2, STAGE_BYTES = 8 * HTB, NXCD = 8, WGM = 8;
__host__ __device__ __forceinline__ int lds_byte(int r, int c) { const int st = (r >> 4) * 2 + (c >> 5), rr = r & 15, cc = c & 31, ob = rr * 64 + cc * 2; return st * 1024 + (ob ^ (((ob >> 9) & 1) << 5)); }
__host__ __device__ __forceinline__ void stage_rc(int b, int& R, int& C) { const int st = b / 1024, sb = b % 1024, swz = sb ^ (((sb >> 9) & 1) << 5); R = (st >> 1) * 16 + swz / 64; C = (st & 1) * 32 + (swz % 64) / 2; }
__host__ __device__ __forceinline__ int perm32(int rho) { const int n = rho >> 4, i = rho & 15; return 8 * (i >> 2) + 4 * n + (i & 3); }

struct Unit { int arow, brow, orow, ocol, aux; };
struct Gemm { const bf16* A; const bf16* Bt; int K; };

struct StaticOrder {
    int nM, nN, nwg, G, c;
    __device__ void init(int M, int N, int G_, int c_) { nM = M / BM; nN = N / BM; nwg = nM * nN; G = G_; c = c_; }
    __device__ __forceinline__ bool next(int i, Unit& u) const {
        const long L = (long)i * G + c; if (L >= nwg) return false;
        int wgid = (int)L; { const int q = nwg / NXCD, r = nwg % NXCD, xcd = wgid % NXCD, off = wgid / NXCD; wgid = (xcd < r ? xcd * (q + 1) : r * (q + 1) + (xcd - r) * q) + off; }
        const int nig = WGM * nN, gid = wgid / nig, fm = gid * WGM, gsz = (nM - fm) < WGM ? (nM - fm) : WGM;
        const int pm = fm + ((wgid % nig) % gsz), pn = (wgid % nig) / gsz;
        u.arow = pm * BM; u.brow = pn * BM; u.orow = pm * BM; u.ocol = pn * BM; u.aux = 0; return true;
    }
};
struct MoeOrder {
    int nN, G, c, TT; int c1, c2, c3, c4, c5, c6, c7;
    int a_estride;
    int b_estride;
    __device__ __forceinline__ bool next(int i, Unit& u) const {
        const int nwg = TT * nN; const long L = (long)i * G + c; if (L >= nwg) return false;
        int wgid = (int)L; { const int q = nwg / NXCD, r = nwg % NXCD, xcd = wgid % NXCD, off = wgid / NXCD; wgid = (xcd < r ? xcd * (q + 1) : r * (q + 1) + (xcd - r) * q) + off; }
        const int nig = WGM * nN, gid = wgid / nig, fm = gid * WGM, gsz = (TT - fm) < WGM ? (TT - fm) : WGM;
        const int g = fm + ((wgid % nig) % gsz), pn = (wgid % nig) / gsz;
        const int e = (g >= c1) + (g >= c2) + (g >= c3) + (g >= c4) + (g >= c5) + (g >= c6) + (g >= c7);
        int cb = 0; cb = e >= 1 ? c1 : cb; cb = e >= 2 ? c2 : cb; cb = e >= 3 ? c3 : cb; cb = e >= 4 ? c4 : cb; cb = e >= 5 ? c5 : cb; cb = e >= 6 ? c6 : cb; cb = e >= 7 ? c7 : cb;
        const int rt = g - cb;
        u.arow = a_estride ? e * a_estride + rt * BM : g * BM; u.brow = e * b_estride + pn * BM; u.orow = g * BM; u.ocol = pn * BM; u.aux = e; return true;
    }
};

__device__ __forceinline__ unsigned cvt_pk_bf16(float lo, float hi) { unsigned r; asm volatile("v_cvt_pk_bf16_f32 %0, %1, %2" : "=v"(r) : "v"(lo), "v"(hi)); return r; }

template <class Epi, class Sched, bool ALIGN_EPI = false, bool SP2 = true>
__device__ __forceinline__ void gemm_phase(LAS unsigned char* lds, const Gemm g, const Sched& S, const Epi& E) {
    const int tid = TID(), wid = __builtin_amdgcn_readfirstlane(tid >> 6), lane = tid & 63, wr = wid >> 2, wc = wid & 3, fr = lane & 15, fq = lane >> 4;
    const int K = g.K, nt = K / BK;
    unsigned voffA[2], voffB[2];
#pragma unroll
    for (int i = 0; i < 2; ++i) { int R, C; stage_rc(tid * 16 + i * 8192, R, C); const int Rb = Epi::PERM ? ((R & ~31) + perm32(R & 31)) : R;
        voffA[i] = (unsigned)(R * K + C) * 2u; voffB[i] = (unsigned)(Rb * K + C) * 2u; }
    const size_t kstep = (size_t)(BK * 2);
    const size_t hstep = (size_t)HALF * K * 2;
    const size_t rstep = (size_t)K * 2;
    const unsigned ldsw = (unsigned)wid * 1024u;
    const int aoff = lds_byte(wr * 64 + fr, fq * 8), boff = lds_byte(wc * 32 + fr, fq * 8);
#define PG8_SA(b, h) (((b) * 2 + (h)) * HTB)
#define PG8_SB(b, h) ((4 + (b) * 2 + (h)) * HTB)
#define PG8_STAGE(bufoff, gbase, voff) do { _Pragma("unroll") for (int _i = 0; _i < 2; ++_i) \
        __builtin_amdgcn_global_load_lds((const unsigned*)((const char*)(gbase) + (voff)[_i]), (LAS unsigned*)(lds + (bufoff) + ldsw + _i * 8192), 16, 0, 0); } while (0)
#define PG8_LDA(dst, b, h) do { _Pragma("unroll") for (int m = 0; m < 4; ++m) _Pragma("unroll") for (int k = 0; k < 2; ++k) dst[m][k] = *(const LAS bf16x8*)(lds + PG8_SA(b, h) + aoff + m * 2048 + k * 1024); } while (0)
#define PG8_LDB(dst, b, h) do { _Pragma("unroll") for (int n = 0; n < 2; ++n) _Pragma("unroll") for (int k = 0; k < 2; ++k) dst[n][k] = *(const LAS bf16x8*)(lds + PG8_SB(b, h) + boff + n * 2048 + k * 1024); } while (0)
#define PG8_MMA(ai, bj, At, Bt) do { __builtin_amdgcn_s_setprio(1); _Pragma("unroll") for (int m = 0; m < 4; ++m) _Pragma("unroll") for (int n = 0; n < 2; ++n) _Pragma("unroll") for (int k = 0; k < 2; ++k) \
        acc[ai][bj][m][n] = __builtin_amdgcn_mfma_f32_16x16x32_bf16(Bt[n][k], At[m][k], acc[ai][bj][m][n], 0, 0, 0); __builtin_amdgcn_s_setprio(0); } while (0)
#define PG8_WAIT_V(n) asm volatile("s_waitcnt vmcnt(" #n ")" ::: "memory")
#define PG8_WAIT_L(n) asm volatile("s_waitcnt lgkmcnt(" #n ")" ::: "memory")
#define PG8_BAR __builtin_amdgcn_s_barrier()
#define PG8_SCHED __builtin_amdgcn_sched_barrier(0)
    Unit cur, nxt; int ui = 0;
    if (!S.next(0, cur)) return;
    f32x4 acc[2][2][4][2];
#pragma unroll
    for (int a = 0; a < 2; ++a)
#pragma unroll
        for (int b = 0; b < 2; ++b)
#pragma unroll
            for (int m = 0; m < 4; ++m)
#pragma unroll
                for (int n = 0; n < 2; ++n) acc[a][b][m][n] = (f32x4){0.f, 0.f, 0.f, 0.f};
    bf16x8 At[4][2], B0[2][2], B1[2][2];
    const char* cA = (const char*)g.A + (size_t)cur.arow * rstep; const char* cB = (const char*)g.Bt + (size_t)cur.brow * rstep;
    if constexpr (SP2) {
        PG8_STAGE(PG8_SB(0, 0), cB, voffB); PG8_STAGE(PG8_SB(0, 1), cB + hstep, voffB); PG8_STAGE(PG8_SA(0, 0), cA, voffA); PG8_STAGE(PG8_SA(0, 1), cA + hstep, voffA);
        if (wr == 1) PG8_BAR;
        PG8_WAIT_V(2); PG8_BAR;
        PG8_STAGE(PG8_SB(1, 0), cB + kstep, voffB); PG8_STAGE(PG8_SA(1, 0), cA + kstep, voffA); PG8_STAGE(PG8_SB(1, 1), cB + hstep + kstep, voffB);
        PG8_WAIT_V(6); PG8_BAR;
    } else {
        PG8_STAGE(PG8_SB(0, 0), cB, voffB); PG8_STAGE(PG8_SA(0, 0), cA, voffA); PG8_STAGE(PG8_SB(0, 1), cB + hstep, voffB); PG8_STAGE(PG8_SA(0, 1), cA + hstep, voffA);
        if (wr == 1) PG8_BAR;
        PG8_WAIT_V(4); PG8_BAR;
        PG8_STAGE(PG8_SB(1, 0), cB + kstep, voffB); PG8_STAGE(PG8_SA(1, 0), cA + kstep, voffA); PG8_STAGE(PG8_SB(1, 1), cB + hstep + kstep, voffB);
        PG8_WAIT_V(6); PG8_BAR;
    }
    for (;;) {
        const bool has_next = S.next(ui + 1, nxt);
        const char* nA = has_next ? (const char*)g.A + (size_t)nxt.arow * rstep : cA; const char* nB = has_next ? (const char*)g.Bt + (size_t)nxt.brow * rstep : cB;
        for (int t = 0; t < nt; t += 2) {
            const bool last = (t == nt - 2);
            const char* a1 = cA + (size_t)(t + 1) * kstep;
            const char* a2 = last ? nA : cA + (size_t)(t + 2) * kstep; const char* b2 = last ? nB : cB + (size_t)(t + 2) * kstep;
            const char* a3 = a2 + kstep; const char* b3 = b2 + kstep;
            if constexpr (SP2) {
            PG8_LDB(B0, 0, 0); PG8_LDB(B1, 0, 1); PG8_SCHED; PG8_LDA(At, 0, 0); PG8_STAGE(PG8_SA(1, 1), a1 + hstep, voffA);
            PG8_WAIT_V(8); PG8_WAIT_L(0); PG8_BAR; PG8_MMA(0, 0, At, B0); PG8_MMA(0, 1, At, B1); PG8_BAR; PG8_SCHED;
            PG8_LDA(At, 0, 1); PG8_STAGE(PG8_SB(0, 0), b2, voffB); PG8_STAGE(PG8_SB(0, 1), b2 + hstep, voffB); PG8_STAGE(PG8_SA(0, 0), a2, voffA);
            PG8_WAIT_V(8); PG8_WAIT_L(0); PG8_BAR; PG8_MMA(1, 0, At, B0); PG8_MMA(1, 1, At, B1); PG8_BAR; PG8_SCHED;
            PG8_LDB(B0, 1, 0); PG8_LDB(B1, 1, 1); PG8_SCHED; PG8_LDA(At, 1, 0); PG8_STAGE(PG8_SA(0, 1), a2 + hstep, voffA);
            PG8_WAIT_V(8); PG8_WAIT_L(0); PG8_BAR; PG8_MMA(0, 0, At, B0); PG8_MMA(0, 1, At, B1); PG8_BAR; PG8_SCHED;
            PG8_LDA(At, 1, 1); PG8_STAGE(PG8_SB(1, 0), b3, voffB); PG8_STAGE(PG8_SB(1, 1), b3 + hstep, voffB); PG8_STAGE(PG8_SA(1, 0), a3, voffA);
            PG8_WAIT_V(8); PG8_WAIT_L(0); PG8_BAR; PG8_MMA(1, 0, At, B0); PG8_MMA(1, 1, At, B1); PG8_BAR; PG8_SCHED;
            } else {
            PG8_LDB(B0, 0, 0); PG8_SCHED; PG8_LDA(At, 0, 0); PG8_STAGE(PG8_SA(1, 1), a1 + hstep, voffA);
            PG8_WAIT_L(8); PG8_BAR; PG8_WAIT_L(0); PG8_MMA(0, 0, At, B0); PG8_BAR; PG8_SCHED;
            PG8_LDB(B1, 0, 1); PG8_STAGE(PG8_SB(0, 0), b2, voffB);
            PG8_BAR; PG8_WAIT_L(0); PG8_MMA(0, 1, At, B1); PG8_BAR;
            PG8_LDA(At, 0, 1); PG8_STAGE(PG8_SA(0, 0), a2, voffA);
            PG8_BAR; PG8_WAIT_L(0); PG8_MMA(1, 0, At, B0); PG8_BAR; PG8_SCHED;
            PG8_STAGE(PG8_SB(0, 1), b2 + hstep, voffB);
            PG8_WAIT_V(6); PG8_BAR; PG8_MMA(1, 1, At, B1); PG8_BAR;
            PG8_LDB(B0, 1, 0); PG8_SCHED; PG8_LDA(At, 1, 0); PG8_STAGE(PG8_SA(0, 1), a2 + hstep, voffA);
            PG8_WAIT_L(8); PG8_BAR; PG8_WAIT_L(0); PG8_MMA(0, 0, At, B0); PG8_BAR; PG8_SCHED;
            PG8_LDB(B1, 1, 1); PG8_STAGE(PG8_SB(1, 0), b3, voffB);
            PG8_BAR; PG8_WAIT_L(0); PG8_MMA(0, 1, At, B1); PG8_BAR;
            PG8_LDA(At, 1, 1); PG8_STAGE(PG8_SA(1, 0), a3, voffA);
            PG8_BAR; PG8_WAIT_L(0); PG8_MMA(1, 0, At, B0); PG8_BAR; PG8_SCHED;
            PG8_STAGE(PG8_SB(1, 1), b3 + hstep, voffB);
            PG8_WAIT_V(6); PG8_BAR; PG8_MMA(1, 1, At, B1); PG8_BAR;
            }
        }
        if constexpr (ALIGN_EPI) { if (wr == 0) PG8_BAR; }
        E(acc, cur, wr, wc, fr, fq);
        if (!has_next) break;
#pragma unroll
        for (int a = 0; a < 2; ++a)
#pragma unroll
            for (int b = 0; b < 2; ++b)
#pragma unroll
                for (int m = 0; m < 4; ++m)
#pragma unroll
                    for (int n = 0; n < 2; ++n) acc[a][b][m][n] = (f32x4){0.f, 0.f, 0.f, 0.f};
        cur = nxt; cA = nA; cB = nB; ++ui;
        if constexpr (ALIGN_EPI) { if (wr == 1) PG8_BAR; }
    }
    PG8_WAIT_V(0);
    if constexpr (!ALIGN_EPI) { if (wr == 0) PG8_BAR; }
    PG8_BAR;
#undef PG8_SA
#undef PG8_SB
#undef PG8_STAGE
#undef PG8_LDA
#undef PG8_LDB
#undef PG8_MMA
#undef PG8_WAIT_V
#undef PG8_WAIT_L
#undef PG8_BAR
#undef PG8_SCHED
}

typedef const f32x4 (&AccRef)[2][2][4][2];
struct EpiG1 {
    static constexpr bool PERM = true;
    bf16* O;
    __device__ __forceinline__ void operator()(AccRef acc, const Unit& u, int wr, int wc, int fr, int fq) const {
        const int t = u.ocol >> 8; const int mode = ((t >= 8 && t < 12) || t >= 24) ? 1 : ((t >= 12 && t < 16) ? 2 : 0);
        const int row0 = u.orow + wr * 64 + fr, col0 = u.ocol + wc * 32 + 8 * fq;
#pragma unroll
        for (int ai = 0; ai < 2; ++ai)
#pragma unroll
            for (int m = 0; m < 4; ++m) { bf16* rowp = O + (size_t)(row0 + ai * HALF + m * 16) * NP + col0;
#pragma unroll
                for (int bj = 0; bj < 2; ++bj) { f32x4 v0 = acc[ai][bj][m][0], v1 = acc[ai][bj][m][1];
                    if (mode == 1) {
#pragma unroll
                        for (int j = 0; j < 4; ++j) { v0[j] = sigmoidf_(v0[j]); v1[j] = sigmoidf_(v1[j]); } }
                    else if (mode == 2) { v0 = v0 * 0.125f; v1 = v1 * 0.125f; }
                    u32x4 w; w.x = cvt_pk_bf16(v0[0], v0[1]); w.y = cvt_pk_bf16(v0[2], v0[3]); w.z = cvt_pk_bf16(v1[0], v1[1]); w.w = cvt_pk_bf16(v1[2], v1[3]);
                    *(u32x4*)(rowp + bj * HALF) = w; } }
    }
};
struct EpiMGa {
    static constexpr bool PERM = true;
    const bf16* P; float* T;
    __device__ __forceinline__ void operator()(AccRef acc, const Unit& u, int wr, int wc, int fr, int fq) const {
        const int row0 = u.orow + wr * 64 + fr, col0 = u.ocol + wc * 32 + 8 * fq;
#pragma unroll
        for (int ai = 0; ai < 2; ++ai)
#pragma unroll
            for (int m = 0; m < 4; ++m) { const size_t r = (size_t)(row0 + ai * HALF + m * 16);
#pragma unroll
                for (int bj = 0; bj < 2; ++bj) { const int c = col0 + bj * HALF;
                    const u32x4 gw = *(const u32x4*)(P + r * NP + PC_GA + c);
                    f32x4 v0 = acc[ai][bj][m][0], v1 = acc[ai][bj][m][1];
                    v0[0] *= bflo(gw.x); v0[1] *= bfhi(gw.x); v0[2] *= bflo(gw.y); v0[3] *= bfhi(gw.y);
                    v1[0] *= bflo(gw.z); v1[1] *= bfhi(gw.z); v1[2] *= bflo(gw.w); v1[3] *= bfhi(gw.w);
                    *(f32x4*)(T + r * D + c) = v0; *(f32x4*)(T + r * D + c + 4) = v1; } }
    }
};
struct EpiMGb {
    static constexpr bool PERM = true;
    const bf16* P; const float* T; bf16* U;
    __device__ __forceinline__ void operator()(AccRef acc, const Unit& u, int wr, int wc, int fr, int fq) const {
        const int row0 = u.orow + wr * 64 + fr, col0 = u.ocol + wc * 32 + 8 * fq;
#pragma unroll
        for (int ai = 0; ai < 2; ++ai)
#pragma unroll
            for (int m = 0; m < 4; ++m) { const size_t r = (size_t)(row0 + ai * HALF + m * 16);
#pragma unroll
                for (int bj = 0; bj < 2; ++bj) { const int c = col0 + bj * HALF;
                    const u32x4 gw = *(const u32x4*)(P + r * NP + PC_GB + c);
                    const f32x4 t0 = *(const f32x4*)(T + r * D + c), t1 = *(const f32x4*)(T + r * D + c + 4);
                    f32x4 v0 = acc[ai][bj][m][0], v1 = acc[ai][bj][m][1];
                    v0[0] = t0[0] + v0[0] * bflo(gw.x); v0[1] = t0[1] + v0[1] * bfhi(gw.x); v0[2] = t0[2] + v0[2] * bflo(gw.y); v0[3] = t0[3] + v0[3] * bfhi(gw.y);
                    v1[0] = t1[0] + v1[0] * bflo(gw.z); v1[1] = t1[1] + v1[1] * bfhi(gw.z); v1[2] = t1[2] + v1[2] * bflo(gw.w); v1[3] = t1[3] + v1[3] * bfhi(gw.w);
                    u32x4 w; w.x = cvt_pk_bf16(v0[0], v0[1]); w.y = cvt_pk_bf16(v0[2], v0[3]); w.z = cvt_pk_bf16(v1[0], v1[1]); w.w = cvt_pk_bf16(v1[2], v1[3]);
                    *(u32x4*)(U + r * D + c) = w; } }
    }
};
struct EpiRes {
    static constexpr bool PERM = false;
    const float* xin_lat; const float* xin_ctx; float* XO; const float* gate;
    __device__ __forceinline__ void operator()(AccRef acc, const Unit& u, int wr, int wc, int fr, int fq) const {
        const int row0 = u.orow + wr * 64 + fr, col0 = u.ocol + wc * 32 + 4 * fq;
        const int mr = u.orow < ML ? (u.orow >> 11) : 8;
        const float* gp = gate + (size_t)mr * 6144 + col0;
        f32x4 gv[2][2];
#pragma unroll
        for (int bj = 0; bj < 2; ++bj)
#pragma unroll
            for (int n = 0; n < 2; ++n) gv[bj][n] = *(const f32x4*)(gp + bj * HALF + n * 16);
        const float* xb = u.orow < ML ? xin_lat : xin_ctx - (size_t)ML * D;
#pragma unroll
        for (int ai = 0; ai < 2; ++ai)
#pragma unroll
            for (int m = 0; m < 4; ++m) { const size_t r = (size_t)(row0 + ai * HALF + m * 16);
#pragma unroll
                for (int bj = 0; bj < 2; ++bj)
#pragma unroll
                    for (int n = 0; n < 2; ++n) { const int c = col0 + bj * HALF + n * 16;
                        const f32x4 xi = *(const f32x4*)(xb + r * D + c);
                        *(f32x4*)(XO + r * D + c) = xi + gv[bj][n] * acc[ai][bj][m][n]; } }
    }
};
struct EpiF32 {
    static constexpr bool PERM = false;
    float* Y;
    __device__ __forceinline__ void operator()(AccRef acc, const Unit& u, int wr, int wc, int fr, int fq) const {
        const int row0 = u.orow + wr * 64 + fr, col0 = u.ocol + wc * 32 + 4 * fq;
#pragma unroll
        for (int ai = 0; ai < 2; ++ai)
#pragma unroll
            for (int m = 0; m < 4; ++m) { const size_t r = (size_t)(row0 + ai * HALF + m * 16);
#pragma unroll
                for (int bj = 0; bj < 2; ++bj)
#pragma unroll
                    for (int n = 0; n < 2; ++n) *(f32x4*)(Y + r * D + col0 + bj * HALF + n * 16) = acc[ai][bj][m][n]; }
    }
};
struct EpiSwiglu {
    static constexpr bool PERM = false;
    bf16* ACT; int ldf;
    __device__ __forceinline__ void operator()(AccRef acc, const Unit& u, int wr, int wc, int fr, int fq) const {
        const int row0 = u.orow + wr * 64 + fr, f0 = (u.ocol >> 1) + wc * 16 + 4 * fq;
#pragma unroll
        for (int ai = 0; ai < 2; ++ai)
#pragma unroll
            for (int m = 0; m < 4; ++m) { const size_t r = (size_t)(row0 + ai * HALF + m * 16);
#pragma unroll
                for (int bj = 0; bj < 2; ++bj) { const f32x4 a = acc[ai][bj][m][0], b = acc[ai][bj][m][1]; f32x4 o;
#pragma unroll
                    for (int j = 0; j < 4; ++j) o[j] = a[j] * sigmoidf_(a[j]) * b[j];
                    u32x2 w; w.x = cvt_pk_bf16(o[0], o[1]); w.y = cvt_pk_bf16(o[2], o[3]);
                    *(u32x2*)(ACT + r * ldf + f0 + bj * 64) = w; } }
    }
};
}

#define XB_TMO      128
#define XB_XCNT(j)  (256  + 64 * (j))
#define XB_XSUB(j)  (1280 + 64 * (j))
#define XB_XGEN(j)  (2304 + 64 * (j))
#define XB_TOP      3328
#define XB_TOPGEN   3392
#define XCD_BAR_WORDS 3456
#define XB_SPIN_CAP (1u << 18)
__device__ __forceinline__ unsigned xb_ld(unsigned* p)              { return __hip_atomic_load(p, __ATOMIC_RELAXED, __HIP_MEMORY_SCOPE_AGENT); }
__device__ __forceinline__ unsigned xb_add(unsigned* p, unsigned v) { return __hip_atomic_fetch_add(p, v, __ATOMIC_RELAXED, __HIP_MEMORY_SCOPE_AGENT); }
__device__ __forceinline__ unsigned xb_xcc_id() { return (unsigned)__builtin_amdgcn_s_getreg((3 << 11) | 20) & 0xFu; }
#define XB_SPIN(cond, bar) do { unsigned _sp = 0; while (cond) { __builtin_amdgcn_s_sleep(1); \
    if ((++_sp & 255u) == 0u) { if (xb_ld(&(bar)[XB_TMO])) break; if (_sp > XB_SPIN_CAP) { atomicAdd(&(bar)[XB_TMO], 1u); break; } } } } while (0)
struct XcdBarrier { unsigned* bar; unsigned x; volatile LAS unsigned* st; };
__device__ __forceinline__ XcdBarrier xcd_barrier_post(unsigned* bar, volatile LAS unsigned* st) {
    XcdBarrier b; b.bar = bar; b.x = xb_xcc_id(); b.st = st;
    if (threadIdx.x == 0) (void)xb_add(&bar[XB_XCNT(b.x)], 1u);
    return b;
}
__device__ __forceinline__ void xcd_barrier_complete(unsigned* bar, unsigned x, unsigned& nloc, unsigned& nx) {
    const unsigned G = gridDim.x * gridDim.y * gridDim.z;
    unsigned sum, cnt, mine, sp = 0u;
    for (;;) {
        sum = 0u; cnt = 0u; mine = 0u;
#pragma unroll
        for (unsigned j = 0; j < 16; ++j) { const unsigned c = xb_ld(&bar[XB_XCNT(j)]); sum += c; cnt += (c > 0u) ? 1u : 0u; mine = (j == x) ? c : mine; }
        if (sum == G) break;
        __builtin_amdgcn_s_sleep(1);
        if ((++sp & 255u) == 0u) { if (xb_ld(&bar[XB_TMO])) break; if (sp > XB_SPIN_CAP) { atomicAdd(&bar[XB_TMO], 1u); break; } }
    }
    nloc = mine > 0u ? mine : 1u; nx = cnt > 0u ? cnt : 1u;
}
__device__ __forceinline__ void xcd_barrier(const XcdBarrier& b) {
    asm volatile("s_waitcnt vmcnt(0)" ::: "memory");
    __syncthreads();
    if (threadIdx.x == 0) {
        unsigned* bar = b.bar;
        __builtin_amdgcn_s_waitcnt(0);
        unsigned nloc = b.st[0], nx = b.st[1];
        if (nloc == 0u) { xcd_barrier_complete(bar, b.x, nloc, nx); b.st[0] = nloc; b.st[1] = nx; }
        const unsigned old = xb_add(&bar[XB_XSUB(b.x)], 1u);
        const unsigned gen = old / nloc;
        if (old + 1u == (gen + 1u) * nloc) {
            __builtin_amdgcn_fence(__ATOMIC_RELEASE, "agent");
            asm volatile("s_waitcnt vmcnt(0)" ::: "memory");
            const unsigned og = xb_add(&bar[XB_TOP], 1u);
            const unsigned tg = og / nx;
            if (og + 1u == (tg + 1u) * nx) xb_add(&bar[XB_TOPGEN], 1u);
            else XB_SPIN(xb_ld(&bar[XB_TOPGEN]) == tg, bar);
            __builtin_amdgcn_fence(__ATOMIC_ACQUIRE, "agent");
            xb_add(&bar[XB_XGEN(b.x)], 1u);
            asm volatile("s_waitcnt vmcnt(0)" ::: "memory");
        } else {
            XB_SPIN(xb_ld(&bar[XB_XGEN(b.x)]) == gen, bar);
            __builtin_amdgcn_fence(__ATOMIC_ACQUIRE, "agent");
            asm volatile("s_waitcnt vmcnt(0)" ::: "memory");
        }
    }
    __syncthreads();
}

struct Args { const float* in[24]; float* out; unsigned char* ws; int ph_lo, ph_hi; };
typedef const __attribute__((address_space(4))) Args* KArgs;
__device__ __forceinline__ KArgs KA() { KArgs p = (KArgs)__builtin_amdgcn_kernarg_segment_ptr(); asm volatile("" : "+s"(p)); return p; }
struct Ctx {
    LAS unsigned char* lds; int tid, lane, wave, G, vcu;
    const float* const* dummy;
};

__device__ __forceinline__ void phase_pre(KArgs a, LAS unsigned char* lds) {
    const int tid = TID(), G = GRD();
    LAS float* sv = (LAS float*)lds;
    LAS float* red = sv + 9 * 1024;
    const float* c = a->in[1]; const float* cc = a->in[3]; const float* w_mod = a->in[4]; const float* b_mod = a->in[5];
    float* MOD = (float*)(a->ws + WS_MOD);
    for (int i = tid; i < 9 * 1024; i += 512) { const int r = i >> 10, k = i & 1023; const float v = r < 8 ? c[r * 1024 + k] : cc[k]; sv[i] = v * sigmoidf_(v); }
    __syncthreads();
    for (int item = BID(); item < DEPTH * 48; item += G) {
        const int l = item / 48, n0 = (item % 48) * 128, kq = tid >> 7, cl = tid & 127;
        float acc[9];
#pragma unroll
        for (int r = 0; r < 9; ++r) acc[r] = 0.f;
        const float* w = w_mod + ((size_t)l * 1024 + kq * 256) * 6144 + n0 + cl;
#pragma unroll 4
        for (int k = 0; k < 256; ++k) { const float wv = w[(size_t)k * 6144];
#pragma unroll
            for (int r = 0; r < 9; ++r) acc[r] += sv[r * 1024 + kq * 256 + k] * wv; }
#pragma unroll
        for (int r = 0; r < 9; ++r) red[(kq * 9 + r) * 128 + cl] = acc[r];
        __syncthreads();
        for (int o = tid; o < 9 * 128; o += 512) { const int r = o >> 7, q = o & 127;
            const float s = red[(0 * 9 + r) * 128 + q] + red[(1 * 9 + r) * 128 + q] + red[(2 * 9 + r) * 128 + q] + red[(3 * 9 + r) * 128 + q] + b_mod[l * 6144 + n0 + q];
            MOD[(size_t)(l * 9 + r) * 6144 + n0 + q] = s; }
        __syncthreads();
    }
}

__device__ __forceinline__ void tr_item(const float* srcA, const float* srcB, int ld, bf16* dst, int K, int drow0, int k0, LAS float* scr, int lane) {
    const int nl = lane & 31; const float* s = nl < 16 ? srcA + nl : srcB + (nl - 16);
#pragma unroll 8
    for (int i = 0; i < 32; ++i) { const int kk = 2 * i + (lane >> 5); scr[kk * 33 + nl] = s[(size_t)(k0 + kk) * ld]; }
    LDS_WAIT(); asm volatile("" ::: "memory");
    const int c = lane & 7;
#pragma unroll
    for (int j = 0; j < 4; ++j) { const int n = (lane >> 3) + 8 * j; const LAS float* p = scr + (8 * c) * 33 + n;
        u32x4 o; o.x = pk2(p[0 * 33], p[1 * 33]); o.y = pk2(p[2 * 33], p[3 * 33]); o.z = pk2(p[4 * 33], p[5 * 33]); o.w = pk2(p[6 * 33], p[7 * 33]);
        *(u32x4*)(dst + (size_t)(drow0 + n) * K + k0 + 8 * c) = o; }
    LDS_WAIT(); asm volatile("" ::: "memory");
}
__device__ __forceinline__ void convert_layer(KArgs a, LAS unsigned char* lds, int l) {
    const int lane = TID() & 63, wave = TID() >> 6;
    LAS float* scr = (LAS float*)(lds + wave * 8704);
    const int gw = BID() * 8 + wave, NGW = GRD() * 8;
    bf16* WIN = (bf16*)(a->ws + WS_WIN); bf16* WBRA = (bf16*)(a->ws + WS_WBRA); bf16* WBRB = (bf16*)(a->ws + WS_WBRB); bf16* WOUT = (bf16*)(a->ws + WS_WOUT);
    bf16* W13 = (bf16*)(a->ws + WS_W13); bf16* W2 = (bf16*)(a->ws + WS_W2);
    const float* w_in = a->in[8] + (size_t)l * D * DIN;
    const float* wbra = a->in[13] + (size_t)l * D * D; const float* wbrb = a->in[14] + (size_t)l * D * D; const float* wout = a->in[15] + (size_t)l * D * D;
    const int j = l >> 1; const bool moe = l & 1;
    constexpr int I_IN = 16 * 256, I_SQ = 16 * 32;
    constexpr int I_D13 = 16 * (2 * FF / 32), I_D2 = (FF / 64) * 32;
    constexpr int I_E13 = 16 * (2 * FFE / 32), I_E2 = (FFE / 64) * 32;
    const int n_ffn = moe ? NE * (I_E13 + I_E2) : (I_D13 + I_D2);
    const int total = I_IN + 3 * I_SQ + n_ffn;
    for (int it = gw; it < total; it += NGW) {
        int r = it;
        if (r < I_IN) { const int kb = r >> 8, nb = r & 255, n0 = nb * 32, sc = n0 < 3072 ? n0 : n0 + 16; tr_item(w_in + sc, w_in + sc + 16, DIN, WIN, D, n0, kb * 64, scr, lane); continue; } r -= I_IN;
        if (r < I_SQ) { const int kb = r >> 5, nb = r & 31; tr_item(wbra + nb * 32, wbra + nb * 32 + 16, D, WBRA, D, nb * 32, kb * 64, scr, lane); continue; } r -= I_SQ;
        if (r < I_SQ) { const int kb = r >> 5, nb = r & 31; tr_item(wbrb + nb * 32, wbrb + nb * 32 + 16, D, WBRB, D, nb * 32, kb * 64, scr, lane); continue; } r -= I_SQ;
        if (r < I_SQ) { const int kb = r >> 5, nb = r & 31; tr_item(wout + nb * 32, wout + nb * 32 + 16, D, WOUT, D, nb * 32, kb * 64, scr, lane); continue; } r -= I_SQ;
        if (!moe) {
            const float* w1 = a->in[16] + (size_t)j * D * FF; const float* w3 = a->in[17] + (size_t)j * D * FF; const float* w2 = a->in[18] + (size_t)j * FF * D;
            if (r < I_D13) { constexpr int NBK = 2 * FF / 32; const int kb = r / NBK, nb = r % NBK; tr_item(w1 + nb * 16, w3 + nb * 16, FF, W13, D, nb * 32, kb * 64, scr, lane); continue; } r -= I_D13;
            { const int kb = r >> 5, nb = r & 31; tr_item(w2 + nb * 32, w2 + nb * 32 + 16, D, W2, FF, nb * 32, kb * 64, scr, lane); }
        } else {
            const int e = r / (I_E13 + I_E2); r -= e * (I_E13 + I_E2);
            const float* w1 = a->in[20] + ((size_t)j * NE + e) * D * FFE; const float* w3 = a->in[21] + ((size_t)j * NE + e) * D * FFE; const float* w2 = a->in[22] + ((size_t)j * NE + e) * FFE * D;
            if (r < I_E13) { constexpr int NBK = 2 * FFE / 32; const int kb = r / NBK, nb = r % NBK; tr_item(w1 + nb * 16, w3 + nb * 16, FFE, W13 + (size_t)e * 2 * FFE * D, D, nb * 32, kb * 64, scr, lane); continue; } r -= I_E13;
            { const int kb = r >> 5, nb = r & 31; tr_item(w2 + nb * 32, w2 + nb * 32 + 16, D, W2 + (size_t)e * D * FFE, FFE, nb * 32, kb * 64, scr, lane); }
        }
    }
}

struct MoeCum { int cum[NE]; };
__device__ __forceinline__ void load_tile_prefix(const unsigned* cnt, int (&cum)[NE + 1]) {
    int acc = 0;
#pragma unroll
    for (int e = 0; e < NE; ++e) { cum[e] = acc; const int c = (int)__hip_atomic_load(cnt + e, __ATOMIC_RELAXED, __HIP_MEMORY_SCOPE_AGENT); acc += (c + 255) >> 8; }
    cum[NE] = acc;
}
__device__ __forceinline__ void moe_combine_row(KArgs a, int lm  , int row, int lane, f32x4 (&v)[4]) {
    const unsigned* cnt = (const unsigned*)(a->ws + WS_CTL) + CW_CNT + (lm >> 1) * 64;
    const int* RTI = (const int*)(a->ws + WS_RTI); const float* RTW = (const float*)(a->ws + WS_RTW); const float* YS = (const float*)(a->ws + WS_YS);
    const float* MOD = (const float*)(a->ws + WS_MOD);
    const int e0 = RTI[row * 4 + 0], r0 = RTI[row * 4 + 1], e1 = RTI[row * 4 + 2], r1 = RTI[row * 4 + 3];
    const float w0 = RTW[row * 2 + 0], w1 = RTW[row * 2 + 1];
    int c0 = 0, c1 = 0, accp = 0;
#pragma unroll
    for (int e = 0; e < NE; ++e) { const int c = (int)__hip_atomic_load(cnt + e, __ATOMIC_RELAXED, __HIP_MEMORY_SCOPE_AGENT); c0 = (e == e0) ? accp : c0; c1 = (e == e1) ? accp : c1; accp += (c + 255) >> 8; }
    const size_t s0 = (size_t)c0 * 256 + r0, s1 = (size_t)c1 * 256 + r1;
    const int mr = row < ML ? (row >> 11) : 8;
    const float* g2 = MOD + (size_t)(lm * 9 + mr) * 6144 + 5120;
#pragma unroll
    for (int j = 0; j < 4; ++j) { const int col = 4 * lane + 256 * j;
        const f32x4 y0 = *(const f32x4*)(YS + s0 * D + col), y1 = *(const f32x4*)(YS + s1 * D + col), g = *(const f32x4*)(g2 + col);
        v[j] = v[j] + g * (y0 * w0 + y1 * w1); }
}

__device__ __forceinline__ void phase_n1(KArgs a, LAS unsigned char* lds, int l) {
    const int tid = TID(), lane = tid & 63, wave = tid >> 6;
    LAS float* gwt = (LAS float*)lds;
    const float* w_in = a->in[8] + (size_t)l * D * DIN;
    __syncthreads();
    for (int i = tid; i < 16 * 1024; i += 512) { const int k = i >> 4, g = i & 15; gwt[g * 1024 + k] = w_in[(size_t)k * DIN + 3072 + g]; }
    __syncthreads();
    const float* MOD = (const float*)(a->ws + WS_MOD); float* XR = (float*)(a->ws + WS_XR); bf16* H = (bf16*)(a->ws + WS_H); float* GPRE = (float*)(a->ws + WS_GPRE);
    const float* g1 = a->in[6] + l * D; const float* gb = a->in[10] + l * 16;
    const bool combine = (l > 0) && ((l - 1) & 1);
    const int gw = BID() * 8 + wave, NGW = GRD() * 8;
    for (int row = gw; row < MROWS; row += NGW) {
        const float* xp = (l == 0) ? (row < ML ? a->in[0] + (size_t)row * D : a->in[2] + (size_t)(row - ML) * D) : XR + (size_t)row * D;
        f32x4 v[4]; float ss = 0.f;
#pragma unroll
        for (int j = 0; j < 4; ++j) v[j] = *(const f32x4*)(xp + 4 * lane + 256 * j);
        if (combine) { moe_combine_row(a, l - 1, row, lane, v);
#pragma unroll
            for (int j = 0; j < 4; ++j) *(f32x4*)(XR + (size_t)row * D + 4 * lane + 256 * j) = v[j]; }
#pragma unroll
        for (int j = 0; j < 4; ++j) ss += (v[j].x * v[j].x + v[j].y * v[j].y) + (v[j].z * v[j].z + v[j].w * v[j].w);
        const float rstd = rsqrtf(wave_sum(ss) * (1.f / D) + EPS);
        const int mr = row < ML ? (row >> 11) : 8; const float* mp = MOD + (size_t)(l * 9 + mr) * 6144;
        f32x4 h[4];
#pragma unroll
        for (int j = 0; j < 4; ++j) { const int col = 4 * lane + 256 * j; const f32x4 g = *(const f32x4*)(g1 + col), sh = *(const f32x4*)(mp + col), sc = *(const f32x4*)(mp + 1024 + col);
            h[j] = (v[j] * rstd * g) * (sc + 1.f) + sh;
            u32x2 w; w.x = pk2(h[j].x, h[j].y); w.y = pk2(h[j].z, h[j].w); *(u32x2*)(H + (size_t)row * D + col) = w; }
        float mine = 0.f;
#pragma unroll 1
        for (int g = 0; g < 16; ++g) { float s = 0.f;
#pragma unroll
            for (int j = 0; j < 4; ++j) { const f32x4 w4 = *(const LAS f32x4*)(gwt + g * 1024 + 256 * j + 4 * lane); s += (h[j].x * w4.x + h[j].y * w4.y) + (h[j].z * w4.z + h[j].w * w4.w); }
            s = wave_sum(s); mine = (lane == g) ? s : mine; }
        if (lane < 16) GPRE[(size_t)row * 16 + lane] = mine + gb[lane];
    }
}

__device__ __forceinline__ void phase_prep(KArgs a, int l) {
    const bf16* P = (const bf16*)(a->ws + WS_P); bf16* QK = (bf16*)(a->ws + WS_QK);
    const float* cw = a->in[9] + (size_t)l * 3 * 1024;
    const int gt = BID() * 512 + TID(), NT = GRD() * 512;
    for (int it = gt; it < MROWS * 64; it += NT) {
        const int row = it >> 6, i = it & 63;
        const bool lat = row < ML; const int t = lat ? (row & (TL - 1)) : ((row - ML) & (TC - 1)); const int T = lat ? TL : TC;
        const int ii = i & 31; const int dbase = (i < 32) ? ii : 64 + ii;
        float cs = 1.f, sn = 0.f;
        if (lat) { const float pos = (i < 32) ? (float)(t >> 6) : (float)(t & 63); const float inv = 1.0f / powf(10000.0f, (float)ii / 32.0f); const float ang = pos * inv; sincosf(ang, &sn, &cs); }
        const bool hp = t > 0, hn = t < T - 1;
#pragma unroll
        for (int qk = 0; qk < 2; ++qk)
#pragma unroll
            for (int h = 0; h < 4; ++h) { const int c1 = qk * 512 + h * 128 + dbase, c2 = c1 + 32;
                float u1 = cw[1024 + c1] * bf2f(P[(size_t)row * NP + c1]), u2 = cw[1024 + c2] * bf2f(P[(size_t)row * NP + c2]);
                if (hp) { u1 += cw[c1] * bf2f(P[(size_t)(row - 1) * NP + c1]); u2 += cw[c2] * bf2f(P[(size_t)(row - 1) * NP + c2]); }
                if (hn) { u1 += cw[2048 + c1] * bf2f(P[(size_t)(row + 1) * NP + c1]); u2 += cw[2048 + c2] * bf2f(P[(size_t)(row + 1) * NP + c2]); }
                u1 = u1 * sigmoidf_(u1); u2 = u2 * sigmoidf_(u2);
                float o1 = u1 * cs - u2 * sn, o2 = u1 * sn + u2 * cs;
                if (qk) { o1 *= 0.08838834764831845f; o2 *= 0.08838834764831845f; }
                QK[(size_t)row * D + c1] = (bf16)f2bf(o1); QK[(size_t)row * D + c2] = (bf16)f2bf(o2); }
    }
}

__device__ __forceinline__ float log_sigmoid_(float x) { return fminf(x, 0.f) - log1pf(__expf(-fabsf(x))); }
__device__ __forceinline__ void phase_scan_naive(KArgs a, LAS unsigned char* lds, int l) {
    const int tid = TID(), lane = tid & 63;
    LAS float* q = (LAS float*)lds;
    LAS float* k = q + 64 * 129;
    LAS float* C = k + 64 * 129;
    LAS float* vv = C + 64 * 129;
    LAS float* S = vv + 64 * 65;
    LAS float* nv = S + 64 * 65;
    LAS float* sc = nv + 128;
    LAS float* bL = sc, *igL = sc + 64, *mrowL = sc + 128, *wintL = sc + 192, *wkL = sc + 256, *denL = sc + 320, *misc = sc + 384;
    const bf16* P = (const bf16*)(a->ws + WS_P); const bf16* QK = (const bf16*)(a->ws + WS_QK); const float* GPRE = (const float*)(a->ws + WS_GPRE);
    float* HS = (float*)(a->ws + WS_HS);
    for (int unit = BID(); unit < 256; unit += GRD()) {
        const int b = unit >> 5, h = (unit >> 3) & 3, dir = (unit >> 2) & 1, vs = unit & 3;
        __syncthreads();
        for (int i = tid; i < 64 * 129; i += 512) C[i] = 0.f;
        if (tid < 128) nv[tid] = 0.f;
        if (tid == 0) misc[0] = 0.f;
        __syncthreads();
        for (int step = 0; step < 36; ++step) {
            const bool isc = step < 4; const int jj = isc ? step : step - 4; const int T = isc ? TC : TL; const int rbase = isc ? ML + b * TC : b * TL;
#define ROWOF(li) (rbase + (dir ? (T - 1 - (64 * jj + (li))) : (64 * jj + (li))))
            for (int i = tid; i < 64 * 128; i += 512) { const int li = i >> 7, d = i & 127; const size_t r = (size_t)ROWOF(li);
                q[li * 129 + d] = bf2f(QK[r * D + h * 128 + d]); k[li * 129 + d] = bf2f(QK[r * D + 512 + h * 128 + d]); }
            for (int i = tid; i < 64 * 64; i += 512) { const int li = i >> 6, v = i & 63; const size_t r = (size_t)ROWOF(li); vv[li * 65 + v] = bf2f(P[r * NP + PC_V + h * 256 + vs * 64 + v]); }
            if (tid < 64) {
                const size_t r = (size_t)ROWOF(lane);
                const float ig = GPRE[r * 16 + (2 * dir) * 4 + h]; const float fg = log_sigmoid_(GPRE[r * 16 + (2 * dir + 1) * 4 + h]);
                float bb = fg;
#pragma unroll
                for (int o = 1; o < 64; o <<= 1) { const float t2 = __shfl_up(bb, o); if (lane >= o) bb += t2; }
                float am = ig - bb;
#pragma unroll
                for (int o = 1; o < 64; o <<= 1) { const float t2 = __shfl_up(am, o); if (lane >= o) am = fmaxf(am, t2); }
                const float m = misc[0];
                const float mrow = bb + fmaxf(m, am);
                const float blast = __shfl(bb, 63);
                const float g = blast - bb + ig;
                const float gmax = wave_max(g);
                const float mnew = fmaxf(blast + m, gmax);
                bL[lane] = bb; igL[lane] = ig; mrowL[lane] = mrow; wintL[lane] = __expf(bb + m - mrow); wkL[lane] = __expf(g - mnew);
                if (lane == 0) { misc[1] = __expf(blast + m - mnew); misc[2] = mnew; }
            }
            __syncthreads();
            for (int it = 0; it < 8; ++it) { const int s = tid & 63, li = (tid >> 6) + 8 * it; float dot = 0.f;
                if (s <= li) {
#pragma unroll 8
                    for (int d = 0; d < 128; ++d) dot += q[li * 129 + d] * k[s * 129 + d];
                    dot *= __expf(bL[li] - bL[s] + igL[s] - mrowL[li]); }
                S[li * 65 + s] = dot; }
            __syncthreads();
            if (tid < 64) { float di = 0.f, dn = 0.f;
                for (int s = 0; s < 64; ++s) di += S[tid * 65 + s];
                for (int d = 0; d < 128; ++d) dn += nv[d] * q[tid * 129 + d];
                const float den = di + wintL[tid] * dn; denL[tid] = fmaxf(fabsf(den), __expf(-mrowL[tid])); }
            __syncthreads();
            for (int it = 0; it < 8; ++it) { const int v = tid & 63, li = (tid >> 6) + 8 * it; float n1 = 0.f, n2 = 0.f;
#pragma unroll 8
                for (int s = 0; s < 64; ++s) n1 += S[li * 65 + s] * vv[s * 65 + v];
#pragma unroll 8
                for (int d = 0; d < 128; ++d) n2 += C[v * 129 + d] * q[li * 129 + d];
                const float num = n1 + wintL[li] * n2;
                HS[((size_t)dir * MROWS + ROWOF(li)) * D + h * 256 + vs * 64 + v] = num / denL[li]; }
            __syncthreads();
            { const float decay = misc[1];
              for (int it = 0; it < 16; ++it) { const int d = tid & 127, v = (tid >> 7) + 4 * it; float s2 = 0.f;
#pragma unroll 8
                  for (int li = 0; li < 64; ++li) s2 += wkL[li] * vv[li * 65 + v] * k[li * 129 + d];
                  C[v * 129 + d] = decay * C[v * 129 + d] + s2; }
              if (tid < 128) { float s2 = 0.f; for (int li = 0; li < 64; ++li) s2 += wkL[li] * k[li * 129 + tid]; nv[tid] = decay * nv[tid] + s2; }
            }
            __syncthreads();
            if (tid == 0) misc[0] = misc[2];
            __syncthreads();
#undef ROWOF
        }
    }
}

__device__ __forceinline__ void phase_na_naive(KArgs a, int l, bool last) {
    const int lane = TID() & 63, wave = TID() >> 6;
    const bf16* P = (const bf16*)(a->ws + WS_P); bf16* HB = (bf16*)(a->ws + WS_HB);
    const float* rpb = a->in[12] + (size_t)l * 16 * 15 * 31;
    const int gw = BID() * 8 + wave, NGW = GRD() * 8;
    const int nitems = (last ? ML : MROWS) * 16;
    for (int item = gw; item < nitems; item += NGW) {
        int h, row;
        if (item < ML * 16) { h = item >> 14; row = item & (ML - 1); } else { const int r2 = item - ML * 16; h = r2 >> 11; row = ML + (r2 & (MC - 1)); }
        const bool lat = row < ML;
        const int b = lat ? (row >> 11) : ((row - ML) >> 8);
        const int t = lat ? (row & (TL - 1)) : 0;
        const int qr = t >> 6, qc = t & 63;
        const int rs = min(max(qr - 4, 0), 24), cs = min(max(qc - 8, 0), 48);
        float q[64];
        { const u32x4* qp = (const u32x4*)(P + (size_t)row * NP + PC_NQ + h * 64);
#pragma unroll
          for (int i = 0; i < 8; ++i) { const u32x4 w = qp[i]; q[8 * i + 0] = bflo(w.x); q[8 * i + 1] = bfhi(w.x); q[8 * i + 2] = bflo(w.y); q[8 * i + 3] = bfhi(w.y); q[8 * i + 4] = bflo(w.z); q[8 * i + 5] = bfhi(w.z); q[8 * i + 6] = bflo(w.w); q[8 * i + 7] = bfhi(w.w); } }
        float s[6];
#pragma unroll
        for (int i = 0; i < 6; ++i) {
            int krow; float bias = 0.f; bool valid = true;
            if (i < 2) { const int li = lane + 64 * i; const int kr = rs + (li >> 4), kc = cs + (li & 15); krow = b * TL + kr * 64 + kc; valid = lat;
                bias = rpb[(h * 15 + (kr - qr + 7)) * 31 + (kc - qc + 15)]; }
            else { krow = ML + b * TC + lane + 64 * (i - 2); }
            float dot = 0.f;
            if (valid) { const u32x4* kp = (const u32x4*)(P + (size_t)krow * NP + PC_NK + h * 64);
#pragma unroll
                for (int j = 0; j < 8; ++j) { const u32x4 w = kp[j];
                    dot += q[8 * j + 0] * bflo(w.x) + q[8 * j + 1] * bfhi(w.x) + q[8 * j + 2] * bflo(w.y) + q[8 * j + 3] * bfhi(w.y) + q[8 * j + 4] * bflo(w.z) + q[8 * j + 5] * bfhi(w.z) + q[8 * j + 6] * bflo(w.w) + q[8 * j + 7] * bfhi(w.w); }
                s[i] = dot + bias; }
            else s[i] = -3.0e38f;
        }
        float mx = s[0];
#pragma unroll
        for (int i = 1; i < 6; ++i) mx = fmaxf(mx, s[i]);
        mx = wave_max(mx);
        float sum = 0.f;
#pragma unroll
        for (int i = 0; i < 6; ++i) { s[i] = (s[i] > -1.0e38f) ? __expf(s[i] - mx) : 0.f; sum += s[i]; }
        sum = wave_sum(sum);
        float o = 0.f;
        const bf16* vb = P + PC_NV + h * 64 + lane;
        if (lat) {
#pragma unroll
            for (int i = 0; i < 2; ++i)
                for (int src = 0; src < 64; ++src) { const int li = src + 64 * i; const int kr = rs + (li >> 4), kc = cs + (li & 15); const size_t krow = (size_t)b * TL + kr * 64 + kc;
                    o += __shfl(s[i], src) * bf2f(vb[krow * NP]); }
        }
#pragma unroll
        for (int i = 2; i < 6; ++i)
            for (int src = 0; src < 64; ++src) { const size_t krow = (size_t)ML + b * TC + src + 64 * (i - 2); o += __shfl(s[i], src) * bf2f(vb[krow * NP]); }
        HB[(size_t)row * D + h * 64 + lane] = (bf16)f2bf(o / sum);
    }
}

__device__ __forceinline__ void phase_ln(KArgs a, int l, bool last) {
    const int lane = TID() & 63, wave = TID() >> 6;
    const float* HS = (const float*)(a->ws + WS_HS); const bf16* P = (const bf16*)(a->ws + WS_P); bf16* HA = (bf16*)(a->ws + WS_HA);
    const float* gh = a->in[11] + l * D;
    const int gw = BID() * 8 + wave, NGW = GRD() * 8; const int nrows = last ? ML : MROWS;
    for (int row = gw; row < nrows; row += NGW) {
#pragma unroll
        for (int j = 0; j < 4; ++j) { const int col = 4 * lane + 256 * j;
            const f32x4 y = *(const f32x4*)(HS + (size_t)row * D + col) + *(const f32x4*)(HS + ((size_t)MROWS + row) * D + col);
            const float mu = wave_sum((y.x + y.y) + (y.z + y.w)) * (1.f / 256.f);
            const f32x4 dlt = y - mu;
            const float var = wave_sum((dlt.x * dlt.x + dlt.y * dlt.y) + (dlt.z * dlt.z + dlt.w * dlt.w)) * (1.f / 256.f);
            const float rstd = rsqrtf(var + EPS);
            const f32x4 g = *(const f32x4*)(gh + col);
            const u32x2 ow = *(const u32x2*)(P + (size_t)row * NP + PC_O + col);
            const f32x4 so = (f32x4){bflo(ow.x), bfhi(ow.x), bflo(ow.y), bfhi(ow.y)};
            const f32x4 r = dlt * rstd * g * so;
            u32x2 w; w.x = pk2(r.x, r.y); w.y = pk2(r.z, r.w); *(u32x2*)(HA + (size_t)row * D + col) = w; }
    }
}

__device__ __forceinline__ void phase_n2(KArgs a, LAS unsigned char* lds, int l, bool last) {
    const int tid = TID(), lane = tid & 63, wave = tid >> 6;
    const bool moe = l & 1; const int jm = l >> 1;
    LAS float* rt = (LAS float*)lds;
    __syncthreads();
    if (moe) { const float* router = a->in[19] + (size_t)jm * D * NE;
        for (int i = tid; i < NE * 1024; i += 512) { const int k = i >> 3, e = i & 7; rt[e * 1024 + k] = router[(size_t)k * NE + e]; } }
    __syncthreads();
    const float* MOD = (const float*)(a->ws + WS_MOD); const float* XR = (const float*)(a->ws + WS_XR); bf16* H = (bf16*)(a->ws + WS_H); bf16* H2S = (bf16*)(a->ws + WS_H2S);
    int* RTI = (int*)(a->ws + WS_RTI); float* RTW = (float*)(a->ws + WS_RTW);
    unsigned* cnt = (unsigned*)(a->ws + WS_CTL) + CW_CNT + jm * 64;
    const float* g2 = a->in[7] + l * D;
    const int gw = BID() * 8 + wave, NGW = GRD() * 8; const int nrows = last ? ML : MROWS;
    for (int row = gw; row < nrows; row += NGW) {
        const float* xp = XR + (size_t)row * D;
        f32x4 v[4]; float ss = 0.f;
#pragma unroll
        for (int j = 0; j < 4; ++j) { v[j] = *(const f32x4*)(xp + 4 * lane + 256 * j); ss += (v[j].x * v[j].x + v[j].y * v[j].y) + (v[j].z * v[j].z + v[j].w * v[j].w); }
        const float rstd = rsqrtf(wave_sum(ss) * (1.f / D) + EPS);
        const int mr = row < ML ? (row >> 11) : 8; const float* mp = MOD + (size_t)(l * 9 + mr) * 6144;
        f32x4 h[4]; u32x2 hw[4];
#pragma unroll
        for (int j = 0; j < 4; ++j) { const int col = 4 * lane + 256 * j; const f32x4 g = *(const f32x4*)(g2 + col), sh = *(const f32x4*)(mp + 3072 + col), sc = *(const f32x4*)(mp + 4096 + col);
            h[j] = (v[j] * rstd * g) * (sc + 1.f) + sh; hw[j].x = pk2(h[j].x, h[j].y); hw[j].y = pk2(h[j].z, h[j].w); }
        if (!moe) {
#pragma unroll
            for (int j = 0; j < 4; ++j) *(u32x2*)(H + (size_t)row * D + 4 * lane + 256 * j) = hw[j];
        } else {
            float lg[NE];
#pragma unroll
            for (int e = 0; e < NE; ++e) { float s = 0.f;
#pragma unroll
                for (int j = 0; j < 4; ++j) { const f32x4 w4 = *(const LAS f32x4*)(rt + e * 1024 + 256 * j + 4 * lane); s += (h[j].x * w4.x + h[j].y * w4.y) + (h[j].z * w4.z + h[j].w * w4.w); }
                lg[e] = wave_sum(s); }
            int i0 = 0; float v0 = lg[0];
#pragma unroll
            for (int e = 1; e < NE; ++e) if (lg[e] > v0) { v0 = lg[e]; i0 = e; }
            int i1 = -1; float v1 = -3.0e38f;
#pragma unroll
            for (int e = 0; e < NE; ++e) if (e != i0 && lg[e] > v1) { v1 = lg[e]; i1 = e; }
            const float w0 = 1.f / (1.f + __expf(v1 - v0)), w1 = 1.f - w0;
            int r0 = 0, r1 = 0;
            if (lane == 0) { r0 = (int)__hip_atomic_fetch_add(cnt + i0, 1u, __ATOMIC_RELAXED, __HIP_MEMORY_SCOPE_AGENT); r1 = (int)__hip_atomic_fetch_add(cnt + i1, 1u, __ATOMIC_RELAXED, __HIP_MEMORY_SCOPE_AGENT); }
            r0 = __shfl(r0, 0); r1 = __shfl(r1, 0);
            if (lane == 0) { RTI[row * 4 + 0] = i0; RTI[row * 4 + 1] = r0; RTI[row * 4 + 2] = i1; RTI[row * 4 + 3] = r1; RTW[row * 2 + 0] = w0; RTW[row * 2 + 1] = w1; }
            bf16* d0 = H2S + ((size_t)i0 * ECAP + r0) * D; bf16* d1 = H2S + ((size_t)i1 * ECAP + r1) * D;
#pragma unroll
            for (int j = 0; j < 4; ++j) { *(u32x2*)(d0 + 4 * lane + 256 * j) = hw[j]; *(u32x2*)(d1 + 4 * lane + 256 * j) = hw[j]; }
        }
    }
}

__device__ __forceinline__ void phase_final(KArgs a) {
    const int lane = TID() & 63, wave = TID() >> 6;
    const float* XR = (const float*)(a->ws + WS_XR); const float* gf = a->in[23];
    const int gw = BID() * 8 + wave, NGW = GRD() * 8;
    for (int row = gw; row < ML; row += NGW) {
        f32x4 v[4]; float ss = 0.f;
#pragma unroll
        for (int j = 0; j < 4; ++j) v[j] = *(const f32x4*)(XR + (size_t)row * D + 4 * lane + 256 * j);
        moe_combine_row(a, DEPTH - 1, row, lane, v);
#pragma unroll
        for (int j = 0; j < 4; ++j) ss += (v[j].x * v[j].x + v[j].y * v[j].y) + (v[j].z * v[j].z + v[j].w * v[j].w);
        const float rstd = rsqrtf(wave_sum(ss) * (1.f / D) + EPS);
#pragma unroll
        for (int j = 0; j < 4; ++j) { const int col = 4 * lane + 256 * j; *(f32x4*)(a->out + (size_t)row * D + col) = v[j] * rstd * *(const f32x4*)(gf + col); }
    }
}

constexpr int PH_PER_LAYER = 10, N_PHASES = 2 + DEPTH * PH_PER_LAYER;
__global__ void __launch_bounds__(512, 2) fwd(Args args) {
    extern __shared__ __attribute__((aligned(16))) unsigned char lds_raw[];
    LAS unsigned char* lds = (LAS unsigned char*)lds_raw;
    const int tid = TID();
    volatile LAS unsigned* MISC = (volatile LAS unsigned*)(lds + MISC_OFF);
    for (int u = tid; u < (LDS_BYTES - RING_BYTES) / 4; u += 512) ((LAS unsigned*)(lds + RING_BYTES))[u] = 0u;
    __syncthreads();
    unsigned* ctl = (unsigned*)(KA()->ws + WS_CTL);
    const int lo = KA()->ph_lo, hi = KA()->ph_hi;
    XcdBarrier bar; bar.bar = ctl + CW_BAR; bar.x = 0; bar.st = nullptr;
    if (hi - lo > 1) bar = xcd_barrier_post(ctl + CW_BAR, MISC + 8);
#ifndef PH_MASK
#define PH_MASK 0xFFFFFFFFu
#endif
#define PM(b) ((PH_MASK >> (b)) & 1u)
#define IN(k) (lo <= (k) && (k) < hi)
#define SEAM(k) do { if (IN(k) && IN((k) + 1)) xcd_barrier(bar); } while (0)

    if (PM(0) && IN(0)) { phase_pre(KA(), lds); } SEAM(0);

    for (int l = 0; l < DEPTH; ++l) {
        const int pb = 1 + l * PH_PER_LAYER; const bool last = (l == DEPTH - 1); const bool moe = l & 1;
        const int Mrows = last ? ML : MROWS;
        const float* MODl = (const float*)(KA()->ws + WS_MOD) + (size_t)l * 9 * 6144;
        if (IN(pb + 0)) { if (PM(1)) convert_layer(KA(), lds, l); if (PM(2)) phase_n1(KA(), lds, l); } SEAM(pb + 0);
        if (PM(3) && IN(pb + 1)) { pg8::Gemm g{(const bf16*)(KA()->ws + WS_H), (const bf16*)(KA()->ws + WS_WIN), D}; pg8::StaticOrder S; S.init(MROWS, NP, GRD(), BID());
            pg8::EpiG1 E{(bf16*)(KA()->ws + WS_P)}; pg8::gemm_phase<pg8::EpiG1, pg8::StaticOrder, true, true>(lds, g, S, E); } SEAM(pb + 1);
        if (PM(4) && IN(pb + 2)) { phase_prep(KA(), l); } SEAM(pb + 2);
        if (IN(pb + 3)) { if (PM(5)) phase_scan_naive(KA(), lds, l); if (PM(6)) phase_na_naive(KA(), l, last); } SEAM(pb + 3);
        if (PM(7) && IN(pb + 4)) { phase_ln(KA(), l, last); } SEAM(pb + 4);
        if (PM(8) && IN(pb + 5)) {
            { pg8::Gemm g{(const bf16*)(KA()->ws + WS_HA), (const bf16*)(KA()->ws + WS_WBRA), D}; pg8::StaticOrder S; S.init(Mrows, D, GRD(), BID());
              pg8::EpiMGa E{(const bf16*)(KA()->ws + WS_P), (float*)(KA()->ws + WS_T32)}; pg8::gemm_phase<pg8::EpiMGa, pg8::StaticOrder, false, true>(lds, g, S, E); }
            { pg8::Gemm g{(const bf16*)(KA()->ws + WS_HB), (const bf16*)(KA()->ws + WS_WBRB), D}; pg8::StaticOrder S; S.init(Mrows, D, GRD(), BID());
              pg8::EpiMGb E{(const bf16*)(KA()->ws + WS_P), (const float*)(KA()->ws + WS_T32), (bf16*)(KA()->ws + WS_U)}; pg8::gemm_phase<pg8::EpiMGb, pg8::StaticOrder, false, true>(lds, g, S, E); }
        } SEAM(pb + 5);
        if (PM(9) && IN(pb + 6)) { pg8::Gemm g{(const bf16*)(KA()->ws + WS_U), (const bf16*)(KA()->ws + WS_WOUT), D}; pg8::StaticOrder S; S.init(Mrows, D, GRD(), BID());
            const float* xl = (l == 0) ? KA()->in[0] : (const float*)(KA()->ws + WS_XR); const float* xc = (l == 0) ? KA()->in[2] : (const float*)(KA()->ws + WS_XR) + (size_t)ML * D;
            pg8::EpiRes E{xl, xc, (float*)(KA()->ws + WS_XR), MODl + 2048}; pg8::gemm_phase<pg8::EpiRes, pg8::StaticOrder, false, true>(lds, g, S, E); } SEAM(pb + 6);
        if (PM(10) && IN(pb + 7)) { phase_n2(KA(), lds, l, last); } SEAM(pb + 7);
        if (!moe) {
            if (PM(11) && IN(pb + 8)) { pg8::Gemm g{(const bf16*)(KA()->ws + WS_H), (const bf16*)(KA()->ws + WS_W13), D}; pg8::StaticOrder S; S.init(Mrows, 2 * FF, GRD(), BID());
                pg8::EpiSwiglu E{(bf16*)(KA()->ws + WS_ACT), FF}; pg8::gemm_phase<pg8::EpiSwiglu, pg8::StaticOrder, true, true>(lds, g, S, E); } SEAM(pb + 8);
            if (PM(12) && IN(pb + 9)) { pg8::Gemm g{(const bf16*)(KA()->ws + WS_ACT), (const bf16*)(KA()->ws + WS_W2), FF}; pg8::StaticOrder S; S.init(Mrows, D, GRD(), BID());
                const float* xr = (const float*)(KA()->ws + WS_XR);
                pg8::EpiRes E{xr, xr + (size_t)ML * D, (float*)(KA()->ws + WS_XR), MODl + 5120}; pg8::gemm_phase<pg8::EpiRes, pg8::StaticOrder, false, true>(lds, g, S, E); } SEAM(pb + 9);
        } else {
            if (PM(13) && (IN(pb + 8) || IN(pb + 9))) {
                int cum[NE + 1]; load_tile_prefix((unsigned*)(KA()->ws + WS_CTL) + CW_CNT + (l >> 1) * 64, cum);
                pg8::MoeOrder S; S.G = GRD(); S.c = BID(); S.TT = __builtin_amdgcn_readfirstlane(cum[8]);
                S.c1 = __builtin_amdgcn_readfirstlane(cum[1]); S.c2 = __builtin_amdgcn_readfirstlane(cum[2]); S.c3 = __builtin_amdgcn_readfirstlane(cum[3]); S.c4 = __builtin_amdgcn_readfirstlane(cum[4]);
                S.c5 = __builtin_amdgcn_readfirstlane(cum[5]); S.c6 = __builtin_amdgcn_readfirstlane(cum[6]); S.c7 = __builtin_amdgcn_readfirstlane(cum[7]);
                if (IN(pb + 8)) { S.nN = 2 * FFE / 256; S.a_estride = ECAP; S.b_estride = 2 * FFE;
                    pg8::Gemm g{(const bf16*)(KA()->ws + WS_H2S), (const bf16*)(KA()->ws + WS_W13), D};
                    pg8::EpiSwiglu E{(bf16*)(KA()->ws + WS_ACT), FFE}; pg8::gemm_phase<pg8::EpiSwiglu, pg8::MoeOrder, true, true>(lds, g, S, E); }
                SEAM(pb + 8);
                if (IN(pb + 9)) { S.nN = D / 256; S.a_estride = 0; S.b_estride = D;
                    pg8::Gemm g{(const bf16*)(KA()->ws + WS_ACT), (const bf16*)(KA()->ws + WS_W2), FFE};
                    pg8::EpiF32 E{(float*)(KA()->ws + WS_YS)}; pg8::gemm_phase<pg8::EpiF32, pg8::MoeOrder, false, true>(lds, g, S, E); }
            }
            SEAM(pb + 9);
        }
    }
    if (PM(14) && IN(N_PHASES - 1)) phase_final(KA());
#undef IN
#undef SEAM
}

extern "C" void kernel_launch(void* const* d_in, const int* in_sizes, int n_in, void* d_out, int out_size, void* d_ws, size_t ws_size, hipStream_t stream) {
    static int grid = 0;
    if (grid == 0) {
        if (n_in != 24 || out_size != ML * D || ws_size < WS_END) { fprintf(stderr, "kernel_launch: unexpected shapes / workspace (%d inputs, out %d, ws %zu < %zu)\n", n_in, out_size, ws_size, (size_t)WS_END); grid = -1; return; }
        int dev = 0, cus = 0;
        if (hipGetDevice(&dev) != hipSuccess || hipDeviceGetAttribute(&cus, hipDeviceAttributeMultiprocessorCount, dev) != hipSuccess) { grid = -1; return; }
        if (hipFuncSetAttribute((const void*)fwd, hipFuncAttributeMaxDynamicSharedMemorySize, LDS_BYTES) != hipSuccess) { fprintf(stderr, "kernel_launch: hipFuncSetAttribute failed\n"); grid = -1; return; }
        int per_cu = 0; (void)hipOccupancyMaxActiveBlocksPerMultiprocessor(&per_cu, (const void*)fwd, 512, LDS_BYTES); (void)hipGetLastError();
        if (per_cu < 1) fprintf(stderr, "kernel_launch: occupancy query reports %d\n", per_cu);
        grid = cus;
    }
    if (grid < 0) return;
    (void)hipMemsetAsync((char*)d_ws + WS_CTL, 0, CTL_ZERO_BYTES, stream);
    Args a{};
    for (int i = 0; i < 24; ++i) a.in[i] = (const float*)d_in[i];
    a.out = (float*)d_out; a.ws = (unsigned char*)d_ws;
#if MK_PER_PHASE
    for (int p = 0; p < N_PHASES; ++p) { a.ph_lo = p; a.ph_hi = p + 1; hipLaunchKernelGGL(fwd, dim3(grid), dim3(512), LDS_BYTES, stream, a); }
#else
    a.ph_lo = 0; a.ph_hi = N_PHASES; hipLaunchKernelGGL(fwd, dim3(grid), dim3(512), LDS_BYTES, stream, a);
#endif
}
```

```cpp
#include <hip/hip_runtime.h>
#include <cstdio>
#include <cstdint>

#ifndef MK_PER_PHASE
#define MK_PER_PHASE 0
#endif

#define LAS __attribute__((address_space(3)))
typedef unsigned short bf16;
typedef short bf16x8 __attribute__((ext_vector_type(8)));
typedef float f32x4 __attribute__((ext_vector_type(4)));
typedef float f32x2 __attribute__((ext_vector_type(2)));
typedef unsigned u32x4 __attribute__((ext_vector_type(4)));
typedef unsigned u32x2 __attribute__((ext_vector_type(2)));

constexpr int D = 1024, NB = 8, TL = 2048, TC = 256, DEPTH = 4;
constexpr int ML = NB * TL, MC = NB * TC, MROWS = ML + MC;
constexpr int DIN = 8208, NP = 8192;
constexpr int PC_Q = 0, PC_K = 512, PC_V = 1024, PC_O = 2048, PC_NQ = 3072, PC_NK = 4096, PC_NV = 5120, PC_GA = 6144, PC_GB = 7168;
constexpr int FF = 2816, FFE = 3584, NE = 8;
constexpr int ECAP = MROWS;
constexpr int MOE_ROWS = 38912;
constexpr float EPS = 1e-6f;

constexpr size_t MiB = 1u << 20;
constexpr size_t WS_CTL = 0, CTL_ZERO_BYTES = 1 * MiB;
constexpr size_t WS_MOD = 1 * MiB;
constexpr size_t WS_RTI = 2 * MiB;
constexpr size_t WS_RTW = 2 * MiB + 512 * 1024;
constexpr size_t WS_GPRE = 3 * MiB;
constexpr size_t WS_XR = 5 * MiB;
constexpr size_t WS_H = 77 * MiB;
constexpr size_t WS_WIN = 113 * MiB;
constexpr size_t WS_WBRA = 129 * MiB, WS_WBRB = 131 * MiB, WS_WOUT = 133 * MiB;
constexpr size_t WS_W13 = 135 * MiB;
constexpr size_t WS_W2 = 247 * MiB;
constexpr size_t WS_GA = 303 * MiB;
constexpr size_t WS_P = WS_GA;
constexpr size_t WS_QK = WS_GA + 288 * MiB;
constexpr size_t WS_HS = WS_GA + 324 * MiB;
constexpr size_t WS_HB = WS_GA + 468 * MiB;
constexpr size_t WS_HA = WS_GA + 504 * MiB;
constexpr size_t WS_T32 = WS_GA + 540 * MiB;
constexpr size_t WS_U = WS_GA + 612 * MiB;
constexpr size_t WS_ACT = WS_GA;
constexpr size_t WS_H2S = WS_GA + 266 * MiB;
constexpr size_t WS_YS = WS_GA + 554 * MiB;
constexpr size_t WS_END = WS_GA + 706 * MiB;
static_assert((size_t)MOE_ROWS * FFE * 2 <= 266 * MiB && (size_t)NE * ECAP * D * 2 <= 288 * MiB && (size_t)MOE_ROWS * D * 4 <= 152 * MiB, "ffn view");

constexpr int CW_BAR = 4096;
constexpr int CW_CNT = 16384;

constexpr int RING_BYTES = 131072;
constexpr int LDS_BYTES = 147456;
constexpr int MISC_OFF = LDS_BYTES - 256;

__device__ __forceinline__ unsigned f2bf(float f) { unsigned u = __builtin_bit_cast(unsigned, f); return (u + 0x7fffu + ((u >> 16) & 1u)) >> 16; }
__device__ __forceinline__ unsigned pk2(float lo, float hi) { return f2bf(lo) | (f2bf(hi) << 16); }
__device__ __forceinline__ float bf2f(unsigned b) { return __builtin_bit_cast(float, b << 16); }
__device__ __forceinline__ float bflo(unsigned w) { return __builtin_bit_cast(float, w << 16); }
__device__ __forceinline__ float bfhi(unsigned w) { return __builtin_bit_cast(float, w & 0xffff0000u); }
__device__ __forceinline__ float sigmoidf_(float x) { return 1.f / (1.f + __expf(-x)); }
__device__ __forceinline__ float wave_sum(float v) {
#pragma unroll
    for (int o = 1; o < 64; o <<= 1) v += __shfl_xor(v, o);
    return v;
}
__device__ __forceinline__ float wave_max(float v) {
#pragma unroll
    for (int o = 1; o < 64; o <<= 1) v = fmaxf(v, __shfl_xor(v, o));
    return v;
}
__device__ __forceinline__ int TID() { int t = threadIdx.x; asm volatile("" : "+v"(t)); return t; }
__device__ __forceinline__ int BID() { int b = blockIdx.x; asm volatile("" : "+s"(b)); return b; }
__device__ __forceinline__ int GRD() { int g = gridDim.x; asm volatile("" : "+s"(g)); return g; }
#define LDS_WAIT() asm volatile("s_waitcnt lgkmcnt(0)" ::: "memory")

namespace pg8 {
constexpr int BM = 256, BK = 64, HALF = 128, HTB = HALF * BK * 2, STAGE_BYTES = 8 * HTB, NXCD = 8, WGM = 8;
__host__ __device__ __forceinline__ int lds_byte(int r, int c) { const int st = (r >> 4) * 2 + (c >> 5), rr = r & 15, cc = c & 31, ob = rr * 64 + cc * 2; return st * 1024 + (ob ^ (((ob >> 9) & 1) << 5)); }
__host__ __device__ __forceinline__ void stage_rc(int b, int& R, int& C) { const int st = b / 1024, sb = b % 1024, swz = sb ^ (((sb >> 9) & 1) << 5); R = (st >> 1) * 16 + swz / 64; C = (st & 1) * 32 + (swz % 64) / 2; }
__host__ __device__ __forceinline__ int perm32(int rho) { const int n = rho >> 4, i = rho & 15; return 8 * (i >> 2) + 4 * n + (i & 3); }

struct Unit { int arow, brow, orow, ocol, aux; };
struct Gemm { const bf16* A; const bf16* Bt; int K; };

struct StaticOrder {
    int nM, nN, nwg, G, c;
    __device__ void init(int M, int N, int G_, int c_) { nM = M / BM; nN = N / BM; nwg = nM * nN; G = G_; c = c_; }
    __device__ __forceinline__ bool next(int i, Unit& u) const {
        const long L = (long)i * G + c; if (L >= nwg) return false;
        int wgid = (int)L; { const int q = nwg / NXCD, r = nwg % NXCD, xcd = wgid % NXCD, off = wgid / NXCD; wgid = (xcd < r ? xcd * (q + 1) : r * (q + 1) + (xcd - r) * q) + off; }
        const int nig = WGM * nN, gid = wgid / nig, fm = gid * WGM, gsz = (nM - fm) < WGM ? (nM - fm) : WGM;
        const int pm = fm + ((wgid % nig) % gsz), pn = (wgid % nig) / gsz;
        u.arow = pm * BM; u.brow = pn * BM; u.orow = pm * BM; u.ocol = pn * BM; u.aux = 0; return true;
    }
};
struct MoeOrder {
    int nN, G, c, TT; int c1, c2, c3, c4, c5, c6, c7;
    int a_estride;
    int b_estride;
    __device__ __forceinline__ bool next(int i, Unit& u) const {
        const int nwg = TT * nN; const long L = (long)i * G + c; if (L >= nwg) return false;
        int wgid = (int)L; { const int q = nwg / NXCD, r = nwg % NXCD, xcd = wgid % NXCD, off = wgid / NXCD; wgid = (xcd < r ? xcd * (q + 1) : r * (q + 1) + (xcd - r) * q) + off; }
        const int nig = WGM * nN, gid = wgid / nig, fm = gid * WGM, gsz = (TT - fm) < WGM ? (TT - fm) : WGM;
        const int g = fm + ((wgid % nig) % gsz), pn = (wgid % nig) / gsz;
        const int e = (g >= c1) + (g >= c2) + (g >= c3) + (g >= c4) + (g >= c5) + (g >= c6) + (g >= c7);
        int cb = 0; cb = e >= 1 ? c1 : cb; cb = e >= 2 ? c2 : cb; cb = e >= 3 ? c3 : cb; cb = e >= 4 ? c4 : cb; cb = e >= 5 ? c5 : cb; cb = e >= 6 ? c6 : cb; cb = e >= 7 ? c7 : cb;
        const int rt = g - cb;
        u.arow = a_estride ? e * a_estride + rt * BM : g * BM; u.brow = e * b_estride + pn * BM; u.orow = g * BM; u.ocol = pn * BM; u.aux = e; return true;
    }
};

__device__ __forceinline__ unsigned cvt_pk_bf16(float lo, float hi) { unsigned r; asm volatile("v_cvt_pk_bf16_f32 %0, %1, %2" : "=v"(r) : "v"(lo), "v"(hi)); return r; }

template <class Epi, class Sched, bool ALIGN_EPI = false, bool SP2 = true>
__device__ __forceinline__ void gemm_phase(LAS unsigned char* lds, const Gemm g, const Sched& S, const Epi& E) {
    const int tid = TID(), wid = __builtin_amdgcn_readfirstlane(tid >> 6), lane = tid & 63, wr = wid >> 2, wc = wid & 3, fr = lane & 15, fq = lane >> 4;
    const int K = g.K, nt = K / BK;
    unsigned voffA[2], voffB[2];
#pragma unroll
    for (int i = 0; i < 2; ++i) { int R, C; stage_rc(tid * 16 + i * 8192, R, C); const int Rb = Epi::PERM ? ((R & ~31) + perm32(R & 31)) : R;
        voffA[i] = (unsigned)(R * K + C) * 2u; voffB[i] = (unsigned)(Rb * K + C) * 2u; }
    const size_t kstep = (size_t)(BK * 2);
    const size_t hstep = (size_t)HALF * K * 2;
    const size_t rstep = (size_t)K * 2;
    const unsigned ldsw = (unsigned)wid * 1024u;
    const int aoff = lds_byte(wr * 64 + fr, fq * 8), boff = lds_byte(wc * 32 + fr, fq * 8);
#define PG8_SA(b, h) (((b) * 2 + (h)) * HTB)
#define PG8_SB(b, h) ((4 + (b) * 2 + (h)) * HTB)
#define PG8_STAGE(bufoff, gbase, voff) do { _Pragma("unroll") for (int _i = 0; _i < 2; ++_i) \
        __builtin_amdgcn_global_load_lds((const unsigned*)((const char*)(gbase) + (voff)[_i]), (LAS unsigned*)(lds + (bufoff) + ldsw + _i * 8192), 16, 0, 0); } while (0)
#define PG8_LDA(dst, b, h) do { _Pragma("unroll") for (int m = 0; m < 4; ++m) _Pragma("unroll") for (int k = 0; k < 2; ++k) dst[m][k] = *(const LAS bf16x8*)(lds + PG8_SA(b, h) + aoff + m * 2048 + k * 1024); } while (0)
#define PG8_LDB(dst, b, h) do { _Pragma("unroll") for (int n = 0; n < 2; ++n) _Pragma("unroll") for (int k = 0; k < 2; ++k) dst[n][k] = *(const LAS bf16x8*)(lds + PG8_SB(b, h) + boff + n * 2048 + k * 1024); } while (0)
#define PG8_MMA(ai, bj, At, Bt) do { __builtin_amdgcn_s_setprio(1); _Pragma("unroll") for (int m = 0; m < 4; ++m) _Pragma("unroll") for (int n = 0; n < 2; ++n) _Pragma("unroll") for (int k = 0; k < 2; ++k) \
        acc[ai][bj][m][n] = __builtin_amdgcn_mfma_f32_16x16x32_bf16(Bt[n][k], At[m][k], acc[ai][bj][m][n], 0, 0, 0); __builtin_amdgcn_s_setprio(0); } while (0)
#define PG8_WAIT_V(n) asm volatile("s_waitcnt vmcnt(" #n ")" ::: "memory")
#define PG8_WAIT_L(n) asm volatile("s_waitcnt lgkmcnt(" #n ")" ::: "memory")
#define PG8_BAR __builtin_amdgcn_s_barrier()
#define PG8_SCHED __builtin_amdgcn_sched_barrier(0)
    Unit cur, nxt; int ui = 0;
    if (!S.next(0, cur)) return;
    f32x4 acc[2][2][4][2];
#pragma unroll
    for (int a = 0; a < 2; ++a)
#pragma unroll
        for (int b = 0; b < 2; ++b)
#pragma unroll
            for (int m = 0; m < 4; ++m)
#pragma unroll
                for (int n = 0; n < 2; ++n) acc[a][b][m][n] = (f32x4){0.f, 0.f, 0.f, 0.f};
    bf16x8 At[4][2], B0[2][2], B1[2][2];
    const char* cA = (const char*)g.A + (size_t)cur.arow * rstep; const char* cB = (const char*)g.Bt + (size_t)cur.brow * rstep;
    if constexpr (SP2) {
        PG8_STAGE(PG8_SB(0, 0), cB, voffB); PG8_STAGE(PG8_SB(0, 1), cB + hstep, voffB); PG8_STAGE(PG8_SA(0, 0), cA, voffA); PG8_STAGE(PG8_SA(0, 1), cA + hstep, voffA);
        if (wr == 1) PG8_BAR;
        PG8_WAIT_V(2); PG8_BAR;
        PG8_STAGE(PG8_SB(1, 0), cB + kstep, voffB); PG8_STAGE(PG8_SA(1, 0), cA + kstep, voffA); PG8_STAGE(PG8_SB(1, 1), cB + hstep + kstep, voffB);
        PG8_WAIT_V(6); PG8_BAR;
    } else {
        PG8_STAGE(PG8_SB(0, 0), cB, voffB); PG8_STAGE(PG8_SA(0, 0), cA, voffA); PG8_STAGE(PG8_SB(0, 1), cB + hstep, voffB); PG8_STAGE(PG8_SA(0, 1), cA + hstep, voffA);
        if (wr == 1) PG8_BAR;
        PG8_WAIT_V(4); PG8_BAR;
        PG8_STAGE(PG8_SB(1, 0), cB + kstep, voffB); PG8_STAGE(PG8_SA(1, 0), cA + kstep, voffA); PG8_STAGE(PG8_SB(1, 1), cB + hstep + kstep, voffB);
        PG8_WAIT_V(6); PG8_BAR;
    }
    for (;;) {
        const bool has_next = S.next(ui + 1, nxt);
        const char* nA = has_next ? (const char*)g.A + (size_t)nxt.arow * rstep : cA; const char* nB = has_next ? (const char*)g.Bt + (size_t)nxt.brow * rstep : cB;
        for (int t = 0; t < nt; t += 2) {
            const bool last = (t == nt - 2);
            const char* a1 = cA + (size_t)(t + 1) * kstep;
            const char* a2 = last ? nA : cA + (size_t)(t + 2) * kstep; const char* b2 = last ? nB : cB + (size_t)(t + 2) * kstep;
            const char* a3 = a2 + kstep; const char* b3 = b2 + kstep;
            if constexpr (SP2) {
            PG8_LDB(B0, 0, 0); PG8_LDB(B1, 0, 1); PG8_SCHED; PG8_LDA(At, 0, 0); PG8_STAGE(PG8_SA(1, 1), a1 + hstep, voffA);
            PG8_WAIT_V(8); PG8_WAIT_L(0); PG8_BAR; PG8_MMA(0, 0, At, B0); PG8_MMA(0, 1, At, B1); PG8_BAR; PG8_SCHED;
            PG8_LDA(At, 0, 1); PG8_STAGE(PG8_SB(0, 0), b2, voffB); PG8_STAGE(PG8_SB(0, 1), b2 + hstep, voffB); PG8_STAGE(PG8_SA(0, 0), a2, voffA);
            PG8_WAIT_V(8); PG8_WAIT_L(0); PG8_BAR; PG8_MMA(1, 0, At, B0); PG8_MMA(1, 1, At, B1); PG8_BAR; PG8_SCHED;
            PG8_LDB(B0, 1, 0); PG8_LDB(B1, 1, 1); PG8_SCHED; PG8_LDA(At, 1, 0); PG8_STAGE(PG8_SA(0, 1), a2 + hstep, voffA);
            PG8_WAIT_V(8); PG8_WAIT_L(0); PG8_BAR; PG8_MMA(0, 0, At, B0); PG8_MMA(0, 1, At, B1); PG8_BAR; PG8_SCHED;
            PG8_LDA(At, 1, 1); PG8_STAGE(PG8_SB(1, 0), b3, voffB); PG8_STAGE(PG8_SB(1, 1), b3 + hstep, voffB); PG8_STAGE(PG8_SA(1, 0), a3, voffA);
            PG8_WAIT_V(8); PG8_WAIT_L(0); PG8_BAR; PG8_MMA(1, 0, At, B0); PG8_MMA(1, 1, At, B1); PG8_BAR; PG8_SCHED;
            } else {
            PG8_LDB(B0, 0, 0); PG8_SCHED; PG8_LDA(At, 0, 0); PG8_STAGE(PG8_SA(1, 1), a1 + hstep, voffA);
            PG8_WAIT_L(8); PG8_BAR; PG8_WAIT_L(0); PG8_MMA(0, 0, At, B0); PG8_BAR; PG8_SCHED;
            PG8_LDB(B1, 0, 1); PG8_STAGE(PG8_SB(0, 0), b2, voffB);
            PG8_BAR; PG8_WAIT_L(0); PG8_MMA(0, 1, At, B1); PG8_BAR;
            PG8_LDA(At, 0, 1); PG8_STAGE(PG8_SA(0, 0), a2, voffA);
            PG8_BAR; PG8_WAIT_L(0); PG8_MMA(1, 0, At, B0); PG8_BAR; PG8_SCHED;
            PG8_STAGE(PG8_SB(0, 1), b2 + hstep, voffB);
            PG8_WAIT_V(6); PG8_BAR; PG8_MMA(1, 1, At, B1); PG8_BAR;
            PG8_LDB(B0, 1, 0); PG8_SCHED; PG8_LDA(At, 1, 0); PG8_STAGE(PG8_SA(0, 1), a2 + hstep, voffA);
            PG8_WAIT_L(8); PG8_BAR; PG8_WAIT_L(0); PG8_MMA(0, 0, At, B0); PG8_BAR; PG8_SCHED;
            PG8_LDB(B1, 1, 1); PG8_STAGE(PG8_SB(1, 0), b3, voffB);
            PG8_BAR; PG8_WAIT_L(0); PG8_MMA(0, 1, At, B1); PG8_BAR;
            PG8_LDA(At, 1, 1); PG8_STAGE(PG8_SA(1, 0), a3, voffA);
            PG8_BAR; PG8_WAIT_L(0); PG8_MMA(1, 0, At, B0); PG8_BAR; PG8_SCHED;
            PG8_STAGE(PG8_SB(1, 1), b3 + hstep, voffB);
            PG8_WAIT_V(6); PG8_BAR; PG8_MMA(1, 1, At, B1); PG8_BAR;
            }
        }
        if constexpr (ALIGN_EPI) { if (wr == 0) PG8_BAR; }
        E(acc, cur, wr, wc, fr, fq);
        if (!has_next) break;
#pragma unroll
        for (int a = 0; a < 2; ++a)
#pragma unroll
            for (int b = 0; b < 2; ++b)
#pragma unroll
                for (int m = 0; m < 4; ++m)
#pragma unroll
                    for (int n = 0; n < 2; ++n) acc[a][b][m][n] = (f32x4){0.f, 0.f, 0.f, 0.f};
        cur = nxt; cA = nA; cB = nB; ++ui;
        if constexpr (ALIGN_EPI) { if (wr == 1) PG8_BAR; }
    }
    PG8_WAIT_V(0);
    if constexpr (!ALIGN_EPI) { if (wr == 0) PG8_BAR; }
    PG8_BAR;
#undef PG8_SA
#undef PG8_SB
#undef PG8_STAGE
#undef PG8_LDA
#undef PG8_LDB
#undef PG8_MMA
#undef PG8_WAIT_V
#undef PG8_WAIT_L
#undef PG8_BAR
#undef PG8_SCHED
}

typedef const f32x4 (&AccRef)[2][2][4][2];
struct EpiG1 {
    static constexpr bool PERM = true;
    bf16* O;
    __device__ __forceinline__ void operator()(AccRef acc, const Unit& u, int wr, int wc, int fr, int fq) const {
        const int t = u.ocol >> 8; const int mode = ((t >= 8 && t < 12) || t >= 24) ? 1 : ((t >= 12 && t < 16) ? 2 : 0);
        const int row0 = u.orow + wr * 64 + fr, col0 = u.ocol + wc * 32 + 8 * fq;
#pragma unroll
        for (int ai = 0; ai < 2; ++ai)
#pragma unroll
            for (int m = 0; m < 4; ++m) { bf16* rowp = O + (size_t)(row0 + ai * HALF + m * 16) * NP + col0;
#pragma unroll
                for (int bj = 0; bj < 2; ++bj) { f32x4 v0 = acc[ai][bj][m][0], v1 = acc[ai][bj][m][1];
                    if (mode == 1) {
#pragma unroll
                        for (int j = 0; j < 4; ++j) { v0[j] = sigmoidf_(v0[j]); v1[j] = sigmoidf_(v1[j]); } }
                    else if (mode == 2) { v0 = v0 * 0.125f; v1 = v1 * 0.125f; }
                    u32x4 w; w.x = cvt_pk_bf16(v0[0], v0[1]); w.y = cvt_pk_bf16(v0[2], v0[3]); w.z = cvt_pk_bf16(v1[0], v1[1]); w.w = cvt_pk_bf16(v1[2], v1[3]);
                    *(u32x4*)(rowp + bj * HALF) = w; } }
    }
};
struct EpiMGa {
    static constexpr bool PERM = true;
    const bf16* P; float* T;
    __device__ __forceinline__ void operator()(AccRef acc, const Unit& u, int wr, int wc, int fr, int fq) const {
        const int row0 = u.orow + wr * 64 + fr, col0 = u.ocol + wc * 32 + 8 * fq;
#pragma unroll
        for (int ai = 0; ai < 2; ++ai)
#pragma unroll
            for (int m = 0; m < 4; ++m) { const size_t r = (size_t)(row0 + ai * HALF + m * 16);
#pragma unroll
                for (int bj = 0; bj < 2; ++bj) { const int c = col0 + bj * HALF;
                    const u32x4 gw = *(const u32x4*)(P + r * NP + PC_GA + c);
                    f32x4 v0 = acc[ai][bj][m][0], v1 = acc[ai][bj][m][1];
                    v0[0] *= bflo(gw.x); v0[1] *= bfhi(gw.x); v0[2] *= bflo(gw.y); v0[3] *= bfhi(gw.y);
                    v1[0] *= bflo(gw.z); v1[1] *= bfhi(gw.z); v1[2] *= bflo(gw.w); v1[3] *= bfhi(gw.w);
                    *(f32x4*)(T + r * D + c) = v0; *(f32x4*)(T + r * D + c + 4) = v1; } }
    }
};
struct EpiMGb {
    static constexpr bool PERM = true;
    const bf16* P; const float* T; bf16* U;
    __device__ __forceinline__ void operator()(AccRef acc, const Unit& u, int wr, int wc, int fr, int fq) const {
        const int row0 = u.orow + wr * 64 + fr, col0 = u.ocol + wc * 32 + 8 * fq;
#pragma unroll
        for (int ai = 0; ai < 2; ++ai)
#pragma unroll
            for (int m = 0; m < 4; ++m) { const size_t r = (size_t)(row0 + ai * HALF + m * 16);
#pragma unroll
                for (int bj = 0; bj < 2; ++bj) { const int c = col0 + bj * HALF;
                    const u32x4 gw = *(const u32x4*)(P + r * NP + PC_GB + c);
                    const f32x4 t0 = *(const f32x4*)(T + r * D + c), t1 = *(const f32x4*)(T + r * D + c + 4);
                    f32x4 v0 = acc[ai][bj][m][0], v1 = acc[ai][bj][m][1];
                    v0[0] = t0[0] + v0[0] * bflo(gw.x); v0[1] = t0[1] + v0[1] * bfhi(gw.x); v0[2] = t0[2] + v0[2] * bflo(gw.y); v0[3] = t0[3] + v0[3] * bfhi(gw.y);
                    v1[0] = t1[0] + v1[0] * bflo(gw.z); v1[1] = t1[1] + v1[1] * bfhi(gw.z); v1[2] = t1[2] + v1[2] * bflo(gw.w); v1[3] = t1[3] + v1[3] * bfhi(gw.w);
                    u32x4 w; w.x = cvt_pk_bf16(v0[0], v0[1]); w.y = cvt_pk_bf16(v0[2], v0[3]); w.z = cvt_pk_bf16(v1[0], v1[1]); w.w = cvt_pk_bf16(v1[2], v1[3]);
                    *(u32x4*)(U + r * D + c) = w; } }
    }
};
struct EpiRes {
    static constexpr bool PERM = false;
    const float* xin_lat; const float* xin_ctx; float* XO; const float* gate;
    __device__ __forceinline__ void operator()(AccRef acc, const Unit& u, int wr, int wc, int fr, int fq) const {
        const int row0 = u.orow + wr * 64 + fr, col0 = u.ocol + wc * 32 + 4 * fq;
        const int mr = u.orow < ML ? (u.orow >> 11) : 8;
        const float* gp = gate + (size_t)mr * 6144 + col0;
        f32x4 gv[2][2];
#pragma unroll
        for (int bj = 0; bj < 2; ++bj)
#pragma unroll
            for (int n = 0; n < 2; ++n) gv[bj][n] = *(const f32x4*)(gp + bj * HALF + n * 16);
        const float* xb = u.orow < ML ? xin_lat : xin_ctx - (size_t)ML * D;
#pragma unroll
        for (int ai = 0; ai < 2; ++ai)
#pragma unroll
            for (int m = 0; m < 4; ++m) { const size_t r = (size_t)(row0 + ai * HALF + m * 16);
#pragma unroll
                for (int bj = 0; bj < 2; ++bj)
#pragma unroll
                    for (int n = 0; n < 2; ++n) { const int c = col0 + bj * HALF + n * 16;
                        const f32x4 xi = *(const f32x4*)(xb + r * D + c);
                        *(f32x4*)(XO + r * D + c) = xi + gv[bj][n] * acc[ai][bj][m][n]; } }
    }
};
struct EpiF32 {
    static constexpr bool PERM = false;
    float* Y;
    __device__ __forceinline__ void operator()(AccRef acc, const Unit& u, int wr, int wc, int fr, int fq) const {
        const int row0 = u.orow + wr * 64 + fr, col0 = u.ocol + wc * 32 + 4 * fq;
#pragma unroll
        for (int ai = 0; ai < 2; ++ai)
#pragma unroll
            for (int m = 0; m < 4; ++m) { const size_t r = (size_t)(row0 + ai * HALF + m * 16);
#pragma unroll
                for (int bj = 0; bj < 2; ++bj)
#pragma unroll
                    for (int n = 0; n < 2; ++n) *(f32x4*)(Y + r * D + col0 + bj * HALF + n * 16) = acc[ai][bj][m][n]; }
    }
};
struct EpiSwiglu {
    static constexpr bool PERM = false;
    bf16* ACT; int ldf;
    __device__ __forceinline__ void operator()(AccRef acc, const Unit& u, int wr, int wc, int fr, int fq) const {
        const int row0 = u.orow + wr * 64 + fr, f0 = (u.ocol >> 1) + wc * 16 + 4 * fq;
#pragma unroll
        for (int ai = 0; ai < 2; ++ai)
#pragma unroll
            for (int m = 0; m < 4; ++m) { const size_t r = (size_t)(row0 + ai * HALF + m * 16);
#pragma unroll
                for (int bj = 0; bj < 2; ++bj) { const f32x4 a = acc[ai][bj][m][0], b = acc[ai][bj][m][1]; f32x4 o;
#pragma unroll
                    for (int j = 0; j < 4; ++j) o[j] = a[j] * sigmoidf_(a[j]) * b[j];
                    u32x2 w; w.x = cvt_pk_bf16(o[0], o[1]); w.y = cvt_pk_bf16(o[2], o[3]);
                    *(u32x2*)(ACT + r * ldf + f0 + bj * 64) = w; } }
    }
};
}

#define XB_TMO      128
#define XB_XCNT(j)  (256  + 64 * (j))
#define XB_XSUB(j)  (1280 + 64 * (j))
#define XB_XGEN(j)  (2304 + 64 * (j))
#define XB_TOP      3328
#define XB_TOPGEN   3392
#define XCD_BAR_WORDS 3456
#define XB_SPIN_CAP (1u << 18)
__device__ __forceinline__ unsigned xb_ld(unsigned* p)              { return __hip_atomic_load(p, __ATOMIC_RELAXED, __HIP_MEMORY_SCOPE_AGENT); }
__device__ __forceinline__ unsigned xb_add(unsigned* p, unsigned v) { return __hip_atomic_fetch_add(p, v, __ATOMIC_RELAXED, __HIP_MEMORY_SCOPE_AGENT); }
__device__ __forceinline__ unsigned xb_xcc_id() { return (unsigned)__builtin_amdgcn_s_getreg((3 << 11) | 20) & 0xFu; }
#define XB_SPIN(cond, bar) do { unsigned _sp = 0; while (cond) { __builtin_amdgcn_s_sleep(1); \
    if ((++_sp & 255u) == 0u) { if (xb_ld(&(bar)[XB_TMO])) break; if (_sp > XB_SPIN_CAP) { atomicAdd(&(bar)[XB_TMO], 1u); break; } } } } while (0)
struct XcdBarrier { unsigned* bar; unsigned x; volatile LAS unsigned* st; };
__device__ __forceinline__ XcdBarrier xcd_barrier_post(unsigned* bar, volatile LAS unsigned* st) {
    XcdBarrier b; b.bar = bar; b.x = xb_xcc_id(); b.st = st;
    if (threadIdx.x == 0) (void)xb_add(&bar[XB_XCNT(b.x)], 1u);
    return b;
}
__device__ __forceinline__ void xcd_barrier_complete(unsigned* bar, unsigned x, unsigned& nloc, unsigned& nx) {
    const unsigned G = gridDim.x * gridDim.y * gridDim.z;
    unsigned sum, cnt, mine, sp = 0u;
    for (;;) {
        sum = 0u; cnt = 0u; mine = 0u;
#pragma unroll
        for (unsigned j = 0; j < 16; ++j) { const unsigned c = xb_ld(&bar[XB_XCNT(j)]); sum += c; cnt += (c > 0u) ? 1u : 0u; mine = (j == x) ? c : mine; }
        if (sum == G) break;
        __builtin_amdgcn_s_sleep(1);
        if ((++sp & 255u) == 0u) { if (xb_ld(&bar[XB_TMO])) break; if (sp > XB_SPIN_CAP) { atomicAdd(&bar[XB_TMO], 1u); break; } }
    }
    nloc = mine > 0u ? mine : 1u; nx = cnt > 0u ? cnt : 1u;
}
__device__ __forceinline__ void xcd_barrier(const XcdBarrier& b) {
    asm volatile("s_waitcnt vmcnt(0)" ::: "memory");
    __syncthreads();
    if (threadIdx.x == 0) {
        unsigned* bar = b.bar;
        __builtin_amdgcn_s_waitcnt(0);
        unsigned nloc = b.st[0], nx = b.st[1];
        if (nloc == 0u) { xcd_barrier_complete(bar, b.x, nloc, nx); b.st[0] = nloc; b.st[1] = nx; }
        const unsigned old = xb_add(&bar[XB_XSUB(b.x)], 1u);
        const unsigned gen = old / nloc;
        if (old + 1u == (gen + 1u) * nloc) {
            __builtin_amdgcn_fence(__ATOMIC_RELEASE, "agent");
            asm volatile("s_waitcnt vmcnt(0)" ::: "memory");
            const unsigned og = xb_add(&bar[XB_TOP], 1u);
            const unsigned tg = og / nx;
            if (og + 1u == (tg + 1u) * nx) xb_add(&bar[XB_TOPGEN], 1u);
            else XB_SPIN(xb_ld(&bar[XB_TOPGEN]) == tg, bar);
            __builtin_amdgcn_fence(__ATOMIC_ACQUIRE, "agent");
            xb_add(&bar[XB_XGEN(b.x)], 1u);
            asm volatile("s_waitcnt vmcnt(0)" ::: "memory");
        } else {
            XB_SPIN(xb_ld(&bar[XB_XGEN(b.x)]) == gen, bar);
            __builtin_amdgcn_fence(__ATOMIC_ACQUIRE, "agent");
            asm volatile("s_waitcnt vmcnt(0)" ::: "memory");
        }
    }
    __syncthreads();
}

struct Args { const float* in[24]; float* out; unsigned char* ws; int ph_lo, ph_hi; };
typedef const __attribute__((address_space(4))) Args* KArgs;
__device__ __forceinline__ KArgs KA() { KArgs p = (KArgs)__builtin_amdgcn_kernarg_segment_ptr(); asm volatile("" : "+s"(p)); return p; }
struct Ctx {
    LAS unsigned char* lds; int tid, lane, wave, G, vcu;
    const float* const* dummy;
};

__device__ __forceinline__ void phase_pre(KArgs a, LAS unsigned char* lds) {
    const int tid = TID(), G = GRD();
    LAS float* sv = (LAS float*)lds;
    LAS float* red = sv + 9 * 1024;
    const float* c = a->in[1]; const float* cc = a->in[3]; const float* w_mod = a->in[4]; const float* b_mod = a->in[5];
    float* MOD = (float*)(a->ws + WS_MOD);
    for (int i = tid; i < 9 * 1024; i += 512) { const int r = i >> 10, k = i & 1023; const float v = r < 8 ? c[r * 1024 + k] : cc[k]; sv[i] = v * sigmoidf_(v); }
    __syncthreads();
    for (int item = BID(); item < DEPTH * 48; item += G) {
        const int l = item / 48, n0 = (item % 48) * 128, kq = tid >> 7, cl = tid & 127;
        float acc[9];
#pragma unroll
        for (int r = 0; r < 9; ++r) acc[r] = 0.f;
        const float* w = w_mod + ((size_t)l * 1024 + kq * 256) * 6144 + n0 + cl;
#pragma unroll 4
        for (int k = 0; k < 256; ++k) { const float wv = w[(size_t)k * 6144];
#pragma unroll
            for (int r = 0; r < 9; ++r) acc[r] += sv[r * 1024 + kq * 256 + k] * wv; }
#pragma unroll
        for (int r = 0; r < 9; ++r) red[(kq * 9 + r) * 128 + cl] = acc[r];
        __syncthreads();
        for (int o = tid; o < 9 * 128; o += 512) { const int r = o >> 7, q = o & 127;
            const float s = red[(0 * 9 + r) * 128 + q] + red[(1 * 9 + r) * 128 + q] + red[(2 * 9 + r) * 128 + q] + red[(3 * 9 + r) * 128 + q] + b_mod[l * 6144 + n0 + q];
            MOD[(size_t)(l * 9 + r) * 6144 + n0 + q] = s; }
        __syncthreads();
    }
}

__device__ __forceinline__ void tr_item(const float* srcA, const float* srcB, int ld, bf16* dst, int K, int drow0, int k0, LAS float* scr, int lane) {
    const int nl = lane & 31; const float* s = nl < 16 ? srcA + nl : srcB + (nl - 16);
#pragma unroll 8
    for (int i = 0; i < 32; ++i) { const int kk = 2 * i + (lane >> 5); scr[kk * 33 + nl] = s[(size_t)(k0 + kk) * ld]; }
    LDS_WAIT(); asm volatile("" ::: "memory");
    const int c = lane & 7;
#pragma unroll
    for (int j = 0; j < 4; ++j) { const int n = (lane >> 3) + 8 * j; const LAS float* p = scr + (8 * c) * 33 + n;
        u32x4 o; o.x = pk2(p[0 * 33], p[1 * 33]); o.y = pk2(p[2 * 33], p[3 * 33]); o.z = pk2(p[4 * 33], p[5 * 33]); o.w = pk2(p[6 * 33], p[7 * 33]);
        *(u32x4*)(dst + (size_t)(drow0 + n) * K + k0 + 8 * c) = o; }
    LDS_WAIT(); asm volatile("" ::: "memory");
}
__device__ __forceinline__ void convert_layer(KArgs a, LAS unsigned char* lds, int l) {
    const int lane = TID() & 63, wave = TID() >> 6;
    LAS float* scr = (LAS float*)(lds + wave * 8704);
    const int gw = BID() * 8 + wave, NGW = GRD() * 8;
    bf16* WIN = (bf16*)(a->ws + WS_WIN); bf16* WBRA = (bf16*)(a->ws + WS_WBRA); bf16* WBRB = (bf16*)(a->ws + WS_WBRB); bf16* WOUT = (bf16*)(a->ws + WS_WOUT);
    bf16* W13 = (bf16*)(a->ws + WS_W13); bf16* W2 = (bf16*)(a->ws + WS_W2);
    const float* w_in = a->in[8] + (size_t)l * D * DIN;
    const float* wbra = a->in[13] + (size_t)l * D * D; const float* wbrb = a->in[14] + (size_t)l * D * D; const float* wout = a->in[15] + (size_t)l * D * D;
    const int j = l >> 1; const bool moe = l & 1;
    constexpr int I_IN = 16 * 256, I_SQ = 16 * 32;
    constexpr int I_D13 = 16 * (2 * FF / 32), I_D2 = (FF / 64) * 32;
    constexpr int I_E13 = 16 * (2 * FFE / 32), I_E2 = (FFE / 64) * 32;
    const int n_ffn = moe ? NE * (I_E13 + I_E2) : (I_D13 + I_D2);
    const int total = I_IN + 3 * I_SQ + n_ffn;
    for (int it = gw; it < total; it += NGW) {
        int r = it;
        if (r < I_IN) { const int kb = r >> 8, nb = r & 255, n0 = nb * 32, sc = n0 < 3072 ? n0 : n0 + 16; tr_item(w_in + sc, w_in + sc + 16, DIN, WIN, D, n0, kb * 64, scr, lane); continue; } r -= I_IN;
        if (r < I_SQ) { const int kb = r >> 5, nb = r & 31; tr_item(wbra + nb * 32, wbra + nb * 32 + 16, D, WBRA, D, nb * 32, kb * 64, scr, lane); continue; } r -= I_SQ;
        if (r < I_SQ) { const int kb = r >> 5, nb = r & 31; tr_item(wbrb + nb * 32, wbrb + nb * 32 + 16, D, WBRB, D, nb * 32, kb * 64, scr, lane); continue; } r -= I_SQ;
        if (r < I_SQ) { const int kb = r >> 5, nb = r & 31; tr_item(wout + nb * 32, wout + nb * 32 + 16, D, WOUT, D, nb * 32, kb * 64, scr, lane); continue; } r -= I_SQ;
        if (!moe) {
            const float* w1 = a->in[16] + (size_t)j * D * FF; const float* w3 = a->in[17] + (size_t)j * D * FF; const float* w2 = a->in[18] + (size_t)j * FF * D;
            if (r < I_D13) { constexpr int NBK = 2 * FF / 32; const int kb = r / NBK, nb = r % NBK; tr_item(w1 + nb * 16, w3 + nb * 16, FF, W13, D, nb * 32, kb * 64, scr, lane); continue; } r -= I_D13;
            { const int kb = r >> 5, nb = r & 31; tr_item(w2 + nb * 32, w2 + nb * 32 + 16, D, W2, FF, nb * 32, kb * 64, scr, lane); }
        } else {
            const int e = r / (I_E13 + I_E2); r -= e * (I_E13 + I_E2);
            const float* w1 = a->in[20] + ((size_t)j * NE + e) * D * FFE; const float* w3 = a->in[21] + ((size_t)j * NE + e) * D * FFE; const float* w2 = a->in[22] + ((size_t)j * NE + e) * FFE * D;
            if (r < I_E13) { constexpr int NBK = 2 * FFE / 32; const int kb = r / NBK, nb = r % NBK; tr_item(w1 + nb * 16, w3 + nb * 16, FFE, W13 + (size_t)e * 2 * FFE * D, D, nb * 32, kb * 64, scr, lane); continue; } r -= I_E13;
            { const int kb = r >> 5, nb = r & 31; tr_item(w2 + nb * 32, w2 + nb * 32 + 16, D, W2 + (size_t)e * D * FFE, FFE, nb * 32, kb * 64, scr, lane); }
        }
    }
}

struct MoeCum { int cum[NE]; };
__device__ __forceinline__ void load_tile_prefix(const unsigned* cnt, int (&cum)[NE + 1]) {
    int acc = 0;
#pragma unroll
    for (int e = 0; e < NE; ++e) { cum[e] = acc; const int c = (int)__hip_atomic_load(cnt + e, __ATOMIC_RELAXED, __HIP_MEMORY_SCOPE_AGENT); acc += (c + 255) >> 8; }
    cum[NE] = acc;
}
__device__ __forceinline__ void moe_combine_row(KArgs a, int lm  , int row, int lane, f32x4 (&v)[4]) {
    const unsigned* cnt = (const unsigned*)(a->ws + WS_CTL) + CW_CNT + (lm >> 1) * 64;
    const int* RTI = (const int*)(a->ws + WS_RTI); const float* RTW = (const float*)(a->ws + WS_RTW); const float* YS = (const float*)(a->ws + WS_YS);
    const float* MOD = (const float*)(a->ws + WS_MOD);
    const int e0 = RTI[row * 4 + 0], r0 = RTI[row * 4 + 1], e1 = RTI[row * 4 + 2], r1 = RTI[row * 4 + 3];
    const float w0 = RTW[row * 2 + 0], w1 = RTW[row * 2 + 1];
    int c0 = 0, c1 = 0, accp = 0;
#pragma unroll
    for (int e = 0; e < NE; ++e) { const int c = (int)__hip_atomic_load(cnt + e, __ATOMIC_RELAXED, __HIP_MEMORY_SCOPE_AGENT); c0 = (e == e0) ? accp : c0; c1 = (e == e1) ? accp : c1; accp += (c + 255) >> 8; }
    const size_t s0 = (size_t)c0 * 256 + r0, s1 = (size_t)c1 * 256 + r1;
    const int mr = row < ML ? (row >> 11) : 8;
    const float* g2 = MOD + (size_t)(lm * 9 + mr) * 6144 + 5120;
#pragma unroll
    for (int j = 0; j < 4; ++j) { const int col = 4 * lane + 256 * j;
        const f32x4 y0 = *(const f32x4*)(YS + s0 * D + col), y1 = *(const f32x4*)(YS + s1 * D + col), g = *(const f32x4*)(g2 + col);
        v[j] = v[j] + g * (y0 * w0 + y1 * w1); }
}

__device__ __forceinline__ void phase_n1(KArgs a, LAS unsigned char* lds, int l) {
    const int tid = TID(), lane = tid & 63, wave = tid >> 6;
    LAS float* gwt = (LAS float*)lds;
    const float* w_in = a->in[8] + (size_t)l * D * DIN;
    __syncthreads();
    for (int i = tid; i < 16 * 1024; i += 512) { const int k = i >> 4, g = i & 15; gwt[g * 1024 + k] = w_in[(size_t)k * DIN + 3072 + g]; }
    __syncthreads();
    const float* MOD = (const float*)(a->ws + WS_MOD); float* XR = (float*)(a->ws + WS_XR); bf16* H = (bf16*)(a->ws + WS_H); float* GPRE = (float*)(a->ws + WS_GPRE);
    const float* g1 = a->in[6] + l * D; const float* gb = a->in[10] + l * 16;
    const bool combine = (l > 0) && ((l - 1) & 1);
    const int gw = BID() * 8 + wave, NGW = GRD() * 8;
    for (int row = gw; row < MROWS; row += NGW) {
        const float* xp = (l == 0) ? (row < ML ? a->in[0] + (size_t)row * D : a->in[2] + (size_t)(row - ML) * D) : XR + (size_t)row * D;
        f32x4 v[4]; float ss = 0.f;
#pragma unroll
        for (int j = 0; j < 4; ++j) v[j] = *(const f32x4*)(xp + 4 * lane + 256 * j);
        if (combine) { moe_combine_row(a, l - 1, row, lane, v);
#pragma unroll
            for (int j = 0; j < 4; ++j) *(f32x4*)(XR + (size_t)row * D + 4 * lane + 256 * j) = v[j]; }
#pragma unroll
        for (int j = 0; j < 4; ++j) ss += (v[j].x * v[j].x + v[j].y * v[j].y) + (v[j].z * v[j].z + v[j].w * v[j].w);
        const float rstd = rsqrtf(wave_sum(ss) * (1.f / D) + EPS);
        const int mr = row < ML ? (row >> 11) : 8; const float* mp = MOD + (size_t)(l * 9 + mr) * 6144;
        f32x4 h[4];
#pragma unroll
        for (int j = 0; j < 4; ++j) { const int col = 4 * lane + 256 * j; const f32x4 g = *(const f32x4*)(g1 + col), sh = *(const f32x4*)(mp + col), sc = *(const f32x4*)(mp + 1024 + col);
            h[j] = (v[j] * rstd * g) * (sc + 1.f) + sh;
            u32x2 w; w.x = pk2(h[j].x, h[j].y); w.y = pk2(h[j].z, h[j].w); *(u32x2*)(H + (size_t)row * D + col) = w; }
        float mine = 0.f;
#pragma unroll 1
        for (int g = 0; g < 16; ++g) { float s = 0.f;
#pragma unroll
            for (int j = 0; j < 4; ++j) { const f32x4 w4 = *(const LAS f32x4*)(gwt + g * 1024 + 256 * j + 4 * lane); s += (h[j].x * w4.x + h[j].y * w4.y) + (h[j].z * w4.z + h[j].w * w4.w); }
            s = wave_sum(s); mine = (lane == g) ? s : mine; }
        if (lane < 16) GPRE[(size_t)row * 16 + lane] = mine + gb[lane];
    }
}

__device__ __forceinline__ void phase_prep(KArgs a, int l) {
    const bf16* P = (const bf16*)(a->ws + WS_P); bf16* QK = (bf16*)(a->ws + WS_QK);
    const float* cw = a->in[9] + (size_t)l * 3 * 1024;
    const int gt = BID() * 512 + TID(), NT = GRD() * 512;
    for (int it = gt; it < MROWS * 64; it += NT) {
        const int row = it >> 6, i = it & 63;
        const bool lat = row < ML; const int t = lat ? (row & (TL - 1)) : ((row - ML) & (TC - 1)); const int T = lat ? TL : TC;
        const int ii = i & 31; const int dbase = (i < 32) ? ii : 64 + ii;
        float cs = 1.f, sn = 0.f;
        if (lat) { const float pos = (i < 32) ? (float)(t >> 6) : (float)(t & 63); const float inv = 1.0f / powf(10000.0f, (float)ii / 32.0f); const float ang = pos * inv; sincosf(ang, &sn, &cs); }
        const bool hp = t > 0, hn = t < T - 1;
#pragma unroll
        for (int qk = 0; qk < 2; ++qk)
#pragma unroll
            for (int h = 0; h < 4; ++h) { const int c1 = qk * 512 + h * 128 + dbase, c2 = c1 + 32;
                float u1 = cw[1024 + c1] * bf2f(P[(size_t)row * NP + c1]), u2 = cw[1024 + c2] * bf2f(P[(size_t)row * NP + c2]);
                if (hp) { u1 += cw[c1] * bf2f(P[(size_t)(row - 1) * NP + c1]); u2 += cw[c2] * bf2f(P[(size_t)(row - 1) * NP + c2]); }
                if (hn) { u1 += cw[2048 + c1] * bf2f(P[(size_t)(row + 1) * NP + c1]); u2 += cw[2048 + c2] * bf2f(P[(size_t)(row + 1) * NP + c2]); }
                u1 = u1 * sigmoidf_(u1); u2 = u2 * sigmoidf_(u2);
                float o1 = u1 * cs - u2 * sn, o2 = u1 * sn + u2 * cs;
                if (qk) { o1 *= 0.08838834764831845f; o2 *= 0.08838834764831845f; }
                QK[(size_t)row * D + c1] = (bf16)f2bf(o1); QK[(size_t)row * D + c2] = (bf16)f2bf(o2); }
    }
}

__device__ __forceinline__ float log_sigmoid_(float x) { return fminf(x, 0.f) - log1pf(__expf(-fabsf(x))); }
__device__ __forceinline__ void phase_scan_naive(KArgs a, LAS unsigned char* lds, int l) {
    const int tid = TID(), lane = tid & 63;
    LAS float* q = (LAS float*)lds;
    LAS float* k = q + 64 * 129;
    LAS float* C = k + 64 * 129;
    LAS float* vv = C + 64 * 129;
    LAS float* S = vv + 64 * 65;
    LAS float* nv = S + 64 * 65;
    LAS float* sc = nv + 128;
    LAS float* bL = sc, *igL = sc + 64, *mrowL = sc + 128, *wintL = sc + 192, *wkL = sc + 256, *denL = sc + 320, *misc = sc + 384;
    const bf16* P = (const bf16*)(a->ws + WS_P); const bf16* QK = (const bf16*)(a->ws + WS_QK); const float* GPRE = (const float*)(a->ws + WS_GPRE);
    float* HS = (float*)(a->ws + WS_HS);
    for (int unit = BID(); unit < 256; unit += GRD()) {
        const int b = unit >> 5, h = (unit >> 3) & 3, dir = (unit >> 2) & 1, vs = unit & 3;
        __syncthreads();
        for (int i = tid; i < 64 * 129; i += 512) C[i] = 0.f;
        if (tid < 128) nv[tid] = 0.f;
        if (tid == 0) misc[0] = 0.f;
        __syncthreads();
        for (int step = 0; step < 36; ++step) {
            const bool isc = step < 4; const int jj = isc ? step : step - 4; const int T = isc ? TC : TL; const int rbase = isc ? ML + b * TC : b * TL;
#define ROWOF(li) (rbase + (dir ? (T - 1 - (64 * jj + (li))) : (64 * jj + (li))))
            for (int i = tid; i < 64 * 128; i += 512) { const int li = i >> 7, d = i & 127; const size_t r = (size_t)ROWOF(li);
                q[li * 129 + d] = bf2f(QK[r * D + h * 128 + d]); k[li * 129 + d] = bf2f(QK[r * D + 512 + h * 128 + d]); }
            for (int i = tid; i < 64 * 64; i += 512) { const int li = i >> 6, v = i & 63; const size_t r = (size_t)ROWOF(li); vv[li * 65 + v] = bf2f(P[r * NP + PC_V + h * 256 + vs * 64 + v]); }
            if (tid < 64) {
                const size_t r = (size_t)ROWOF(lane);
                const float ig = GPRE[r * 16 + (2 * dir) * 4 + h]; const float fg = log_sigmoid_(GPRE[r * 16 + (2 * dir + 1) * 4 + h]);
                float bb = fg;
#pragma unroll
                for (int o = 1; o < 64; o <<= 1) { const float t2 = __shfl_up(bb, o); if (lane >= o) bb += t2; }
                float am = ig - bb;
#pragma unroll
                for (int o = 1; o < 64; o <<= 1) { const float t2 = __shfl_up(am, o); if (lane >= o) am = fmaxf(am, t2); }
                const float m = misc[0];
                const float mrow = bb + fmaxf(m, am);
                const float blast = __shfl(bb, 63);
                const float g = blast - bb + ig;
                const float gmax = wave_max(g);
                const float mnew = fmaxf(blast + m, gmax);
                bL[lane] = bb; igL[lane] = ig; mrowL[lane] = mrow; wintL[lane] = __expf(bb + m - mrow); wkL[lane] = __expf(g - mnew);
                if (lane == 0) { misc[1] = __expf(blast + m - mnew); misc[2] = mnew; }
            }
            __syncthreads();
            for (int it = 0; it < 8; ++it) { const int s = tid & 63, li = (tid >> 6) + 8 * it; float dot = 0.f;
                if (s <= li) {
#pragma unroll 8
                    for (int d = 0; d < 128; ++d) dot += q[li * 129 + d] * k[s * 129 + d];
                    dot *= __expf(bL[li] - bL[s] + igL[s] - mrowL[li]); }
                S[li * 65 + s] = dot; }
            __syncthreads();
            if (tid < 64) { float di = 0.f, dn = 0.f;
                for (int s = 0; s < 64; ++s) di += S[tid * 65 + s];
                for (int d = 0; d < 128; ++d) dn += nv[d] * q[tid * 129 + d];
                const float den = di + wintL[tid] * dn; denL[tid] = fmaxf(fabsf(den), __expf(-mrowL[tid])); }
            __syncthreads();
            for (int it = 0; it < 8; ++it) { const int v = tid & 63, li = (tid >> 6) + 8 * it; float n1 = 0.f, n2 = 0.f;
#pragma unroll 8
                for (int s = 0; s < 64; ++s) n1 += S[li * 65 + s] * vv[s * 65 + v];
#pragma unroll 8
                for (int d = 0; d < 128; ++d) n2 += C[v * 129 + d] * q[li * 129 + d];
                const float num = n1 + wintL[li] * n2;
                HS[((size_t)dir * MROWS + ROWOF(li)) * D + h * 256 + vs * 64 + v] = num / denL[li]; }
            __syncthreads();
            { const float decay = misc[1];
              for (int it = 0; it < 16; ++it) { const int d = tid & 127, v = (tid >> 7) + 4 * it; float s2 = 0.f;
#pragma unroll 8
                  for (int li = 0; li < 64; ++li) s2 += wkL[li] * vv[li * 65 + v] * k[li * 129 + d];
                  C[v * 129 + d] = decay * C[v * 129 + d] + s2; }
              if (tid < 128) { float s2 = 0.f; for (int li = 0; li < 64; ++li) s2 += wkL[li] * k[li * 129 + tid]; nv[tid] = decay * nv[tid] + s2; }
            }
            __syncthreads();
            if (tid == 0) misc[0] = misc[2];
            __syncthreads();
#undef ROWOF
        }
    }
}

__device__ __forceinline__ void phase_na_naive(KArgs a, int l, bool last) {
    const int lane = TID() & 63, wave = TID() >> 6;
    const bf16* P = (const bf16*)(a->ws + WS_P); bf16* HB = (bf16*)(a->ws + WS_HB);
    const float* rpb = a->in[12] + (size_t)l * 16 * 15 * 31;
    const int gw = BID() * 8 + wave, NGW = GRD() * 8;
    const int nitems = (last ? ML : MROWS) * 16;
    for (int item = gw; item < nitems; item += NGW) {
        int h, row;
        if (item < ML * 16) { h = item >> 14; row = item & (ML - 1); } else { const int r2 = item - ML * 16; h = r2 >> 11; row = ML + (r2 & (MC - 1)); }
        const bool lat = row < ML;
        const int b = lat ? (row >> 11) : ((row - ML) >> 8);
        const int t = lat ? (row & (TL - 1)) : 0;
        const int qr = t >> 6, qc = t & 63;
        const int rs = min(max(qr - 4, 0), 24), cs = min(max(qc - 8, 0), 48);
        float q[64];
        { const u32x4* qp = (const u32x4*)(P + (size_t)row * NP + PC_NQ + h * 64);
#pragma unroll
          for (int i = 0; i < 8; ++i) { const u32x4 w = qp[i]; q[8 * i + 0] = bflo(w.x); q[8 * i + 1] = bfhi(w.x); q[8 * i + 2] = bflo(w.y); q[8 * i + 3] = bfhi(w.y); q[8 * i + 4] = bflo(w.z); q[8 * i + 5] = bfhi(w.z); q[8 * i + 6] = bflo(w.w); q[8 * i + 7] = bfhi(w.w); } }
        float s[6];
#pragma unroll
        for (int i = 0; i < 6; ++i) {
            int krow; float bias = 0.f; bool valid = true;
            if (i < 2) { const int li = lane + 64 * i; const int kr = rs + (li >> 4), kc = cs + (li & 15); krow = b * TL + kr * 64 + kc; valid = lat;
                bias = rpb[(h * 15 + (kr - qr + 7)) * 31 + (kc - qc + 15)]; }
            else { krow = ML + b * TC + lane + 64 * (i - 2); }
            float dot = 0.f;
            if (valid) { const u32x4* kp = (const u32x4*)(P + (size_t)krow * NP + PC_NK + h * 64);
#pragma unroll
                for (int j = 0; j < 8; ++j) { const u32x4 w = kp[j];
                    dot += q[8 * j + 0] * bflo(w.x) + q[8 * j + 1] * bfhi(w.x) + q[8 * j + 2] * bflo(w.y) + q[8 * j + 3] * bfhi(w.y) + q[8 * j + 4] * bflo(w.z) + q[8 * j + 5] * bfhi(w.z) + q[8 * j + 6] * bflo(w.w) + q[8 * j + 7] * bfhi(w.w); }
                s[i] = dot + bias; }
            else s[i] = -3.0e38f;
        }
        float mx = s[0];
#pragma unroll
        for (int i = 1; i < 6; ++i) mx = fmaxf(mx, s[i]);
        mx = wave_max(mx);
        float sum = 0.f;
#pragma unroll
        for (int i = 0; i < 6; ++i) { s[i] = (s[i] > -1.0e38f) ? __expf(s[i] - mx) : 0.f; sum += s[i]; }
        sum = wave_sum(sum);
        float o = 0.f;
        const bf16* vb = P + PC_NV + h * 64 + lane;
        if (lat) {
#pragma unroll
            for (int i = 0; i < 2; ++i)
                for (int src = 0; src < 64; ++src) { const int li = src + 64 * i; const int kr = rs + (li >> 4), kc = cs + (li & 15); const size_t krow = (size_t)b * TL + kr * 64 + kc;
                    o += __shfl(s[i], src) * bf2f(vb[krow * NP]); }
        }
#pragma unroll
        for (int i = 2; i < 6; ++i)
            for (int src = 0; src < 64; ++src) { const size_t krow = (size_t)ML + b * TC + src + 64 * (i - 2); o += __shfl(s[i], src) * bf2f(vb[krow * NP]); }
        HB[(size_t)row * D + h * 64 + lane] = (bf16)f2bf(o / sum);
    }
}

__device__ __forceinline__ void phase_ln(KArgs a, int l, bool last) {
    const int lane = TID() & 63, wave = TID() >> 6;
    const float* HS = (const float*)(a->ws + WS_HS); const bf16* P = (const bf16*)(a->ws + WS_P); bf16* HA = (bf16*)(a->ws + WS_HA);
    const float* gh = a->in[11] + l * D;
    const int gw = BID() * 8 + wave, NGW = GRD() * 8; const int nrows = last ? ML : MROWS;
    for (int row = gw; row < nrows; row += NGW) {
#pragma unroll
        for (int j = 0; j < 4; ++j) { const int col = 4 * lane + 256 * j;
            const f32x4 y = *(const f32x4*)(HS + (size_t)row * D + col) + *(const f32x4*)(HS + ((size_t)MROWS + row) * D + col);
            const float mu = wave_sum((y.x + y.y) + (y.z + y.w)) * (1.f / 256.f);
            const f32x4 dlt = y - mu;
            const float var = wave_sum((dlt.x * dlt.x + dlt.y * dlt.y) + (dlt.z * dlt.z + dlt.w * dlt.w)) * (1.f / 256.f);
            const float rstd = rsqrtf(var + EPS);
            const f32x4 g = *(const f32x4*)(gh + col);
            const u32x2 ow = *(const u32x2*)(P + (size_t)row * NP + PC_O + col);
            const f32x4 so = (f32x4){bflo(ow.x), bfhi(ow.x), bflo(ow.y), bfhi(ow.y)};
            const f32x4 r = dlt * rstd * g * so;
            u32x2 w; w.x = pk2(r.x, r.y); w.y = pk2(r.z, r.w); *(u32x2*)(HA + (size_t)row * D + col) = w; }
    }
}

__device__ __forceinline__ void phase_n2(KArgs a, LAS unsigned char* lds, int l, bool last) {
    const int tid = TID(), lane = tid & 63, wave = tid >> 6;
    const bool moe = l & 1; const int jm = l >> 1;
    LAS float* rt = (LAS float*)lds;
    __syncthreads();
    if (moe) { const float* router = a->in[19] + (size_t)jm * D * NE;
        for (int i = tid; i < NE * 1024; i += 512) { const int k = i >> 3, e = i & 7; rt[e * 1024 + k] = router[(size_t)k * NE + e]; } }
    __syncthreads();
    const float* MOD = (const float*)(a->ws + WS_MOD); const float* XR = (const float*)(a->ws + WS_XR); bf16* H = (bf16*)(a->ws + WS_H); bf16* H2S = (bf16*)(a->ws + WS_H2S);
    int* RTI = (int*)(a->ws + WS_RTI); float* RTW = (float*)(a->ws + WS_RTW);
    unsigned* cnt = (unsigned*)(a->ws + WS_CTL) + CW_CNT + jm * 64;
    const float* g2 = a->in[7] + l * D;
    const int gw = BID() * 8 + wave, NGW = GRD() * 8; const int nrows = last ? ML : MROWS;
    for (int row = gw; row < nrows; row += NGW) {
        const float* xp = XR + (size_t)row * D;
        f32x4 v[4]; float ss = 0.f;
#pragma unroll
        for (int j = 0; j < 4; ++j) { v[j] = *(const f32x4*)(xp + 4 * lane + 256 * j); ss += (v[j].x * v[j].x + v[j].y * v[j].y) + (v[j].z * v[j].z + v[j].w * v[j].w); }
        const float rstd = rsqrtf(wave_sum(ss) * (1.f / D) + EPS);
        const int mr = row < ML ? (row >> 11) : 8; const float* mp = MOD + (size_t)(l * 9 + mr) * 6144;
        f32x4 h[4]; u32x2 hw[4];
#pragma unroll
        for (int j = 0; j < 4; ++j) { const int col = 4 * lane + 256 * j; const f32x4 g = *(const f32x4*)(g2 + col), sh = *(const f32x4*)(mp + 3072 + col), sc = *(const f32x4*)(mp + 4096 + col);
            h[j] = (v[j] * rstd * g) * (sc + 1.f) + sh; hw[j].x = pk2(h[j].x, h[j].y); hw[j].y = pk2(h[j].z, h[j].w); }
        if (!moe) {
#pragma unroll
            for (int j = 0; j < 4; ++j) *(u32x2*)(H + (size_t)row * D + 4 * lane + 256 * j) = hw[j];
        } else {
            float lg[NE];
#pragma unroll
            for (int e = 0; e < NE; ++e) { float s = 0.f;
#pragma unroll
                for (int j = 0; j < 4; ++j) { const f32x4 w4 = *(const LAS f32x4*)(rt + e * 1024 + 256 * j + 4 * lane); s += (h[j].x * w4.x + h[j].y * w4.y) + (h[j].z * w4.z + h[j].w * w4.w); }
                lg[e] = wave_sum(s); }
            int i0 = 0; float v0 = lg[0];
#pragma unroll
            for (int e = 1; e < NE; ++e) if (lg[e] > v0) { v0 = lg[e]; i0 = e; }
            int i1 = -1; float v1 = -3.0e38f;
#pragma unroll
            for (int e = 0; e < NE; ++e) if (e != i0 && lg[e] > v1) { v1 = lg[e]; i1 = e; }
            const float w0 = 1.f / (1.f + __expf(v1 - v0)), w1 = 1.f - w0;
            int r0 = 0, r1 = 0;
            if (lane == 0) { r0 = (int)__hip_atomic_fetch_add(cnt + i0, 1u, __ATOMIC_RELAXED, __HIP_MEMORY_SCOPE_AGENT); r1 = (int)__hip_atomic_fetch_add(cnt + i1, 1u, __ATOMIC_RELAXED, __HIP_MEMORY_SCOPE_AGENT); }
            r0 = __shfl(r0, 0); r1 = __shfl(r1, 0);
            if (lane == 0) { RTI[row * 4 + 0] = i0; RTI[row * 4 + 1] = r0; RTI[row * 4 + 2] = i1; RTI[row * 4 + 3] = r1; RTW[row * 2 + 0] = w0; RTW[row * 2 + 1] = w1; }
            bf16* d0 = H2S + ((size_t)i0 * ECAP + r0) * D; bf16* d1 = H2S + ((size_t)i1 * ECAP + r1) * D;
#pragma unroll
            for (int j = 0; j < 4; ++j) { *(u32x2*)(d0 + 4 * lane + 256 * j) = hw[j]; *(u32x2*)(d1 + 4 * lane + 256 * j) = hw[j]; }
        }
    }
}

__device__ __forceinline__ void phase_final(KArgs a) {
    const int lane = TID() & 63, wave = TID() >> 6;
    const float* XR = (const float*)(a->ws + WS_XR); const float* gf = a->in[23];
    const int gw = BID() * 8 + wave, NGW = GRD() * 8;
    for (int row = gw; row < ML; row += NGW) {
        f32x4 v[4]; float ss = 0.f;
#pragma unroll
        for (int j = 0; j < 4; ++j) v[j] = *(const f32x4*)(XR + (size_t)row * D + 4 * lane + 256 * j);
        moe_combine_row(a, DEPTH - 1, row, lane, v);
#pragma unroll
        for (int j = 0; j < 4; ++j) ss += (v[j].x * v[j].x + v[j].y * v[j].y) + (v[j].z * v[j].z + v[j].w * v[j].w);
        const float rstd = rsqrtf(wave_sum(ss) * (1.f / D) + EPS);
#pragma unroll
        for (int j = 0; j < 4; ++j) { const int col = 4 * lane + 256 * j; *(f32x4*)(a->out + (size_t)row * D + col) = v[j] * rstd * *(const f32x4*)(gf + col); }
    }
}

constexpr int PH_PER_LAYER = 10, N_PHASES = 2 + DEPTH * PH_PER_LAYER;
__global__ void __launch_bounds__(512, 2) fwd(Args args) {
    extern __shared__ __attribute__((aligned(16))) unsigned char lds_raw[];
    LAS unsigned char* lds = (LAS unsigned char*)lds_raw;
    const int tid = TID();
    volatile LAS unsigned* MISC = (volatile LAS unsigned*)(lds + MISC_OFF);
    for (int u = tid; u < (LDS_BYTES - MISC_OFF) / 4; u += 512) ((LAS unsigned*)(lds + MISC_OFF))[u] = 0u;
    __syncthreads();
    unsigned* ctl = (unsigned*)(KA()->ws + WS_CTL);
    const int lo = KA()->ph_lo, hi = KA()->ph_hi;
    XcdBarrier bar; bar.bar = ctl + CW_BAR; bar.x = 0; bar.st = nullptr;
    if (hi - lo > 1) bar = xcd_barrier_post(ctl + CW_BAR, MISC + 8);
#ifndef PH_MASK
#define PH_MASK 0xFFFFFFFFu
#endif
#define PM(b) ((PH_MASK >> (b)) & 1u)
#define IN(k) (lo <= (k) && (k) < hi)
#define SEAM(k) do { if (IN(k) && IN((k) + 1)) xcd_barrier(bar); } while (0)

    if (PM(0) && IN(0)) { phase_pre(KA(), lds); } SEAM(0);

    for (int l = 0; l < DEPTH; ++l) {
        const int pb = 1 + l * PH_PER_LAYER; const bool last = (l == DEPTH - 1); const bool moe = l & 1;
        const int Mrows = last ? ML : MROWS;
        const float* MODl = (const float*)(KA()->ws + WS_MOD) + (size_t)l * 9 * 6144;
        if (IN(pb + 0)) { if (PM(1)) convert_layer(KA(), lds, l); if (PM(2)) phase_n1(KA(), lds, l); } SEAM(pb + 0);
        if (PM(3) && IN(pb + 1)) { pg8::Gemm g{(const bf16*)(KA()->ws + WS_H), (const bf16*)(KA()->ws + WS_WIN), D}; pg8::StaticOrder S; S.init(MROWS, NP, GRD(), BID());
            pg8::EpiG1 E{(bf16*)(KA()->ws + WS_P)}; pg8::gemm_phase<pg8::EpiG1, pg8::StaticOrder, true, true>(lds, g, S, E); } SEAM(pb + 1);
        if (PM(4) && IN(pb + 2)) { phase_prep(KA(), l); } SEAM(pb + 2);
        if (IN(pb + 3)) { if (PM(5)) phase_scan_naive(KA(), lds, l); if (PM(6)) phase_na_naive(KA(), l, last); } SEAM(pb + 3);
        if (PM(7) && IN(pb + 4)) { phase_ln(KA(), l, last); } SEAM(pb + 4);
        if (PM(8) && IN(pb + 5)) {
            { pg8::Gemm g{(const bf16*)(KA()->ws + WS_HA), (const bf16*)(KA()->ws + WS_WBRA), D}; pg8::StaticOrder S; S.init(Mrows, D, GRD(), BID());
              pg8::EpiMGa E{(const bf16*)(KA()->ws + WS_P), (float*)(KA()->ws + WS_T32)}; pg8::gemm_phase<pg8::EpiMGa, pg8::StaticOrder, false, true>(lds, g, S, E); }
            { pg8::Gemm g{(const bf16*)(KA()->ws + WS_HB), (const bf16*)(KA()->ws + WS_WBRB), D}; pg8::StaticOrder S; S.init(Mrows, D, GRD(), BID());
              pg8::EpiMGb E{(const bf16*)(KA()->ws + WS_P), (const float*)(KA()->ws + WS_T32), (bf16*)(KA()->ws + WS_U)}; pg8::gemm_phase<pg8::EpiMGb, pg8::StaticOrder, false, true>(lds, g, S, E); }
        } SEAM(pb + 5);
        if (PM(9) && IN(pb + 6)) { pg8::Gemm g{(const bf16*)(KA()->ws + WS_U), (const bf16*)(KA()->ws + WS_WOUT), D}; pg8::StaticOrder S; S.init(Mrows, D, GRD(), BID());
            const float* xl = (l == 0) ? KA()->in[0] : (const float*)(KA()->ws + WS_XR); const float* xc = (l == 0) ? KA()->in[2] : (const float*)(KA()->ws + WS_XR) + (size_t)ML * D;
            pg8::EpiRes E{xl, xc, (float*)(KA()->ws + WS_XR), MODl + 2048}; pg8::gemm_phase<pg8::EpiRes, pg8::StaticOrder, false, true>(lds, g, S, E); } SEAM(pb + 6);
        if (PM(10) && IN(pb + 7)) { phase_n2(KA(), lds, l, last); } SEAM(pb + 7);
        if (!moe) {
            if (PM(11) && IN(pb + 8)) { pg8::Gemm g{(const bf16*)(KA()->ws + WS_H), (const bf16*)(KA()->ws + WS_W13), D}; pg8::StaticOrder S; S.init(Mrows, 2 * FF, GRD(), BID());
                pg8::EpiSwiglu E{(bf16*)(KA()->ws + WS_ACT), FF}; pg8::gemm_phase<pg8::EpiSwiglu, pg8::StaticOrder, true, true>(lds, g, S, E); } SEAM(pb + 8);
            if (PM(12) && IN(pb + 9)) { pg8::Gemm g{(const bf16*)(KA()->ws + WS_ACT), (const bf16*)(KA()->ws + WS_W2), FF}; pg8::StaticOrder S; S.init(Mrows, D, GRD(), BID());
                const float* xr = (const float*)(KA()->ws + WS_XR);
                pg8::EpiRes E{xr, xr + (size_t)ML * D, (float*)(KA()->ws + WS_XR), MODl + 5120}; pg8::gemm_phase<pg8::EpiRes, pg8::StaticOrder, false, true>(lds, g, S, E); } SEAM(pb + 9);
        } else {
            if (PM(13) && (IN(pb + 8) || IN(pb + 9))) {
                int cum[NE + 1]; load_tile_prefix((unsigned*)(KA()->ws + WS_CTL) + CW_CNT + (l >> 1) * 64, cum);
                pg8::MoeOrder S; S.G = GRD(); S.c = BID(); S.TT = __builtin_amdgcn_readfirstlane(cum[8]);
                S.c1 = __builtin_amdgcn_readfirstlane(cum[1]); S.c2 = __builtin_amdgcn_readfirstlane(cum[2]); S.c3 = __builtin_amdgcn_readfirstlane(cum[3]); S.c4 = __builtin_amdgcn_readfirstlane(cum[4]);
                S.c5 = __builtin_amdgcn_readfirstlane(cum[5]); S.c6 = __builtin_amdgcn_readfirstlane(cum[6]); S.c7 = __builtin_amdgcn_readfirstlane(cum[7]);
                if (IN(pb + 8)) { S.nN = 2 * FFE / 256; S.a_estride = ECAP; S.b_estride = 2 * FFE;
                    pg8::Gemm g{(const bf16*)(KA()->ws + WS_H2S), (const bf16*)(KA()->ws + WS_W13), D};
                    pg8::EpiSwiglu E{(bf16*)(KA()->ws + WS_ACT), FFE}; pg8::gemm_phase<pg8::EpiSwiglu, pg8::MoeOrder, true, true>(lds, g, S, E); }
                SEAM(pb + 8);
                if (IN(pb + 9)) { S.nN = D / 256; S.a_estride = 0; S.b_estride = D;
                    pg8::Gemm g{(const bf16*)(KA()->ws + WS_ACT), (const bf16*)(KA()->ws + WS_W2), FFE};
                    pg8::EpiF32 E{(float*)(KA()->ws + WS_YS)}; pg8::gemm_phase<pg8::EpiF32, pg8::MoeOrder, false, true>(lds, g, S, E); }
            }
            SEAM(pb + 9);
        }
    }
    if (PM(14) && IN(N_PHASES - 1)) phase_final(KA());
#undef IN
#undef SEAM
}

extern "C" void kernel_launch(void* const* d_in, const int* in_sizes, int n_in, void* d_out, int out_size, void* d_ws, size_t ws_size, hipStream_t stream) {
    static int grid = 0;
    if (grid == 0) {
        if (n_in != 24 || out_size != ML * D || ws_size < WS_END) { fprintf(stderr, "kernel_launch: unexpected shapes / workspace (%d inputs, out %d, ws %zu < %zu)\n", n_in, out_size, ws_size, (size_t)WS_END); grid = -1; return; }
        int dev = 0, cus = 0;
        if (hipGetDevice(&dev) != hipSuccess || hipDeviceGetAttribute(&cus, hipDeviceAttributeMultiprocessorCount, dev) != hipSuccess) { grid = -1; return; }
        if (hipFuncSetAttribute((const void*)fwd, hipFuncAttributeMaxDynamicSharedMemorySize, LDS_BYTES) != hipSuccess) { fprintf(stderr, "kernel_launch: hipFuncSetAttribute failed\n"); grid = -1; return; }
        int per_cu = 0; (void)hipOccupancyMaxActiveBlocksPerMultiprocessor(&per_cu, (const void*)fwd, 512, LDS_BYTES); (void)hipGetLastError();
        if (per_cu < 1) fprintf(stderr, "kernel_launch: occupancy query reports %d\n", per_cu);
        grid = cus;
    }
    if (grid < 0) return;
    (void)hipMemsetAsync((char*)d_ws + WS_CTL, 0, CTL_ZERO_BYTES, stream);
    Args a{};
    for (int i = 0; i < 24; ++i) a.in[i] = (const float*)d_in[i];
    a.out = (float*)d_out; a.ws = (unsigned char*)d_ws;
#if MK_PER_PHASE
    for (int p = 0; p < N_PHASES; ++p) { a.ph_lo = p; a.ph_hi = p + 1; hipLaunchKernelGGL(fwd, dim3(grid), dim3(512), LDS_BYTES, stream, a); }
#else
    a.ph_lo = 0; a.ph_hi = N_PHASES; hipLaunchKernelGGL(fwd, dim3(grid), dim3(512), LDS_BYTES, stream, a);
#endif
}
```

```cpp
#include <hip/hip_runtime.h>
#include <cstdio>
#include <cstdint>

#ifndef MK_PER_PHASE
#define MK_PER_PHASE 0
#endif

#define LAS __attribute__((address_space(3)))
typedef unsigned short bf16;
typedef short bf16x8 __attribute__((ext_vector_type(8)));
typedef float f32x4 __attribute__((ext_vector_type(4)));
typedef float f32x2 __attribute__((ext_vector_type(2)));
typedef unsigned u32x4 __attribute__((ext_vector_type(4)));
typedef unsigned u32x2 __attribute__((ext_vector_type(2)));

constexpr int D = 1024, NB = 8, TL = 2048, TC = 256, DEPTH = 4;
constexpr int ML = NB * TL, MC = NB * TC, MROWS = ML + MC;
constexpr int DIN = 8208, NP = 8192;
constexpr int PC_Q = 0, PC_K = 512, PC_V = 1024, PC_O = 2048, PC_NQ = 3072, PC_NK = 4096, PC_NV = 5120, PC_GA = 6144, PC_GB = 7168;
constexpr int FF = 2816, FFE = 3584, NE = 8;
constexpr int ECAP = MROWS;
constexpr int MOE_ROWS = 38912;
constexpr float EPS = 1e-6f;

constexpr size_t MiB = 1u << 20;
constexpr size_t WS_CTL = 0, CTL_ZERO_BYTES = 1 * MiB;
constexpr size_t WS_MOD = 1 * MiB;
constexpr size_t WS_RTI = 2 * MiB;
constexpr size_t WS_RTW = 2 * MiB + 512 * 1024;
constexpr size_t WS_GPRE = 3 * MiB;
constexpr size_t WS_XR = 5 * MiB;
constexpr size_t WS_H = 77 * MiB;
constexpr size_t WS_WIN = 113 * MiB;
constexpr size_t WS_WBRA = 129 * MiB, WS_WBRB = 131 * MiB, WS_WOUT = 133 * MiB;
constexpr size_t WS_W13 = 135 * MiB;
constexpr size_t WS_W2 = 247 * MiB;
constexpr size_t WS_GA = 303 * MiB;
constexpr size_t WS_P = WS_GA;
constexpr size_t WS_QK = WS_GA + 288 * MiB;
constexpr size_t WS_HS = WS_GA + 324 * MiB;
constexpr size_t WS_HB = WS_GA + 468 * MiB;
constexpr size_t WS_HA = WS_GA + 504 * MiB;
constexpr size_t WS_T32 = WS_GA + 540 * MiB;
constexpr size_t WS_U = WS_GA + 612 * MiB;
constexpr size_t WS_ACT = WS_GA;
constexpr size_t WS_H2S = WS_GA + 266 * MiB;
constexpr size_t WS_YS = WS_GA + 554 * MiB;
constexpr size_t WS_END = WS_GA + 706 * MiB;
static_assert((size_t)MOE_ROWS * FFE * 2 <= 266 * MiB && (size_t)NE * ECAP * D * 2 <= 288 * MiB && (size_t)MOE_ROWS * D * 4 <= 152 * MiB, "ffn view");

constexpr int CW_BAR = 4096;
constexpr int CW_CNT = 16384;

constexpr int RING_BYTES = 131072;
constexpr int LDS_BYTES = 147456;
constexpr int MISC_OFF = LDS_BYTES - 256;

__device__ __forceinline__ unsigned f2bf(float f) { unsigned u = __builtin_bit_cast(unsigned, f); return (u + 0x7fffu + ((u >> 16) & 1u)) >> 16; }
__device__ __forceinline__ unsigned pk2(float lo, float hi) { return f2bf(lo) | (f2bf(hi) << 16); }
__device__ __forceinline__ float bf2f(unsigned b) { return __builtin_bit_cast(float, b << 16); }
__device__ __forceinline__ float bflo(unsigned w) { return __builtin_bit_cast(float, w << 16); }
__device__ __forceinline__ float bfhi(unsigned w) { return __builtin_bit_cast(float, w & 0xffff0000u); }
__device__ __forceinline__ float sigmoidf_(float x) { return 1.f / (1.f + __expf(-x)); }
__device__ __forceinline__ float wave_sum(float v) {
#pragma unroll
    for (int o = 1; o < 64; o <<= 1) v += __shfl_xor(v, o);
    return v;
}
__device__ __forceinline__ float wave_max(float v) {
#pragma unroll
    for (int o = 1; o < 64; o <<= 1) v = fmaxf(v, __shfl_xor(v, o));
    return v;
}
__device__ __forceinline__ int TID() { int t = threadIdx.x; asm volatile("" : "+v"(t)); return t; }
__device__ __forceinline__ int BID() { int b = blockIdx.x; asm volatile("" : "+s"(b)); return b; }
__device__ __forceinline__ int GRD() { int g = gridDim.x; asm volatile("" : "+s"(g)); return g; }
#define LDS_WAIT() asm volatile("s_waitcnt lgkmcnt(0)" ::: "memory")

namespace pg8 {
constexpr int BM = 256, BK = 64, HALF = 128, HTB = HALF * BK * 2, STAGE_BYTES = 8 * HTB, NXCD = 8, WGM = 8;
__host__ __device__ __forceinline__ int lds_byte(int r, int c) { const int st = (r >> 4) * 2 + (c >> 5), rr = r & 15, cc = c & 31, ob = rr * 64 + cc * 2; return st * 1024 + (ob ^ (((ob >> 9) & 1) << 5)); }
__host__ __device__ __forceinline__ void stage_rc(int b, int& R, int& C) { const int st = b / 1024, sb = b % 1024, swz = sb ^ (((sb >> 9) & 1) << 5); R = (st >> 1) * 16 + swz / 64; C = (st & 1) * 32 + (swz % 64) / 2; }
__host__ __device__ __forceinline__ int perm32(int rho) { const int n = rho >> 4, i = rho & 15; return 8 * (i >> 2) + 4 * n + (i & 3); }

struct Unit { int arow, brow, orow, ocol, aux; };
struct Gemm { const bf16* A; const bf16* Bt; int K; };

struct StaticOrder {
    int nM, nN, nwg, G, c;
    __device__ void init(int M, int N, int G_, int c_) { nM = M / BM; nN = N / BM; nwg = nM * nN; G = G_; c = c_; }
    __device__ __forceinline__ bool next(int i, Unit& u) const {
        const long L = (long)i * G + c; if (L >= nwg) return false;
        int wgid = (int)L; { const int q = nwg / NXCD, r = nwg % NXCD, xcd = wgid % NXCD, off = wgid / NXCD; wgid = (xcd < r ? xcd * (q + 1) : r * (q + 1) + (xcd - r) * q) + off; }
        const int nig = WGM * nN, gid = wgid / nig, fm = gid * WGM, gsz = (nM - fm) < WGM ? (nM - fm) : WGM;
        const int pm = fm + ((wgid % nig) % gsz), pn = (wgid % nig) / gsz;
        u.arow = pm * BM; u.brow = pn * BM; u.orow = pm * BM; u.ocol = pn * BM; u.aux = 0; return true;
    }
};
struct MoeOrder {
    int nN, G, c, TT; int c1, c2, c3, c4, c5, c6, c7;
    int a_estride;
    int b_estride;
    __device__ __forceinline__ bool next(int i, Unit& u) const {
        const int nwg = TT * nN; const long L = (long)i * G + c; if (L >= nwg) return false;
        int wgid = (int)L; { const int q = nwg / NXCD, r = nwg % NXCD, xcd = wgid % NXCD, off = wgid / NXCD; wgid = (xcd < r ? xcd * (q + 1) : r * (q + 1) + (xcd - r) * q) + off; }
        const int nig = WGM * nN, gid = wgid / nig, fm = gid * WGM, gsz = (TT - fm) < WGM ? (TT - fm) : WGM;
        const int g = fm + ((wgid % nig) % gsz), pn = (wgid % nig) / gsz;
        const int e = (g >= c1) + (g >= c2) + (g >= c3) + (g >= c4) + (g >= c5) + (g >= c6) + (g >= c7);
        int cb = 0; cb = e >= 1 ? c1 : cb; cb = e >= 2 ? c2 : cb; cb = e >= 3 ? c3 : cb; cb = e >= 4 ? c4 : cb; cb = e >= 5 ? c5 : cb; cb = e >= 6 ? c6 : cb; cb = e >= 7 ? c7 : cb;
        const int rt = g - cb;
        u.arow = a_estride ? e * a_estride + rt * BM : g * BM; u.brow = e * b_estride + pn * BM; u.orow = g * BM; u.ocol = pn * BM; u.aux = e; return true;
    }
};

__device__ __forceinline__ unsigned cvt_pk_bf16(float lo, float hi) { unsigned r; asm volatile("v_cvt_pk_bf16_f32 %0, %1, %2" : "=v"(r) : "v"(lo), "v"(hi)); return r; }

template <class Epi, class Sched, bool ALIGN_EPI = false, bool SP2 = true>
__device__ __forceinline__ void gemm_phase(LAS unsigned char* lds, const Gemm g, const Sched& S, const Epi& E) {
    const int tid = TID(), wid = __builtin_amdgcn_readfirstlane(tid >> 6), lane = tid & 63, wr = wid >> 2, wc = wid & 3, fr = lane & 15, fq = lane >> 4;
    const int K = g.K, nt = K / BK;
    unsigned voffA[2], voffB[2];
#pragma unroll
    for (int i = 0; i < 2; ++i) { int R, C; stage_rc(tid * 16 + i * 8192, R, C); const int Rb = Epi::PERM ? ((R & ~31) + perm32(R & 31)) : R;
        voffA[i] = (unsigned)(R * K + C) * 2u; voffB[i] = (unsigned)(Rb * K + C) * 2u; }
    const size_t kstep = (size_t)(BK * 2);
    const size_t hstep = (size_t)HALF * K * 2;
    const size_t rstep = (size_t)K * 2;
    const unsigned ldsw = (unsigned)wid * 1024u;
    const int aoff = lds_byte(wr * 64 + fr, fq * 8), boff = lds_byte(wc * 32 + fr, fq * 8);
#define PG8_SA(b, h) (((b) * 2 + (h)) * HTB)
#define PG8_SB(b, h) ((4 + (b) * 2 + (h)) * HTB)
#define PG8_STAGE(bufoff, gbase, voff) do { _Pragma("unroll") for (int _i = 0; _i < 2; ++_i) \
        __builtin_amdgcn_global_load_lds((const unsigned*)((const char*)(gbase) + (voff)[_i]), (LAS unsigned*)(lds + (bufoff) + ldsw + _i * 8192), 16, 0, 0); } while (0)
#define PG8_LDA(dst, b, h) do { _Pragma("unroll") for (int m = 0; m < 4; ++m) _Pragma("unroll") for (int k = 0; k < 2; ++k) dst[m][k] = *(const LAS bf16x8*)(lds + PG8_SA(b, h) + aoff + m * 2048 + k * 1024); } while (0)
#define PG8_LDB(dst, b, h) do { _Pragma("unroll") for (int n = 0; n < 2; ++n) _Pragma("unroll") for (int k = 0; k < 2; ++k) dst[n][k] = *(const LAS bf16x8*)(lds + PG8_SB(b, h) + boff + n * 2048 + k * 1024); } while (0)
#define PG8_MMA(ai, bj, At, Bt) do { __builtin_amdgcn_s_setprio(1); _Pragma("unroll") for (int m = 0; m < 4; ++m) _Pragma("unroll") for (int n = 0; n < 2; ++n) _Pragma("unroll") for (int k = 0; k < 2; ++k) \
        acc[ai][bj][m][n] = __builtin_amdgcn_mfma_f32_16x16x32_bf16(Bt[n][k], At[m][k], acc[ai][bj][m][n], 0, 0, 0); __builtin_amdgcn_s_setprio(0); } while (0)
#define PG8_WAIT_V(n) asm volatile("s_waitcnt vmcnt(" #n ")" ::: "memory")
#define PG8_WAIT_L(n) asm volatile("s_waitcnt lgkmcnt(" #n ")" ::: "memory")
#define PG8_BAR __builtin_amdgcn_s_barrier()
#define PG8_SCHED __builtin_amdgcn_sched_barrier(0)
    Unit cur, nxt; int ui = 0;
    if (!S.next(0, cur)) return;
    f32x4 acc[2][2][4][2];
#pragma unroll
    for (int a = 0; a < 2; ++a)
#pragma unroll
        for (int b = 0; b < 2; ++b)
#pragma unroll
            for (int m = 0; m < 4; ++m)
#pragma unroll
                for (int n = 0; n < 2; ++n) acc[a][b][m][n] = (f32x4){0.f, 0.f, 0.f, 0.f};
    bf16x8 At[4][2], B0[2][2], B1[2][2];
    const char* cA = (const char*)g.A + (size_t)cur.arow * rstep; const char* cB = (const char*)g.Bt + (size_t)cur.brow * rstep;
    if constexpr (SP2) {
        PG8_STAGE(PG8_SB(0, 0), cB, voffB); PG8_STAGE(PG8_SB(0, 1), cB + hstep, voffB); PG8_STAGE(PG8_SA(0, 0), cA, voffA); PG8_STAGE(PG8_SA(0, 1), cA + hstep, voffA);
        if (wr == 1) PG8_BAR;
        PG8_WAIT_V(2); PG8_BAR;
        PG8_STAGE(PG8_SB(1, 0), cB + kstep, voffB); PG8_STAGE(PG8_SA(1, 0), cA + kstep, voffA); PG8_STAGE(PG8_SB(1, 1), cB + hstep + kstep, voffB);
        PG8_WAIT_V(6); PG8_BAR;
    } else {
        PG8_STAGE(PG8_SB(0, 0), cB, voffB); PG8_STAGE(PG8_SA(0, 0), cA, voffA); PG8_STAGE(PG8_SB(0, 1), cB + hstep, voffB); PG8_STAGE(PG8_SA(0, 1), cA + hstep, voffA);
        if (wr == 1) PG8_BAR;
        PG8_WAIT_V(4); PG8_BAR;
        PG8_STAGE(PG8_SB(1, 0), cB + kstep, voffB); PG8_STAGE(PG8_SA(1, 0), cA + kstep, voffA); PG8_STAGE(PG8_SB(1, 1), cB + hstep + kstep, voffB);
        PG8_WAIT_V(6); PG8_BAR;
    }
    for (;;) {
        const bool has_next = S.next(ui + 1, nxt);
        const char* nA = has_next ? (const char*)g.A + (size_t)nxt.arow * rstep : cA; const char* nB = has_next ? (const char*)g.Bt + (size_t)nxt.brow * rstep : cB;
        for (int t = 0; t < nt; t += 2) {
            const bool last = (t == nt - 2);
            const char* a1 = cA + (size_t)(t + 1) * kstep;
            const char* a2 = last ? nA : cA + (size_t)(t + 2) * kstep; const char* b2 = last ? nB : cB + (size_t)(t + 2) * kstep;
            const char* a3 = a2 + kstep; const char* b3 = b2 + kstep;
            if constexpr (SP2) {
            PG8_LDB(B0, 0, 0); PG8_LDB(B1, 0, 1); PG8_SCHED; PG8_LDA(At, 0, 0); PG8_STAGE(PG8_SA(1, 1), a1 + hstep, voffA);
            PG8_WAIT_V(8); PG8_WAIT_L(0); PG8_BAR; PG8_MMA(0, 0, At, B0); PG8_MMA(0, 1, At, B1); PG8_BAR; PG8_SCHED;
            PG8_LDA(At, 0, 1); PG8_STAGE(PG8_SB(0, 0), b2, voffB); PG8_STAGE(PG8_SB(0, 1), b2 + hstep, voffB); PG8_STAGE(PG8_SA(0, 0), a2, voffA);
            PG8_WAIT_V(8); PG8_WAIT_L(0); PG8_BAR; PG8_MMA(1, 0, At, B0); PG8_MMA(1, 1, At, B1); PG8_BAR; PG8_SCHED;
            PG8_LDB(B0, 1, 0); PG8_LDB(B1, 1, 1); PG8_SCHED; PG8_LDA(At, 1, 0); PG8_STAGE(PG8_SA(0, 1), a2 + hstep, voffA);
            PG8_WAIT_V(8); PG8_WAIT_L(0); PG8_BAR; PG8_MMA(0, 0, At, B0); PG8_MMA(0, 1, At, B1); PG8_BAR; PG8_SCHED;
            PG8_LDA(At, 1, 1); PG8_STAGE(PG8_SB(1, 0), b3, voffB); PG8_STAGE(PG8_SB(1, 1), b3 + hstep, voffB); PG8_STAGE(PG8_SA(1, 0), a3, voffA);
            PG8_WAIT_V(8); PG8_WAIT_L(0); PG8_BAR; PG8_MMA(1, 0, At, B0); PG8_MMA(1, 1, At, B1); PG8_BAR; PG8_SCHED;
            } else {
            PG8_LDB(B0, 0, 0); PG8_SCHED; PG8_LDA(At, 0, 0); PG8_STAGE(PG8_SA(1, 1), a1 + hstep, voffA);
            PG8_WAIT_L(8); PG8_BAR; PG8_WAIT_L(0); PG8_MMA(0, 0, At, B0); PG8_BAR; PG8_SCHED;
            PG8_LDB(B1, 0, 1); PG8_STAGE(PG8_SB(0, 0), b2, voffB);
            PG8_BAR; PG8_WAIT_L(0); PG8_MMA(0, 1, At, B1); PG8_BAR;
            PG8_LDA(At, 0, 1); PG8_STAGE(PG8_SA(0, 0), a2, voffA);
            PG8_BAR; PG8_WAIT_L(0); PG8_MMA(1, 0, At, B0); PG8_BAR; PG8_SCHED;
            PG8_STAGE(PG8_SB(0, 1), b2 + hstep, voffB);
            PG8_WAIT_V(6); PG8_BAR; PG8_MMA(1, 1, At, B1); PG8_BAR;
            PG8_LDB(B0, 1, 0); PG8_SCHED; PG8_LDA(At, 1, 0); PG8_STAGE(PG8_SA(0, 1), a2 + hstep, voffA);
            PG8_WAIT_L(8); PG8_BAR; PG8_WAIT_L(0); PG8_MMA(0, 0, At, B0); PG8_BAR; PG8_SCHED;
            PG8_LDB(B1, 1, 1); PG8_STAGE(PG8_SB(1, 0), b3, voffB);
            PG8_BAR; PG8_WAIT_L(0); PG8_MMA(0, 1, At, B1); PG8_BAR;
            PG8_LDA(At, 1, 1); PG8_STAGE(PG8_SA(1, 0), a3, voffA);
            PG8_BAR; PG8_WAIT_L(0); PG8_MMA(1, 0, At, B0); PG8_BAR; PG8_SCHED;
            PG8_STAGE(PG8_SB(1, 1), b3 + hstep, voffB);
            PG8_WAIT_V(6); PG8_BAR; PG8_MMA(1, 1, At, B1); PG8_BAR;
            }
        }
        if constexpr (ALIGN_EPI) { if (wr == 0) PG8_BAR; }
        E(acc, cur, wr, wc, fr, fq);
        if (!has_next) break;
#pragma unroll
        for (int a = 0; a < 2; ++a)
#pragma unroll
            for (int b = 0; b < 2; ++b)
#pragma unroll
                for (int m = 0; m < 4; ++m)
#pragma unroll
                    for (int n = 0; n < 2; ++n) acc[a][b][m][n] = (f32x4){0.f, 0.f, 0.f, 0.f};
        cur = nxt; cA = nA; cB = nB; ++ui;
        if constexpr (ALIGN_EPI) { if (wr == 1) PG8_BAR; }
    }
    PG8_WAIT_V(0);
    if constexpr (!ALIGN_EPI) { if (wr == 0) PG8_BAR; }
    PG8_BAR;
#undef PG8_SA
#undef PG8_SB
#undef PG8_STAGE
#undef PG8_LDA
#undef PG8_LDB
#undef PG8_MMA
#undef PG8_WAIT_V
#undef PG8_WAIT_L
#undef PG8_BAR
#undef PG8_SCHED
}

typedef const f32x4 (&AccRef)[2][2][4][2];
struct EpiG1 {
    static constexpr bool PERM = true;
    bf16* O;
    __device__ __forceinline__ void operator()(AccRef acc, const Unit& u, int wr, int wc, int fr, int fq) const {
        const int t = u.ocol >> 8; const int mode = ((t >= 8 && t < 12) || t >= 24) ? 1 : ((t >= 12 && t < 16) ? 2 : 0);
        const int row0 = u.orow + wr * 64 + fr, col0 = u.ocol + wc * 32 + 8 * fq;
#pragma unroll
        for (int ai = 0; ai < 2; ++ai)
#pragma unroll
            for (int m = 0; m < 4; ++m) { bf16* rowp = O + (size_t)(row0 + ai * HALF + m * 16) * NP + col0;
#pragma unroll
                for (int bj = 0; bj < 2; ++bj) { f32x4 v0 = acc[ai][bj][m][0], v1 = acc[ai][bj][m][1];
                    if (mode == 1) {
#pragma unroll
                        for (int j = 0; j < 4; ++j) { v0[j] = sigmoidf_(v0[j]); v1[j] = sigmoidf_(v1[j]); } }
                    else if (mode == 2) { v0 = v0 * 0.125f; v1 = v1 * 0.125f; }
                    u32x4 w; w.x = cvt_pk_bf16(v0[0], v0[1]); w.y = cvt_pk_bf16(v0[2], v0[3]); w.z = cvt_pk_bf16(v1[0], v1[1]); w.w = cvt_pk_bf16(v1[2], v1[3]);
                    *(u32x4*)(rowp + bj * HALF) = w; } }
    }
};
struct EpiMGa {
    static constexpr bool PERM = true;
    const bf16* P; float* T;
    __device__ __forceinline__ void operator()(AccRef acc, const Unit& u, int wr, int wc, int fr, int fq) const {
        const int row0 = u.orow + wr * 64 + fr, col0 = u.ocol + wc * 32 + 8 * fq;
#pragma unroll
        for (int ai = 0; ai < 2; ++ai)
#pragma unroll
            for (int m = 0; m < 4; ++m) { const size_t r = (size_t)(row0 + ai * HALF + m * 16);
#pragma unroll
                for (int bj = 0; bj < 2; ++bj) { const int c = col0 + bj * HALF;
                    const u32x4 gw = *(const u32x4*)(P + r * NP + PC_GA + c);
                    f32x4 v0 = acc[ai][bj][m][0], v1 = acc[ai][bj][m][1];
                    v0[0] *= bflo(gw.x); v0[1] *= bfhi(gw.x); v0[2] *= bflo(gw.y); v0[3] *= bfhi(gw.y);
                    v1[0] *= bflo(gw.z); v1[1] *= bfhi(gw.z); v1[2] *= bflo(gw.w); v1[3] *= bfhi(gw.w);
                    *(f32x4*)(T + r * D + c) = v0; *(f32x4*)(T + r * D + c + 4) = v1; } }
    }
};
struct EpiMGb {
    static constexpr bool PERM = true;
    const bf16* P; const float* T; bf16* U;
    __device__ __forceinline__ void operator()(AccRef acc, const Unit& u, int wr, int wc, int fr, int fq) const {
        const int row0 = u.orow + wr * 64 + fr, col0 = u.ocol + wc * 32 + 8 * fq;
#pragma unroll
        for (int ai = 0; ai < 2; ++ai)
#pragma unroll
            for (int m = 0; m < 4; ++m) { const size_t r = (size_t)(row0 + ai * HALF + m * 16);
#pragma unroll
                for (int bj = 0; bj < 2; ++bj) { const int c = col0 + bj * HALF;
                    const u32x4 gw = *(const u32x4*)(P + r * NP + PC_GB + c);
                    const f32x4 t0 = *(const f32x4*)(T + r * D + c), t1 = *(const f32x4*)(T + r * D + c + 4);
                    f32x4 v0 = acc[ai][bj][m][0], v1 = acc[ai][bj][m][1];
                    v0[0] = t0[0] + v0[0] * bflo(gw.x); v0[1] = t0[1] + v0[1] * bfhi(gw.x); v0[2] = t0[2] + v0[2] * bflo(gw.y); v0[3] = t0[3] + v0[3] * bfhi(gw.y);
                    v1[0] = t1[0] + v1[0] * bflo(gw.z); v1[1] = t1[1] + v1[1] * bfhi(gw.z); v1[2] = t1[2] + v1[2] * bflo(gw.w); v1[3] = t1[3] + v1[3] * bfhi(gw.w);
                    u32x4 w; w.x = cvt_pk_bf16(v0[0], v0[1]); w.y = cvt_pk_bf16(v0[2], v0[3]); w.z = cvt_pk_bf16(v1[0], v1[1]); w.w = cvt_pk_bf16(v1[2], v1[3]);
                    *(u32x4*)(U + r * D + c) = w; } }
    }
};
struct EpiRes {
    static constexpr bool PERM = false;
    const float* xin_lat; const float* xin_ctx; float* XO; const float* gate;
    __device__ __forceinline__ void operator()(AccRef acc, const Unit& u, int wr, int wc, int fr, int fq) const {
        const int row0 = u.orow + wr * 64 + fr, col0 = u.ocol + wc * 32 + 4 * fq;
        const int mr = u.orow < ML ? (u.orow >> 11) : 8;
        const float* gp = gate + (size_t)mr * 6144 + col0;
        f32x4 gv[2][2];
#pragma unroll
        for (int bj = 0; bj < 2; ++bj)
#pragma unroll
            for (int n = 0; n < 2; ++n) gv[bj][n] = *(const f32x4*)(gp + bj * HALF + n * 16);
        const float* xb = u.orow < ML ? xin_lat : xin_ctx - (size_t)ML * D;
#pragma unroll
        for (int ai = 0; ai < 2; ++ai)
#pragma unroll
            for (int m = 0; m < 4; ++m) { const size_t r = (size_t)(row0 + ai * HALF + m * 16);
#pragma unroll
                for (int bj = 0; bj < 2; ++bj)
#pragma unroll
                    for (int n = 0; n < 2; ++n) { const int c = col0 + bj * HALF + n * 16;
                        const f32x4 xi = *(const f32x4*)(xb + r * D + c);
                        *(f32x4*)(XO + r * D + c) = xi + gv[bj][n] * acc[ai][bj][m][n]; } }
    }
};
struct EpiF32 {
    static constexpr bool PERM = false;
    float* Y;
    __device__ __forceinline__ void operator()(AccRef acc, const Unit& u, int wr, int wc, int fr, int fq) const {
        const int row0 = u.orow + wr * 64 + fr, col0 = u.ocol + wc * 32 + 4 * fq;
#pragma unroll
        for (int ai = 0; ai < 2; ++ai)
#pragma unroll
            for (int m = 0; m < 4; ++m) { const size_t r = (size_t)(row0 + ai * HALF + m * 16);
#pragma unroll
                for (int bj = 0; bj < 2; ++bj)
#pragma unroll
                    for (int n = 0; n < 2; ++n) *(f32x4*)(Y + r * D + col0 + bj * HALF + n * 16) = acc[ai][bj][m][n]; }
    }
};
struct EpiSwiglu {
    static constexpr bool PERM = false;
    bf16* ACT; int ldf;
    __device__ __forceinline__ void operator()(AccRef acc, const Unit& u, int wr, int wc, int fr, int fq) const {
        const int row0 = u.orow + wr * 64 + fr, f0 = (u.ocol >> 1) + wc * 16 + 4 * fq;
#pragma unroll
        for (int ai = 0; ai < 2; ++ai)
#pragma unroll
            for (int m = 0; m < 4; ++m) { const size_t r = (size_t)(row0 + ai * HALF + m * 16);
#pragma unroll
                for (int bj = 0; bj < 2; ++bj) { const f32x4 a = acc[ai][bj][m][0], b = acc[ai][bj][m][1]; f32x4 o;
#pragma unroll
                    for (int j = 0; j < 4; ++j) o[j] = a[j] * sigmoidf_(a[j]) * b[j];
                    u32x2 w; w.x = cvt_pk_bf16(o[0], o[1]); w.y = cvt_pk_bf16(o[2], o[3]);
                    *(u32x2*)(ACT + r * ldf + f0 + bj * 64) = w; } }
    }
};
}

#define XB_TMO      128
#define XB_XCNT(j)  (256  + 64 * (j))
#define XB_XSUB(j)  (1280 + 64 * (j))
#define XB_XGEN(j)  (2304 + 64 * (j))
#define XB_TOP      3328
#define XB_TOPGEN   3392
#define XCD_BAR_WORDS 3456
#define XB_SPIN_CAP (1u << 18)
__device__ __forceinline__ unsigned xb_ld(unsigned* p)              { return __hip_atomic_load(p, __ATOMIC_RELAXED, __HIP_MEMORY_SCOPE_AGENT); }
__device__ __forceinline__ unsigned xb_add(unsigned* p, unsigned v) { return __hip_atomic_fetch_add(p, v, __ATOMIC_RELAXED, __HIP_MEMORY_SCOPE_AGENT); }
__device__ __forceinline__ unsigned xb_xcc_id() { return (unsigned)__builtin_amdgcn_s_getreg((3 << 11) | 20) & 0xFu; }
#define XB_SPIN(cond, bar) do { unsigned _sp = 0; while (cond) { __builtin_amdgcn_s_sleep(1); \
    if ((++_sp & 255u) == 0u) { if (xb_ld(&(bar)[XB_TMO])) break; if (_sp > XB_SPIN_CAP) { atomicAdd(&(bar)[XB_TMO], 1u); break; } } } } while (0)
struct XcdBarrier { unsigned* bar; unsigned x; volatile LAS unsigned* st; };
__device__ __forceinline__ XcdBarrier xcd_barrier_post(unsigned* bar, volatile LAS unsigned* st) {
    XcdBarrier b; b.bar = bar; b.x = xb_xcc_id(); b.st = st;
    if (threadIdx.x == 0) (void)xb_add(&bar[XB_XCNT(b.x)], 1u);
    return b;
}
__device__ __forceinline__ void xcd_barrier_complete(unsigned* bar, unsigned x, unsigned& nloc, unsigned& nx) {
    const unsigned G = gridDim.x * gridDim.y * gridDim.z;
    unsigned sum, cnt, mine, sp = 0u;
    for (;;) {
        sum = 0u; cnt = 0u; mine = 0u;
#pragma unroll
        for (unsigned j = 0; j < 16; ++j) { const unsigned c = xb_ld(&bar[XB_XCNT(j)]); sum += c; cnt += (c > 0u) ? 1u : 0u; mine = (j == x) ? c : mine; }
        if (sum == G) break;
        __builtin_amdgcn_s_sleep(1);
        if ((++sp & 255u) == 0u) { if (xb_ld(&bar[XB_TMO])) break; if (sp > XB_SPIN_CAP) { atomicAdd(&bar[XB_TMO], 1u); break; } }
    }
    nloc = mine > 0u ? mine : 1u; nx = cnt > 0u ? cnt : 1u;
}
__device__ __forceinline__ void xcd_barrier(const XcdBarrier& b) {
    asm volatile("s_waitcnt vmcnt(0)" ::: "memory");
    __syncthreads();
    if (threadIdx.x == 0) {
        unsigned* bar = b.bar;
        __builtin_amdgcn_s_waitcnt(0);
        unsigned nloc = b.st[0], nx = b.st[1];
        if (nloc == 0u) { xcd_barrier_complete(bar, b.x, nloc, nx); b.st[0] = nloc; b.st[1] = nx; }
        const unsigned old = xb_add(&bar[XB_XSUB(b.x)], 1u);
        const unsigned gen = old / nloc;
        if (old + 1u == (gen + 1u) * nloc) {
            __builtin_amdgcn_fence(__ATOMIC_RELEASE, "agent");
            asm volatile("s_waitcnt vmcnt(0)" ::: "memory");
            const unsigned og = xb_add(&bar[XB_TOP], 1u);
            const unsigned tg = og / nx;
            if (og + 1u == (tg + 1u) * nx) xb_add(&bar[XB_TOPGEN], 1u);
            else XB_SPIN(xb_ld(&bar[XB_TOPGEN]) == tg, bar);
            __builtin_amdgcn_fence(__ATOMIC_ACQUIRE, "agent");
            xb_add(&bar[XB_XGEN(b.x)], 1u);
            asm volatile("s_waitcnt vmcnt(0)" ::: "memory");
        } else {
            XB_SPIN(xb_ld(&bar[XB_XGEN(b.x)]) == gen, bar);
            __builtin_amdgcn_fence(__ATOMIC_ACQUIRE, "agent");
            asm volatile("s_waitcnt vmcnt(0)" ::: "memory");
        }
    }
    __syncthreads();
}

struct Args { const float* in[24]; float* out; unsigned char* ws; int ph_lo, ph_hi; };
typedef const __attribute__((address_space(4))) Args* KArgs;
__device__ __forceinline__ KArgs KA() { KArgs p = (KArgs)__builtin_amdgcn_kernarg_segment_ptr(); asm volatile("" : "+s"(p)); return p; }
struct Ctx {
    LAS unsigned char* lds; int tid, lane, wave, G, vcu;
    const float* const* dummy;
};

__device__ __forceinline__ void phase_pre(KArgs a, LAS unsigned char* lds) {
    const int tid = TID(), G = GRD();
    LAS float* sv = (LAS float*)lds;
    LAS float* red = sv + 9 * 1024;
    const float* c = a->in[1]; const float* cc = a->in[3]; const float* w_mod = a->in[4]; const float* b_mod = a->in[5];
    float* MOD = (float*)(a->ws + WS_MOD);
    for (int i = tid; i < 9 * 1024; i += 512) { const int r = i >> 10, k = i & 1023; const float v = r < 8 ? c[r * 1024 + k] : cc[k]; sv[i] = v * sigmoidf_(v); }
    __syncthreads();
    for (int item = BID(); item < DEPTH * 48; item += G) {
        const int l = item / 48, n0 = (item % 48) * 128, kq = tid >> 7, cl = tid & 127;
        float acc[9];
#pragma unroll
        for (int r = 0; r < 9; ++r) acc[r] = 0.f;
        const float* w = w_mod + ((size_t)l * 1024 + kq * 256) * 6144 + n0 + cl;
#pragma unroll 4
        for (int k = 0; k < 256; ++k) { const float wv = w[(size_t)k * 6144];
#pragma unroll
            for (int r = 0; r < 9; ++r) acc[r] += sv[r * 1024 + kq * 256 + k] * wv; }
#pragma unroll
        for (int r = 0; r < 9; ++r) red[(kq * 9 + r) * 128 + cl] = acc[r];
        __syncthreads();
        for (int o = tid; o < 9 * 128; o += 512) { const int r = o >> 7, q = o & 127;
            const float s = red[(0 * 9 + r) * 128 + q] + red[(1 * 9 + r) * 128 + q] + red[(2 * 9 + r) * 128 + q] + red[(3 * 9 + r) * 128 + q] + b_mod[l * 6144 + n0 + q];
            MOD[(size_t)(l * 9 + r) * 6144 + n0 + q] = s; }
        __syncthreads();
    }
}

__device__ __forceinline__ void tr_item(const float* srcA, const float* srcB, int ld, bf16* dst, int K, int drow0, int k0, LAS float* scr, int lane) {
    const int nl = lane & 31; const float* s = nl < 16 ? srcA + nl : srcB + (nl - 16);
#pragma unroll 8
    for (int i = 0; i < 32; ++i) { const int kk = 2 * i + (lane >> 5); scr[kk * 33 + nl] = s[(size_t)(k0 + kk) * ld]; }
    LDS_WAIT(); asm volatile("" ::: "memory");
    const int c = lane & 7;
#pragma unroll
    for (int j = 0; j < 4; ++j) { const int n = (lane >> 3) + 8 * j; const LAS float* p = scr + (8 * c) * 33 + n;
        u32x4 o; o.x = pk2(p[0 * 33], p[1 * 33]); o.y = pk2(p[2 * 33], p[3 * 33]); o.z = pk2(p[4 * 33], p[5 * 33]); o.w = pk2(p[6 * 33], p[7 * 33]);
        *(u32x4*)(dst + (size_t)(drow0 + n) * K + k0 + 8 * c) = o; }
    LDS_WAIT(); asm volatile("" ::: "memory");
}
__device__ __forceinline__ void convert_layer(KArgs a, LAS unsigned char* lds, int l) {
    const int lane = TID() & 63, wave = TID() >> 6;
    LAS float* scr = (LAS float*)(lds + wave * 8704);
    const int gw = BID() * 8 + wave, NGW = GRD() * 8;
    bf16* WIN = (bf16*)(a->ws + WS_WIN); bf16* WBRA = (bf16*)(a->ws + WS_WBRA); bf16* WBRB = (bf16*)(a->ws + WS_WBRB); bf16* WOUT = (bf16*)(a->ws + WS_WOUT);
    bf16* W13 = (bf16*)(a->ws + WS_W13); bf16* W2 = (bf16*)(a->ws + WS_W2);
    const float* w_in = a->in[8] + (size_t)l * D * DIN;
    const float* wbra = a->in[13] + (size_t)l * D * D; const float* wbrb = a->in[14] + (size_t)l * D * D; const float* wout = a->in[15] + (size_t)l * D * D;
    const int j = l >> 1; const bool moe = l & 1;
    constexpr int I_IN = 16 * 256, I_SQ = 16 * 32;
    constexpr int I_D13 = 16 * (2 * FF / 32), I_D2 = (FF / 64) * 32;
    constexpr int I_E13 = 16 * (2 * FFE / 32), I_E2 = (FFE / 64) * 32;
    const int n_ffn = moe ? NE * (I_E13 + I_E2) : (I_D13 + I_D2);
    const int total = I_IN + 3 * I_SQ + n_ffn;
    for (int it = gw; it < total; it += NGW) {
        int r = it;
        if (r < I_IN) { const int kb = r >> 8, nb = r & 255, n0 = nb * 32, sc = n0 < 3072 ? n0 : n0 + 16; tr_item(w_in + sc, w_in + sc + 16, DIN, WIN, D, n0, kb * 64, scr, lane); continue; } r -= I_IN;
        if (r < I_SQ) { const int kb = r >> 5, nb = r & 31; tr_item(wbra + nb * 32, wbra + nb * 32 + 16, D, WBRA, D, nb * 32, kb * 64, scr, lane); continue; } r -= I_SQ;
        if (r < I_SQ) { const int kb = r >> 5, nb = r & 31; tr_item(wbrb + nb * 32, wbrb + nb * 32 + 16, D, WBRB, D, nb * 32, kb * 64, scr, lane); continue; } r -= I_SQ;
        if (r < I_SQ) { const int kb = r >> 5, nb = r & 31; tr_item(wout + nb * 32, wout + nb * 32 + 16, D, WOUT, D, nb * 32, kb * 64, scr, lane); continue; } r -= I_SQ;
        if (!moe) {
            const float* w1 = a->in[16] + (size_t)j * D * FF; const float* w3 = a->in[17] + (size_t)j * D * FF; const float* w2 = a->in[18] + (size_t)j * FF * D;
            if (r < I_D13) { constexpr int NBK = 2 * FF / 32; const int kb = r / NBK, nb = r % NBK; tr_item(w1 + nb * 16, w3 + nb * 16, FF, W13, D, nb * 32, kb * 64, scr, lane); continue; } r -= I_D13;
            { const int kb = r >> 5, nb = r & 31; tr_item(w2 + nb * 32, w2 + nb * 32 + 16, D, W2, FF, nb * 32, kb * 64, scr, lane); }
        } else {
            const int e = r / (I_E13 + I_E2); r -= e * (I_E13 + I_E2);
            const float* w1 = a->in[20] + ((size_t)j * NE + e) * D * FFE; const float* w3 = a->in[21] + ((size_t)j * NE + e) * D * FFE; const float* w2 = a->in[22] + ((size_t)j * NE + e) * FFE * D;
            if (r < I_E13) { constexpr int NBK = 2 * FFE / 32; const int kb = r / NBK, nb = r % NBK; tr_item(w1 + nb * 16, w3 + nb * 16, FFE, W13 + (size_t)e * 2 * FFE * D, D, nb * 32, kb * 64, scr, lane); continue; } r -= I_E13;
            { const int kb = r >> 5, nb = r & 31; tr_item(w2 + nb * 32, w2 + nb * 32 + 16, D, W2 + (size_t)e * D * FFE, FFE, nb * 32, kb * 64, scr, lane); }
        }
    }
}

struct MoeCum { int cum[NE]; };
__device__ __forceinline__ void load_tile_prefix(const unsigned* cnt, int (&cum)[NE + 1]) {
    int acc = 0;
#pragma unroll
    for (int e = 0; e < NE; ++e) { cum[e] = acc; const int c = (int)__hip_atomic_load(cnt + e, __ATOMIC_RELAXED, __HIP_MEMORY_SCOPE_AGENT); acc += (c + 255) >> 8; }
    cum[NE] = acc;
}
__device__ __forceinline__ void moe_combine_row(KArgs a, int lm  , int row, int lane, f32x4 (&v)[4]) {
    const unsigned* cnt = (const unsigned*)(a->ws + WS_CTL) + CW_CNT + (lm >> 1) * 64;
    const int* RTI = (const int*)(a->ws + WS_RTI); const float* RTW = (const float*)(a->ws + WS_RTW); const float* YS = (const float*)(a->ws + WS_YS);
    const float* MOD = (const float*)(a->ws + WS_MOD);
    const int e0 = RTI[row * 4 + 0], r0 = RTI[row * 4 + 1], e1 = RTI[row * 4 + 2], r1 = RTI[row * 4 + 3];
    const float w0 = RTW[row * 2 + 0], w1 = RTW[row * 2 + 1];
    int c0 = 0, c1 = 0, accp = 0;
#pragma unroll
    for (int e = 0; e < NE; ++e) { const int c = (int)__hip_atomic_load(cnt + e, __ATOMIC_RELAXED, __HIP_MEMORY_SCOPE_AGENT); c0 = (e == e0) ? accp : c0; c1 = (e == e1) ? accp : c1; accp += (c + 255) >> 8; }
    const size_t s0 = (size_t)c0 * 256 + r0, s1 = (size_t)c1 * 256 + r1;
    const int mr = row < ML ? (row >> 11) : 8;
    const float* g2 = MOD + (size_t)(lm * 9 + mr) * 6144 + 5120;
#pragma unroll
    for (int j = 0; j < 4; ++j) { const int col = 4 * lane + 256 * j;
        const f32x4 y0 = *(const f32x4*)(YS + s0 * D + col), y1 = *(const f32x4*)(YS + s1 * D + col), g = *(const f32x4*)(g2 + col);
        v[j] = v[j] + g * (y0 * w0 + y1 * w1); }
}

__device__ __forceinline__ void phase_n1(KArgs a, LAS unsigned char* lds, int l) {
    const int tid = TID(), lane = tid & 63, wave = tid >> 6;
    LAS float* gwt = (LAS float*)lds;
    const float* w_in = a->in[8] + (size_t)l * D * DIN;
    __syncthreads();
    for (int i = tid; i < 16 * 1024; i += 512) { const int k = i >> 4, g = i & 15; gwt[g * 1024 + k] = w_in[(size_t)k * DIN + 3072 + g]; }
    __syncthreads();
    const float* MOD = (const float*)(a->ws + WS_MOD); float* XR = (float*)(a->ws + WS_XR); bf16* H = (bf16*)(a->ws + WS_H); float* GPRE = (float*)(a->ws + WS_GPRE);
    const float* g1 = a->in[6] + l * D; const float* gb = a->in[10] + l * 16;
    const bool combine = (l > 0) && ((l - 1) & 1);
    const int gw = BID() * 8 + wave, NGW = GRD() * 8;
    for (int row = gw; row < MROWS; row += NGW) {
        const float* xp = (l == 0) ? (row < ML ? a->in[0] + (size_t)row * D : a->in[2] + (size_t)(row - ML) * D) : XR + (size_t)row * D;
        f32x4 v[4]; float ss = 0.f;
#pragma unroll
        for (int j = 0; j < 4; ++j) v[j] = *(const f32x4*)(xp + 4 * lane + 256 * j);
        if (combine) { moe_combine_row(a, l - 1, row, lane, v);
#pragma unroll
            for (int j = 0; j < 4; ++j) *(f32x4*)(XR + (size_t)row * D + 4 * lane + 256 * j) = v[j]; }
#pragma unroll
        for (int j = 0; j < 4; ++j) ss += (v[j].x * v[j].x + v[j].y * v[j].y) + (v[j].z * v[j].z + v[j].w * v[j].w);
        const float rstd = rsqrtf(wave_sum(ss) * (1.f / D) + EPS);
        const int mr = row < ML ? (row >> 11) : 8; const float* mp = MOD + (size_t)(l * 9 + mr) * 6144;
        f32x4 h[4];
#pragma unroll
        for (int j = 0; j < 4; ++j) { const int col = 4 * lane + 256 * j; const f32x4 g = *(const f32x4*)(g1 + col), sh = *(const f32x4*)(mp + col), sc = *(const f32x4*)(mp + 1024 + col);
            h[j] = (v[j] * rstd * g) * (sc + 1.f) + sh;
            u32x2 w; w.x = pk2(h[j].x, h[j].y); w.y = pk2(h[j].z, h[j].w); *(u32x2*)(H + (size_t)row * D + col) = w; }
        float mine = 0.f;
#pragma unroll 1
        for (int g = 0; g < 16; ++g) { float s = 0.f;
#pragma unroll
            for (int j = 0; j < 4; ++j) { const f32x4 w4 = *(const LAS f32x4*)(gwt + g * 1024 + 256 * j + 4 * lane); s += (h[j].x * w4.x + h[j].y * w4.y) + (h[j].z * w4.z + h[j].w * w4.w); }
            s = wave_sum(s); mine = (lane == g) ? s : mine; }
        if (lane < 16) GPRE[(size_t)row * 16 + lane] = mine + gb[lane];
    }
}

__device__ __forceinline__ void phase_prep(KArgs a, int l) {
    const bf16* P = (const bf16*)(a->ws + WS_P); bf16* QK = (bf16*)(a->ws + WS_QK);
    const float* cw = a->in[9] + (size_t)l * 3 * 1024;
    const int gt = BID() * 512 + TID(), NT = GRD() * 512;
    for (int it = gt; it < MROWS * 64; it += NT) {
        const int row = it >> 6, i = it & 63;
        const bool lat = row < ML; const int t = lat ? (row & (TL - 1)) : ((row - ML) & (TC - 1)); const int T = lat ? TL : TC;
        const int ii = i & 31; const int dbase = (i < 32) ? ii : 64 + ii;
        float cs = 1.f, sn = 0.f;
        if (lat) { const float pos = (i < 32) ? (float)(t >> 6) : (float)(t & 63); const float inv = 1.0f / powf(10000.0f, (float)ii / 32.0f); const float ang = pos * inv; sincosf(ang, &sn, &cs); }
        const bool hp = t > 0, hn = t < T - 1;
#pragma unroll
        for (int qk = 0; qk < 2; ++qk)
#pragma unroll
            for (int h = 0; h < 4; ++h) { const int c1 = qk * 512 + h * 128 + dbase, c2 = c1 + 32;
                float u1 = cw[1024 + c1] * bf2f(P[(size_t)row * NP + c1]), u2 = cw[1024 + c2] * bf2f(P[(size_t)row * NP + c2]);
                if (hp) { u1 += cw[c1] * bf2f(P[(size_t)(row - 1) * NP + c1]); u2 += cw[c2] * bf2f(P[(size_t)(row - 1) * NP + c2]); }
                if (hn) { u1 += cw[2048 + c1] * bf2f(P[(size_t)(row + 1) * NP + c1]); u2 += cw[2048 + c2] * bf2f(P[(size_t)(row + 1) * NP + c2]); }
                u1 = u1 * sigmoidf_(u1); u2 = u2 * sigmoidf_(u2);
                float o1 = u1 * cs - u2 * sn, o2 = u1 * sn + u2 * cs;
                if (qk) { o1 *= 0.08838834764831845f; o2 *= 0.08838834764831845f; }
                QK[(size_t)row * D + c1] = (bf16)f2bf(o1); QK[(size_t)row * D + c2] = (bf16)f2bf(o2); }
    }
}

__device__ __forceinline__ float log_sigmoid_(float x) { return fminf(x, 0.f) - log1pf(__expf(-fabsf(x))); }
__device__ __forceinline__ void phase_scan_naive(KArgs a, LAS unsigned char* lds, int l) {
    const int tid = TID(), lane = tid & 63;
    LAS float* q = (LAS float*)lds;
    LAS float* k = q + 64 * 129;
    LAS float* C = k + 64 * 129;
    LAS float* vv = C + 64 * 129;
    LAS float* S = vv + 64 * 65;
    LAS float* nv = S + 64 * 65;
    LAS float* sc = nv + 128;
    LAS float* bL = sc, *igL = sc + 64, *mrowL = sc + 128, *wintL = sc + 192, *wkL = sc + 256, *denL = sc + 320, *misc = sc + 384;
    const bf16* P = (const bf16*)(a->ws + WS_P); const bf16* QK = (const bf16*)(a->ws + WS_QK); const float* GPRE = (const float*)(a->ws + WS_GPRE);
    float* HS = (float*)(a->ws + WS_HS);
    for (int unit = BID(); unit < 256; unit += GRD()) {
        const int b = unit >> 5, h = (unit >> 3) & 3, dir = (unit >> 2) & 1, vs = unit & 3;
        __syncthreads();
        for (int i = tid; i < 64 * 129; i += 512) C[i] = 0.f;
        if (tid < 128) nv[tid] = 0.f;
        if (tid == 0) misc[0] = 0.f;
        __syncthreads();
        for (int step = 0; step < 36; ++step) {
            const bool isc = step < 4; const int jj = isc ? step : step - 4; const int T = isc ? TC : TL; const int rbase = isc ? ML + b * TC : b * TL;
#define ROWOF(li) (rbase + (dir ? (T - 1 - (64 * jj + (li))) : (64 * jj + (li))))
            for (int i = tid; i < 64 * 128; i += 512) { const int li = i >> 7, d = i & 127; const size_t r = (size_t)ROWOF(li);
                q[li * 129 + d] = bf2f(QK[r * D + h * 128 + d]); k[li * 129 + d] = bf2f(QK[r * D + 512 + h * 128 + d]); }
            for (int i = tid; i < 64 * 64; i += 512) { const int li = i >> 6, v = i & 63; const size_t r = (size_t)ROWOF(li); vv[li * 65 + v] = bf2f(P[r * NP + PC_V + h * 256 + vs * 64 + v]); }
            if (tid < 64) {
                const size_t r = (size_t)ROWOF(lane);
                const float ig = GPRE[r * 16 + (2 * dir) * 4 + h]; const float fg = log_sigmoid_(GPRE[r * 16 + (2 * dir + 1) * 4 + h]);
                float bb = fg;
#pragma unroll
                for (int o = 1; o < 64; o <<= 1) { const float t2 = __shfl_up(bb, o); if (lane >= o) bb += t2; }
                float am = ig - bb;
#pragma unroll
                for (int o = 1; o < 64; o <<= 1) { const float t2 = __shfl_up(am, o); if (lane >= o) am = fmaxf(am, t2); }
                const float m = misc[0];
                const float mrow = bb + fmaxf(m, am);
                const float blast = __shfl(bb, 63);
                const float g = blast - bb + ig;
                const float gmax = wave_max(g);
                const float mnew = fmaxf(blast + m, gmax);
                bL[lane] = bb; igL[lane] = ig; mrowL[lane] = mrow; wintL[lane] = __expf(bb + m - mrow); wkL[lane] = __expf(g - mnew);
                if (lane == 0) { misc[1] = __expf(blast + m - mnew); misc[2] = mnew; }
            }
            __syncthreads();
            for (int it = 0; it < 8; ++it) { const int s = tid & 63, li = (tid >> 6) + 8 * it; float dot = 0.f;
                if (s <= li) {
#pragma unroll 8
                    for (int d = 0; d < 128; ++d) dot += q[li * 129 + d] * k[s * 129 + d];
                    dot *= __expf(bL[li] - bL[s] + igL[s] - mrowL[li]); }
                S[li * 65 + s] = dot; }
            __syncthreads();
            if (tid < 64) { float di = 0.f, dn = 0.f;
                for (int s = 0; s < 64; ++s) di += S[tid * 65 + s];
                for (int d = 0; d < 128; ++d) dn += nv[d] * q[tid * 129 + d];
                const float den = di + wintL[tid] * dn; denL[tid] = fmaxf(fabsf(den), __expf(-mrowL[tid])); }
            __syncthreads();
            for (int it = 0; it < 8; ++it) { const int v = tid & 63, li = (tid >> 6) + 8 * it; float n1 = 0.f, n2 = 0.f;
#pragma unroll 8
                for (int s = 0; s < 64; ++s) n1 += S[li * 65 + s] * vv[s * 65 + v];
#pragma unroll 8
                for (int d = 0; d < 128; ++d) n2 += C[v * 129 + d] * q[li * 129 + d];
                const float num = n1 + wintL[li] * n2;
                HS[((size_t)dir * MROWS + ROWOF(li)) * D + h * 256 + vs * 64 + v] = num / denL[li]; }
            __syncthreads();
            { const float decay = misc[1];
              for (int it = 0; it < 16; ++it) { const int d = tid & 127, v = (tid >> 7) + 4 * it; float s2 = 0.f;
#pragma unroll 8
                  for (int li = 0; li < 64; ++li) s2 += wkL[li] * vv[li * 65 + v] * k[li * 129 + d];
                  C[v * 129 + d] = decay * C[v * 129 + d] + s2; }
              if (tid < 128) { float s2 = 0.f; for (int li = 0; li < 64; ++li) s2 += wkL[li] * k[li * 129 + tid]; nv[tid] = decay * nv[tid] + s2; }
            }
            __syncthreads();
            if (tid == 0) misc[0] = misc[2];
            __syncthreads();
#undef ROWOF
        }
    }
}

typedef short s16x4 __attribute__((ext_vector_type(4)));
__device__ __forceinline__ s16x4 ds_tr(LAS unsigned char* p) { return __builtin_amdgcn_ds_read_tr16_b64_v4i16((LAS s16x4*)p); }
__device__ __forceinline__ bf16x8 cat8(s16x4 a, s16x4 b) { return __builtin_shufflevector(a, b, 0, 1, 2, 3, 4, 5, 6, 7); }
__device__ __forceinline__ f32x4 mfma16(bf16x8 a, bf16x8 b, f32x4 c) { return __builtin_amdgcn_mfma_f32_16x16x32_bf16(a, b, c, 0, 0, 0); }
__device__ __forceinline__ void phase_scan_mfma(KArgs a, LAS unsigned char* lds, int l) {
    const int tid = TID(), lane = tid & 63, w = __builtin_amdgcn_readfirstlane(tid >> 6), c = lane & 15, g = lane >> 4;
    constexpr int QS = 0, KS = 17408, VS = 34816, CB = 46080, SC = 67840, RS = 272, VRS = 176;
    LAS float* uL = (LAS float*)(lds + SC); LAS float* wL = uL + 64; LAS float* wintL = uL + 128; LAS float* wkL = uL + 192; LAS float* emL = uL + 256; LAS float* misc = uL + 320;
    const bf16* P = (const bf16*)(a->ws + WS_P); const bf16* QK = (const bf16*)(a->ws + WS_QK); const float* GPRE = (const float*)(a->ws + WS_GPRE);
    float* HS = (float*)(a->ws + WS_HS);
    const int lt = w & 3, vh = w >> 2;
    for (int unit = BID(); unit < 256; unit += GRD()) {
        const int b = unit >> 5, h = (unit >> 3) & 3, dir = (unit >> 2) & 1, vs = unit & 3;
        __syncthreads();
        for (int i = tid; i < 64 * 16; i += 512) { const int li = i >> 4, cc = i & 15; *(LAS bf16*)(lds + VS + li * VRS + (64 + cc) * 2) = (bf16)(cc == 0 ? 0x3F80 : 0); }
        for (int i = tid; i < 80 * RS / 4; i += 512) ((LAS unsigned*)(lds + CB))[i] = 0u;
        f32x4 Cacc[5];
#pragma unroll
        for (int mt = 0; mt < 5; ++mt) Cacc[mt] = (f32x4){0.f, 0.f, 0.f, 0.f};
        float mcur = 0.f;
        u32x4 pq0, pq1, pk0, pk1, pv; float pig = 0.f, pfg = 0.f;
        const int li_ld = tid >> 3, ch_ld = tid & 7;
#define SC_ROW(step_, li_) (((step_) < 4 ? ML + b * TC : b * TL) + (dir ? (((step_) < 4 ? TC : TL) - 1 - (64 * ((step_) < 4 ? (step_) : (step_) - 4) + (li_))) : (64 * ((step_) < 4 ? (step_) : (step_) - 4) + (li_))))
#define SC_LOAD(step_) do { const size_t r_ = (size_t)SC_ROW(step_, li_ld); \
            const unsigned char* qp_ = (const unsigned char*)(QK + r_ * D + h * 128) + ch_ld * 16; \
            pq0 = *(const u32x4*)qp_; pq1 = *(const u32x4*)(qp_ + 128); pk0 = *(const u32x4*)(qp_ + 1024); pk1 = *(const u32x4*)(qp_ + 1024 + 128); \
            pv = *(const u32x4*)((const unsigned char*)(P + r_ * NP + PC_V + h * 256 + vs * 64) + ch_ld * 16); \
            if (w == 0) { const size_t rg_ = (size_t)SC_ROW(step_, lane); pig = GPRE[rg_ * 16 + (2 * dir) * 4 + h]; pfg = GPRE[rg_ * 16 + (2 * dir + 1) * 4 + h]; } } while (0)
        SC_LOAD(0);
        for (int step = 0; step < 36; ++step) {
            *(LAS u32x4*)(lds + QS + li_ld * RS + ch_ld * 16) = pq0; *(LAS u32x4*)(lds + QS + li_ld * RS + ch_ld * 16 + 128) = pq1;
            *(LAS u32x4*)(lds + KS + li_ld * RS + ch_ld * 16) = pk0; *(LAS u32x4*)(lds + KS + li_ld * RS + ch_ld * 16 + 128) = pk1;
            *(LAS u32x4*)(lds + VS + li_ld * VRS + ch_ld * 16) = pv;
            if (w == 0) {
                const float ig = pig, fg = log_sigmoid_(pfg);
                float bb = fg;
#pragma unroll
                for (int o = 1; o < 64; o <<= 1) { const float t2 = __shfl_up(bb, o); if (lane >= o) bb += t2; }
                float am = ig - bb;
#pragma unroll
                for (int o = 1; o < 64; o <<= 1) { const float t2 = __shfl_up(am, o); if (lane >= o) am = fmaxf(am, t2); }
                const float mrow = bb + fmaxf(mcur, am);
                const float blast = __shfl(bb, 63);
                const float gg = blast - bb + ig;
                const float mnew = fmaxf(blast + mcur, wave_max(gg));
                uL[lane] = bb - mrow; wL[lane] = ig - bb; wintL[lane] = __expf(bb + mcur - mrow); wkL[lane] = __expf(gg - mnew); emL[lane] = __expf(-mrow);
                if (lane == 0) misc[1] = __expf(blast + mcur - mnew);
                mcur = mnew;
            }
            __syncthreads();
            if (step + 1 < 36) SC_LOAD(step + 1);
            bf16x8 qf[4];
#pragma unroll
            for (int ks = 0; ks < 4; ++ks) qf[ks] = *(const LAS bf16x8*)(lds + QS + (16 * lt + c) * RS + (32 * ks + 8 * g) * 2);
            f32x4 acc[3];
#pragma unroll
            for (int nt = 0; nt < 3; ++nt) { acc[nt] = (f32x4){0.f, 0.f, 0.f, 0.f}; const int vrow0 = nt < 2 ? 16 * (2 * vh + nt) : 64;
#pragma unroll
                for (int ks = 0; ks < 4; ++ks) { const bf16x8 bfr = *(const LAS bf16x8*)(lds + CB + (vrow0 + c) * RS + (32 * ks + 8 * g) * 2); acc[nt] = mfma16(qf[ks], bfr, acc[nt]); } }
            { const f32x4 wi = *(const LAS f32x4*)(wintL + 16 * lt + 4 * g);
#pragma unroll
              for (int nt = 0; nt < 3; ++nt) acc[nt] = acc[nt] * wi; }
            const float ul = uL[16 * lt + c];
#pragma unroll
            for (int sc2 = 0; sc2 < 2; ++sc2) {
                if (2 * sc2 <= lt) {
                    unsigned pw[4];
#pragma unroll
                    for (int hh = 0; hh < 2; ++hh) { const int st = 2 * sc2 + hh; float p[4] = {0.f, 0.f, 0.f, 0.f};
                        if (st <= lt) { f32x4 sT = (f32x4){0.f, 0.f, 0.f, 0.f};
#pragma unroll
                            for (int ks = 0; ks < 4; ++ks) { const bf16x8 afr = *(const LAS bf16x8*)(lds + KS + (16 * st + c) * RS + (32 * ks + 8 * g) * 2); sT = mfma16(afr, qf[ks], sT); }
                            const f32x4 ws = *(const LAS f32x4*)(wL + 16 * st + 4 * g);
#pragma unroll
                            for (int r = 0; r < 4; ++r) p[r] = (16 * st + 4 * g + r <= 16 * lt + c) ? sT[r] * __expf(ul + ws[r]) : 0.f; }
                        pw[2 * hh] = pk2(p[0], p[1]); pw[2 * hh + 1] = pk2(p[2], p[3]); }
                    const u32x4 pwv = (u32x4){pw[0], pw[1], pw[2], pw[3]};
                    const bf16x8 pfrag = __builtin_bit_cast(bf16x8, pwv);
#pragma unroll
                    for (int nt = 0; nt < 3; ++nt) { const int ncol0 = nt < 2 ? 16 * (2 * vh + nt) : 64;
                        LAS unsigned char* vp = lds + VS + (32 * sc2 + 4 * g + (c >> 2)) * VRS + (ncol0 + 4 * (c & 3)) * 2;
                        const s16x4 t0 = ds_tr(vp), t1 = ds_tr(vp + 16 * VRS);
                        acc[nt] = mfma16(pfrag, cat8(t0, t1), acc[nt]); }
                }
            }
            { float den[4];
#pragma unroll
              for (int r = 0; r < 4; ++r) den[r] = __shfl(acc[2][r], lane & 48);
              const f32x4 em = *(const LAS f32x4*)(emL + 16 * lt + 4 * g);
#pragma unroll
              for (int r = 0; r < 4; ++r) { const float dn = 1.f / fmaxf(fabsf(den[r]), em[r]); const size_t row = (size_t)SC_ROW(step, 16 * lt + 4 * g + r);
                  float* op = HS + ((size_t)dir * MROWS + row) * D + h * 256 + vs * 64 + c;
                  op[16 * (2 * vh + 0)] = acc[0][r] * dn; op[16 * (2 * vh + 1)] = acc[1][r] * dn; } }
            { const float decay = misc[1];
#pragma unroll
              for (int mt = 0; mt < 5; ++mt) Cacc[mt] = Cacc[mt] * decay;
#pragma unroll
              for (int kc = 0; kc < 2; ++kc) {
                  LAS unsigned char* kp = lds + KS + (32 * kc + 8 * g + (c >> 2)) * RS + (16 * w + 4 * (c & 3)) * 2;
                  const s16x4 t0 = ds_tr(kp), t1 = ds_tr(kp + 4 * RS);
                  const f32x4 wka = *(const LAS f32x4*)(wkL + 32 * kc + 8 * g), wkb = *(const LAS f32x4*)(wkL + 32 * kc + 8 * g + 4);
                  u32x4 bwv;
                  bwv.x = pk2(bf2f((unsigned short)t0[0]) * wka[0], bf2f((unsigned short)t0[1]) * wka[1]); bwv.y = pk2(bf2f((unsigned short)t0[2]) * wka[2], bf2f((unsigned short)t0[3]) * wka[3]);
                  bwv.z = pk2(bf2f((unsigned short)t1[0]) * wkb[0], bf2f((unsigned short)t1[1]) * wkb[1]); bwv.w = pk2(bf2f((unsigned short)t1[2]) * wkb[2], bf2f((unsigned short)t1[3]) * wkb[3]);
                  const bf16x8 bw = __builtin_bit_cast(bf16x8, bwv);
#pragma unroll
                  for (int mt = 0; mt < 5; ++mt) { LAS unsigned char* vp = lds + VS + (32 * kc + 8 * g + (c >> 2)) * VRS + (16 * mt + 4 * (c & 3)) * 2;
                      const s16x4 a0 = ds_tr(vp), a1 = ds_tr(vp + 4 * VRS);
                      Cacc[mt] = mfma16(cat8(a0, a1), bw, Cacc[mt]); } } }
            __syncthreads();
#pragma unroll
            for (int mt = 0; mt < 5; ++mt)
#pragma unroll
                for (int r = 0; r < 4; ++r) *(LAS bf16*)(lds + CB + (16 * mt + 4 * g + r) * RS + (16 * w + c) * 2) = (bf16)f2bf(Cacc[mt][r]);
        }
#undef SC_LOAD
#undef SC_ROW
    }
}

__device__ __forceinline__ void phase_na_naive(KArgs a, int l, bool last) {
    const int lane = TID() & 63, wave = TID() >> 6;
    const bf16* P = (const bf16*)(a->ws + WS_P); bf16* HB = (bf16*)(a->ws + WS_HB);
    const float* rpb = a->in[12] + (size_t)l * 16 * 15 * 31;
    const int gw = BID() * 8 + wave, NGW = GRD() * 8;
    const int nitems = (last ? ML : MROWS) * 16;
    for (int item = gw; item < nitems; item += NGW) {
        int h, row;
        if (item < ML * 16) { h = item >> 14; row = item & (ML - 1); } else { const int r2 = item - ML * 16; h = r2 >> 11; row = ML + (r2 & (MC - 1)); }
        const bool lat = row < ML;
        const int b = lat ? (row >> 11) : ((row - ML) >> 8);
        const int t = lat ? (row & (TL - 1)) : 0;
        const int qr = t >> 6, qc = t & 63;
        const int rs = min(max(qr - 4, 0), 24), cs = min(max(qc - 8, 0), 48);
        float q[64];
        { const u32x4* qp = (const u32x4*)(P + (size_t)row * NP + PC_NQ + h * 64);
#pragma unroll
          for (int i = 0; i < 8; ++i) { const u32x4 w = qp[i]; q[8 * i + 0] = bflo(w.x); q[8 * i + 1] = bfhi(w.x); q[8 * i + 2] = bflo(w.y); q[8 * i + 3] = bfhi(w.y); q[8 * i + 4] = bflo(w.z); q[8 * i + 5] = bfhi(w.z); q[8 * i + 6] = bflo(w.w); q[8 * i + 7] = bfhi(w.w); } }
        float s[6];
#pragma unroll
        for (int i = 0; i < 6; ++i) {
            int krow; float bias = 0.f; bool valid = true;
            if (i < 2) { const int li = lane + 64 * i; const int kr = rs + (li >> 4), kc = cs + (li & 15); krow = b * TL + kr * 64 + kc; valid = lat;
                bias = rpb[(h * 15 + (kr - qr + 7)) * 31 + (kc - qc + 15)]; }
            else { krow = ML + b * TC + lane + 64 * (i - 2); }
            float dot = 0.f;
            if (valid) { const u32x4* kp = (const u32x4*)(P + (size_t)krow * NP + PC_NK + h * 64);
#pragma unroll
                for (int j = 0; j < 8; ++j) { const u32x4 w = kp[j];
                    dot += q[8 * j + 0] * bflo(w.x) + q[8 * j + 1] * bfhi(w.x) + q[8 * j + 2] * bflo(w.y) + q[8 * j + 3] * bfhi(w.y) + q[8 * j + 4] * bflo(w.z) + q[8 * j + 5] * bfhi(w.z) + q[8 * j + 6] * bflo(w.w) + q[8 * j + 7] * bfhi(w.w); }
                s[i] = dot + bias; }
            else s[i] = -3.0e38f;
        }
        float mx = s[0];
#pragma unroll
        for (int i = 1; i < 6; ++i) mx = fmaxf(mx, s[i]);
        mx = wave_max(mx);
        float sum = 0.f;
#pragma unroll
        for (int i = 0; i < 6; ++i) { s[i] = (s[i] > -1.0e38f) ? __expf(s[i] - mx) : 0.f; sum += s[i]; }
        sum = wave_sum(sum);
        float o = 0.f;
        const bf16* vb = P + PC_NV + h * 64 + lane;
        if (lat) {
#pragma unroll
            for (int i = 0; i < 2; ++i)
                for (int src = 0; src < 64; ++src) { const int li = src + 64 * i; const int kr = rs + (li >> 4), kc = cs + (li & 15); const size_t krow = (size_t)b * TL + kr * 64 + kc;
                    o += __shfl(s[i], src) * bf2f(vb[krow * NP]); }
        }
#pragma unroll
        for (int i = 2; i < 6; ++i)
            for (int src = 0; src < 64; ++src) { const size_t krow = (size_t)ML + b * TC + src + 64 * (i - 2); o += __shfl(s[i], src) * bf2f(vb[krow * NP]); }
        HB[(size_t)row * D + h * 64 + lane] = (bf16)f2bf(o / sum);
    }
}

__device__ __forceinline__ void phase_ln(KArgs a, int l, bool last) {
    const int lane = TID() & 63, wave = TID() >> 6;
    const float* HS = (const float*)(a->ws + WS_HS); const bf16* P = (const bf16*)(a->ws + WS_P); bf16* HA = (bf16*)(a->ws + WS_HA);
    const float* gh = a->in[11] + l * D;
    const int gw = BID() * 8 + wave, NGW = GRD() * 8; const int nrows = last ? ML : MROWS;
    for (int row = gw; row < nrows; row += NGW) {
#pragma unroll
        for (int j = 0; j < 4; ++j) { const int col = 4 * lane + 256 * j;
            const f32x4 y = *(const f32x4*)(HS + (size_t)row * D + col) + *(const f32x4*)(HS + ((size_t)MROWS + row) * D + col);
            const float mu = wave_sum((y.x + y.y) + (y.z + y.w)) * (1.f / 256.f);
            const f32x4 dlt = y - mu;
            const float var = wave_sum((dlt.x * dlt.x + dlt.y * dlt.y) + (dlt.z * dlt.z + dlt.w * dlt.w)) * (1.f / 256.f);
            const float rstd = rsqrtf(var + EPS);
            const f32x4 g = *(const f32x4*)(gh + col);
            const u32x2 ow = *(const u32x2*)(P + (size_t)row * NP + PC_O + col);
            const f32x4 so = (f32x4){bflo(ow.x), bfhi(ow.x), bflo(ow.y), bfhi(ow.y)};
            const f32x4 r = dlt * rstd * g * so;
            u32x2 w; w.x = pk2(r.x, r.y); w.y = pk2(r.z, r.w); *(u32x2*)(HA + (size_t)row * D + col) = w; }
    }
}

__device__ __forceinline__ void phase_n2(KArgs a, LAS unsigned char* lds, int l, bool last) {
    const int tid = TID(), lane = tid & 63, wave = tid >> 6;
    const bool moe = l & 1; const int jm = l >> 1;
    LAS float* rt = (LAS float*)lds;
    __syncthreads();
    if (moe) { const float* router = a->in[19] + (size_t)jm * D * NE;
        for (int i = tid; i < NE * 1024; i += 512) { const int k = i >> 3, e = i & 7; rt[e * 1024 + k] = router[(size_t)k * NE + e]; } }
    __syncthreads();
    const float* MOD = (const float*)(a->ws + WS_MOD); const float* XR = (const float*)(a->ws + WS_XR); bf16* H = (bf16*)(a->ws + WS_H); bf16* H2S = (bf16*)(a->ws + WS_H2S);
    int* RTI = (int*)(a->ws + WS_RTI); float* RTW = (float*)(a->ws + WS_RTW);
    unsigned* cnt = (unsigned*)(a->ws + WS_CTL) + CW_CNT + jm * 64;
    const float* g2 = a->in[7] + l * D;
    const int gw = BID() * 8 + wave, NGW = GRD() * 8; const int nrows = last ? ML : MROWS;
    for (int row = gw; row < nrows; row += NGW) {
        const float* xp = XR + (size_t)row * D;
        f32x4 v[4]; float ss = 0.f;
#pragma unroll
        for (int j = 0; j < 4; ++j) { v[j] = *(const f32x4*)(xp + 4 * lane + 256 * j); ss += (v[j].x * v[j].x + v[j].y * v[j].y) + (v[j].z * v[j].z + v[j].w * v[j].w); }
        const float rstd = rsqrtf(wave_sum(ss) * (1.f / D) + EPS);
        const int mr = row < ML ? (row >> 11) : 8; const float* mp = MOD + (size_t)(l * 9 + mr) * 6144;
        f32x4 h[4]; u32x2 hw[4];
#pragma unroll
        for (int j = 0; j < 4; ++j) { const int col = 4 * lane + 256 * j; const f32x4 g = *(const f32x4*)(g2 + col), sh = *(const f32x4*)(mp + 3072 + col), sc = *(const f32x4*)(mp + 4096 + col);
            h[j] = (v[j] * rstd * g) * (sc + 1.f) + sh; hw[j].x = pk2(h[j].x, h[j].y); hw[j].y = pk2(h[j].z, h[j].w); }
        if (!moe) {
#pragma unroll
            for (int j = 0; j < 4; ++j) *(u32x2*)(H + (size_t)row * D + 4 * lane + 256 * j) = hw[j];
        } else {
            float lg[NE];
#pragma unroll
            for (int e = 0; e < NE; ++e) { float s = 0.f;
#pragma unroll
                for (int j = 0; j < 4; ++j) { const f32x4 w4 = *(const LAS f32x4*)(rt + e * 1024 + 256 * j + 4 * lane); s += (h[j].x * w4.x + h[j].y * w4.y) + (h[j].z * w4.z + h[j].w * w4.w); }
                lg[e] = wave_sum(s); }
            int i0 = 0; float v0 = lg[0];
#pragma unroll
            for (int e = 1; e < NE; ++e) if (lg[e] > v0) { v0 = lg[e]; i0 = e; }
            int i1 = -1; float v1 = -3.0e38f;
#pragma unroll
            for (int e = 0; e < NE; ++e) if (e != i0 && lg[e] > v1) { v1 = lg[e]; i1 = e; }
            const float w0 = 1.f / (1.f + __expf(v1 - v0)), w1 = 1.f - w0;
            int r0 = 0, r1 = 0;
            if (lane == 0) { r0 = (int)__hip_atomic_fetch_add(cnt + i0, 1u, __ATOMIC_RELAXED, __HIP_MEMORY_SCOPE_AGENT); r1 = (int)__hip_atomic_fetch_add(cnt + i1, 1u, __ATOMIC_RELAXED, __HIP_MEMORY_SCOPE_AGENT); }
            r0 = __shfl(r0, 0); r1 = __shfl(r1, 0);
            if (lane == 0) { RTI[row * 4 + 0] = i0; RTI[row * 4 + 1] = r0; RTI[row * 4 + 2] = i1; RTI[row * 4 + 3] = r1; RTW[row * 2 + 0] = w0; RTW[row * 2 + 1] = w1; }
            bf16* d0 = H2S + ((size_t)i0 * ECAP + r0) * D; bf16* d1 = H2S + ((size_t)i1 * ECAP + r1) * D;
#pragma unroll
            for (int j = 0; j < 4; ++j) { *(u32x2*)(d0 + 4 * lane + 256 * j) = hw[j]; *(u32x2*)(d1 + 4 * lane + 256 * j) = hw[j]; }
        }
    }
}

__device__ __forceinline__ void phase_final(KArgs a) {
    const int lane = TID() & 63, wave = TID() >> 6;
    const float* XR = (const float*)(a->ws + WS_XR); const float* gf = a->in[23];
    const int gw = BID() * 8 + wave, NGW = GRD() * 8;
    for (int row = gw; row < ML; row += NGW) {
        f32x4 v[4]; float ss = 0.f;
#pragma unroll
        for (int j = 0; j < 4; ++j) v[j] = *(const f32x4*)(XR + (size_t)row * D + 4 * lane + 256 * j);
        moe_combine_row(a, DEPTH - 1, row, lane, v);
#pragma unroll
        for (int j = 0; j < 4; ++j) ss += (v[j].x * v[j].x + v[j].y * v[j].y) + (v[j].z * v[j].z + v[j].w * v[j].w);
        const float rstd = rsqrtf(wave_sum(ss) * (1.f / D) + EPS);
#pragma unroll
        for (int j = 0; j < 4; ++j) { const int col = 4 * lane + 256 * j; *(f32x4*)(a->out + (size_t)row * D + col) = v[j] * rstd * *(const f32x4*)(gf + col); }
    }
}

constexpr int PH_PER_LAYER = 10, N_PHASES = 2 + DEPTH * PH_PER_LAYER;
__global__ void __launch_bounds__(512, 2) fwd(Args args) {
    extern __shared__ __attribute__((aligned(16))) unsigned char lds_raw[];
    LAS unsigned char* lds = (LAS unsigned char*)lds_raw;
    const int tid = TID();
    volatile LAS unsigned* MISC = (volatile LAS unsigned*)(lds + MISC_OFF);
    for (int u = tid; u < (LDS_BYTES - MISC_OFF) / 4; u += 512) ((LAS unsigned*)(lds + MISC_OFF))[u] = 0u;
    __syncthreads();
    unsigned* ctl = (unsigned*)(KA()->ws + WS_CTL);
    const int lo = KA()->ph_lo, hi = KA()->ph_hi;
    XcdBarrier bar; bar.bar = ctl + CW_BAR; bar.x = 0; bar.st = nullptr;
    if (hi - lo > 1) bar = xcd_barrier_post(ctl + CW_BAR, MISC + 8);
#ifndef PH_MASK
#define PH_MASK 0xFFFFFFFFu
#endif
#define PM(b) ((PH_MASK >> (b)) & 1u)
#define IN(k) (lo <= (k) && (k) < hi)
#define SEAM(k) do { if (IN(k) && IN((k) + 1)) xcd_barrier(bar); } while (0)

    if (PM(0) && IN(0)) { phase_pre(KA(), lds); } SEAM(0);

    for (int l = 0; l < DEPTH; ++l) {
        const int pb = 1 + l * PH_PER_LAYER; const bool last = (l == DEPTH - 1); const bool moe = l & 1;
        const int Mrows = last ? ML : MROWS;
        const float* MODl = (const float*)(KA()->ws + WS_MOD) + (size_t)l * 9 * 6144;
        if (IN(pb + 0)) { if (PM(1)) convert_layer(KA(), lds, l); if (PM(2)) phase_n1(KA(), lds, l); } SEAM(pb + 0);
        if (PM(3) && IN(pb + 1)) { pg8::Gemm g{(const bf16*)(KA()->ws + WS_H), (const bf16*)(KA()->ws + WS_WIN), D}; pg8::StaticOrder S; S.init(MROWS, NP, GRD(), BID());
            pg8::EpiG1 E{(bf16*)(KA()->ws + WS_P)}; pg8::gemm_phase<pg8::EpiG1, pg8::StaticOrder, true, true>(lds, g, S, E); } SEAM(pb + 1);
        if (PM(4) && IN(pb + 2)) { phase_prep(KA(), l); } SEAM(pb + 2);
        if (IN(pb + 3)) { if (PM(5)) phase_scan_mfma(KA(), lds, l); if (PM(6)) phase_na_naive(KA(), l, last); } SEAM(pb + 3);
        if (PM(7) && IN(pb + 4)) { phase_ln(KA(), l, last); } SEAM(pb + 4);
        if (PM(8) && IN(pb + 5)) {
            { pg8::Gemm g{(const bf16*)(KA()->ws + WS_HA), (const bf16*)(KA()->ws + WS_WBRA), D}; pg8::StaticOrder S; S.init(Mrows, D, GRD(), BID());
              pg8::EpiMGa E{(const bf16*)(KA()->ws + WS_P), (float*)(KA()->ws + WS_T32)}; pg8::gemm_phase<pg8::EpiMGa, pg8::StaticOrder, false, true>(lds, g, S, E); }
            { pg8::Gemm g{(const bf16*)(KA()->ws + WS_HB), (const bf16*)(KA()->ws + WS_WBRB), D}; pg8::StaticOrder S; S.init(Mrows, D, GRD(), BID());
              pg8::EpiMGb E{(const bf16*)(KA()->ws + WS_P), (const float*)(KA()->ws + WS_T32), (bf16*)(KA()->ws + WS_U)}; pg8::gemm_phase<pg8::EpiMGb, pg8::StaticOrder, false, true>(lds, g, S, E); }
        } SEAM(pb + 5);
        if (PM(9) && IN(pb + 6)) { pg8::Gemm g{(const bf16*)(KA()->ws + WS_U), (const bf16*)(KA()->ws + WS_WOUT), D}; pg8::StaticOrder S; S.init(Mrows, D, GRD(), BID());
            const float* xl = (l == 0) ? KA()->in[0] : (const float*)(KA()->ws + WS_XR); const float* xc = (l == 0) ? KA()->in[2] : (const float*)(KA()->ws + WS_XR) + (size_t)ML * D;
            pg8::EpiRes E{xl, xc, (float*)(KA()->ws + WS_XR), MODl + 2048}; pg8::gemm_phase<pg8::EpiRes, pg8::StaticOrder, false, true>(lds, g, S, E); } SEAM(pb + 6);
        if (PM(10) && IN(pb + 7)) { phase_n2(KA(), lds, l, last); } SEAM(pb + 7);
        if (!moe) {
            if (PM(11) && IN(pb + 8)) { pg8::Gemm g{(const bf16*)(KA()->ws + WS_H), (const bf16*)(KA()->ws + WS_W13), D}; pg8::StaticOrder S; S.init(Mrows, 2 * FF, GRD(), BID());
                pg8::EpiSwiglu E{(bf16*)(KA()->ws + WS_ACT), FF}; pg8::gemm_phase<pg8::EpiSwiglu, pg8::StaticOrder, true, true>(lds, g, S, E); } SEAM(pb + 8);
            if (PM(12) && IN(pb + 9)) { pg8::Gemm g{(const bf16*)(KA()->ws + WS_ACT), (const bf16*)(KA()->ws + WS_W2), FF}; pg8::StaticOrder S; S.init(Mrows, D, GRD(), BID());
                const float* xr = (const float*)(KA()->ws + WS_XR);
                pg8::EpiRes E{xr, xr + (size_t)ML * D, (float*)(KA()->ws + WS_XR), MODl + 5120}; pg8::gemm_phase<pg8::EpiRes, pg8::StaticOrder, false, true>(lds, g, S, E); } SEAM(pb + 9);
        } else {
            if (PM(13) && (IN(pb + 8) || IN(pb + 9))) {
                int cum[NE + 1]; load_tile_prefix((unsigned*)(KA()->ws + WS_CTL) + CW_CNT + (l >> 1) * 64, cum);
                pg8::MoeOrder S; S.G = GRD(); S.c = BID(); S.TT = __builtin_amdgcn_readfirstlane(cum[8]);
                S.c1 = __builtin_amdgcn_readfirstlane(cum[1]); S.c2 = __builtin_amdgcn_readfirstlane(cum[2]); S.c3 = __builtin_amdgcn_readfirstlane(cum[3]); S.c4 = __builtin_amdgcn_readfirstlane(cum[4]);
                S.c5 = __builtin_amdgcn_readfirstlane(cum[5]); S.c6 = __builtin_amdgcn_readfirstlane(cum[6]); S.c7 = __builtin_amdgcn_readfirstlane(cum[7]);
                if (IN(pb + 8)) { S.nN = 2 * FFE / 256; S.a_estride = ECAP; S.b_estride = 2 * FFE;
                    pg8::Gemm g{(const bf16*)(KA()->ws + WS_H2S), (const bf16*)(KA()->ws + WS_W13), D};
                    pg8::EpiSwiglu E{(bf16*)(KA()->ws + WS_ACT), FFE}; pg8::gemm_phase<pg8::EpiSwiglu, pg8::MoeOrder, true, true>(lds, g, S, E); }
                SEAM(pb + 8);
                if (IN(pb + 9)) { S.nN = D / 256; S.a_estride = 0; S.b_estride = D;
                    pg8::Gemm g{(const bf16*)(KA()->ws + WS_ACT), (const bf16*)(KA()->ws + WS_W2), FFE};
                    pg8::EpiF32 E{(float*)(KA()->ws + WS_YS)}; pg8::gemm_phase<pg8::EpiF32, pg8::MoeOrder, false, true>(lds, g, S, E); }
            }
            SEAM(pb + 9);
        }
    }
    if (PM(14) && IN(N_PHASES - 1)) phase_final(KA());
#undef IN
#undef SEAM
}

extern "C" void kernel_launch(void* const* d_in, const int* in_sizes, int n_in, void* d_out, int out_size, void* d_ws, size_t ws_size, hipStream_t stream) {
    static int grid = 0;
    if (grid == 0) {
        if (n_in != 24 || out_size != ML * D || ws_size < WS_END) { fprintf(stderr, "kernel_launch: unexpected shapes / workspace (%d inputs, out %d, ws %zu < %zu)\n", n_in, out_size, ws_size, (size_t)WS_END); grid = -1; return; }
        int dev = 0, cus = 0;
        if (hipGetDevice(&dev) != hipSuccess || hipDeviceGetAttribute(&cus, hipDeviceAttributeMultiprocessorCount, dev) != hipSuccess) { grid = -1; return; }
        if (hipFuncSetAttribute((const void*)fwd, hipFuncAttributeMaxDynamicSharedMemorySize, LDS_BYTES) != hipSuccess) { fprintf(stderr, "kernel_launch: hipFuncSetAttribute failed\n"); grid = -1; return; }
        int per_cu = 0; (void)hipOccupancyMaxActiveBlocksPerMultiprocessor(&per_cu, (const void*)fwd, 512, LDS_BYTES); (void)hipGetLastError();
        if (per_cu < 1) fprintf(stderr, "kernel_launch: occupancy query reports %d\n", per_cu);
        grid = cus;
    }
    if (grid < 0) return;
    (void)hipMemsetAsync((char*)d_ws + WS_CTL, 0, CTL_ZERO_BYTES, stream);
    Args a{};
    for (int i = 0; i < 24; ++i) a.in[i] = (const float*)d_in[i];
    a.out = (float*)d_out; a.ws = (unsigned char*)d_ws;
#if MK_PER_PHASE
    for (int p = 0; p < N_PHASES; ++p) { a.ph_lo = p; a.ph_hi = p + 1; hipLaunchKernelGGL(fwd, dim3(grid), dim3(512), LDS_BYTES, stream, a); }
#else
    a.ph_lo = 0; a.ph_hi = N_PHASES; hipLaunchKernelGGL(fwd, dim3(grid), dim3(512), LDS_BYTES, stream, a);
#endif
}
```

```cpp
#include <hip/hip_runtime.h>
#include <cstdio>
#include <cstdint>

#ifndef MK_PER_PHASE
#define MK_PER_PHASE 0
#endif

#define LAS __attribute__((address_space(3)))
typedef unsigned short bf16;
typedef short bf16x8 __attribute__((ext_vector_type(8)));
typedef float f32x4 __attribute__((ext_vector_type(4)));
typedef float f32x2 __attribute__((ext_vector_type(2)));
typedef unsigned u32x4 __attribute__((ext_vector_type(4)));
typedef unsigned u32x2 __attribute__((ext_vector_type(2)));

constexpr int D = 1024, NB = 8, TL = 2048, TC = 256, DEPTH = 4;
constexpr int ML = NB * TL, MC = NB * TC, MROWS = ML + MC;
constexpr int DIN = 8208, NP = 8192;
constexpr int PC_Q = 0, PC_K = 512, PC_V = 1024, PC_O = 2048, PC_NQ = 3072, PC_NK = 4096, PC_NV = 5120, PC_GA = 6144, PC_GB = 7168;
constexpr int FF = 2816, FFE = 3584, NE = 8;
constexpr int ECAP = MROWS;
constexpr int MOE_ROWS = 38912;
constexpr float EPS = 1e-6f;

constexpr size_t MiB = 1u << 20;
constexpr size_t WS_CTL = 0, CTL_ZERO_BYTES = 1 * MiB;
constexpr size_t WS_MOD = 1 * MiB;
constexpr size_t WS_RTI = 2 * MiB;
constexpr size_t WS_RTW = 2 * MiB + 512 * 1024;
constexpr size_t WS_GPRE = 3 * MiB;
constexpr size_t WS_XR = 5 * MiB;
constexpr size_t WS_H = 77 * MiB;
constexpr size_t WS_WIN = 113 * MiB;
constexpr size_t WS_WBRA = 129 * MiB, WS_WBRB = 131 * MiB, WS_WOUT = 133 * MiB;
constexpr size_t WS_W13 = 135 * MiB;
constexpr size_t WS_W2 = 247 * MiB;
constexpr size_t WS_GA = 303 * MiB;
constexpr size_t WS_P = WS_GA;
constexpr size_t WS_QK = WS_GA + 288 * MiB;
constexpr size_t WS_HS = WS_GA + 324 * MiB;
constexpr size_t WS_HB = WS_GA + 468 * MiB;
constexpr size_t WS_HA = WS_GA + 504 * MiB;
constexpr size_t WS_T32 = WS_GA + 540 * MiB;
constexpr size_t WS_U = WS_GA + 612 * MiB;
constexpr size_t WS_ACT = WS_GA;
constexpr size_t WS_H2S = WS_GA + 266 * MiB;
constexpr size_t WS_YS = WS_GA + 554 * MiB;
constexpr size_t WS_END = WS_GA + 706 * MiB;
static_assert((size_t)MOE_ROWS * FFE * 2 <= 266 * MiB && (size_t)NE * ECAP * D * 2 <= 288 * MiB && (size_t)MOE_ROWS * D * 4 <= 152 * MiB, "ffn view");

constexpr int CW_BAR = 4096;
constexpr int CW_CNT = 16384;

constexpr int RING_BYTES = 131072;
constexpr int LDS_BYTES = 147456;
constexpr int MISC_OFF = LDS_BYTES - 256;

__device__ __forceinline__ unsigned f2bf(float f) { unsigned u = __builtin_bit_cast(unsigned, f); return (u + 0x7fffu + ((u >> 16) & 1u)) >> 16; }
__device__ __forceinline__ unsigned pk2(float lo, float hi) { return f2bf(lo) | (f2bf(hi) << 16); }
__device__ __forceinline__ float bf2f(unsigned b) { return __builtin_bit_cast(float, b << 16); }
__device__ __forceinline__ float bflo(unsigned w) { return __builtin_bit_cast(float, w << 16); }
__device__ __forceinline__ float bfhi(unsigned w) { return __builtin_bit_cast(float, w & 0xffff0000u); }
__device__ __forceinline__ float sigmoidf_(float x) { return 1.f / (1.f + __expf(-x)); }
__device__ __forceinline__ float wave_sum(float v) {
#pragma unroll
    for (int o = 1; o < 64; o <<= 1) v += __shfl_xor(v, o);
    return v;
}
__device__ __forceinline__ float wave_max(float v) {
#pragma unroll
    for (int o = 1; o < 64; o <<= 1) v = fmaxf(v, __shfl_xor(v, o));
    return v;
}
__device__ __forceinline__ int TID() { int t = threadIdx.x; asm volatile("" : "+v"(t)); return t; }
__device__ __forceinline__ int BID() { int b = blockIdx.x; asm volatile("" : "+s"(b)); return b; }
__device__ __forceinline__ int GRD() { int g = gridDim.x; asm volatile("" : "+s"(g)); return g; }
#define LDS_WAIT() asm volatile("s_waitcnt lgkmcnt(0)" ::: "memory")

namespace pg8 {
constexpr int BM = 256, BK = 64, HALF = 128, HTB = HALF * BK * 2, STAGE_BYTES = 8 * HTB, NXCD = 8, WGM = 8;
__host__ __device__ __forceinline__ int lds_byte(int r, int c) { const int st = (r >> 4) * 2 + (c >> 5), rr = r & 15, cc = c & 31, ob = rr * 64 + cc * 2; return st * 1024 + (ob ^ (((ob >> 9) & 1) << 5)); }
__host__ __device__ __forceinline__ void stage_rc(int b, int& R, int& C) { const int st = b / 1024, sb = b % 1024, swz = sb ^ (((sb >> 9) & 1) << 5); R = (st >> 1) * 16 + swz / 64; C = (st & 1) * 32 + (swz % 64) / 2; }
__host__ __device__ __forceinline__ int perm32(int rho) { const int n = rho >> 4, i = rho & 15; return 8 * (i >> 2) + 4 * n + (i & 3); }

struct Unit { int arow, brow, orow, ocol, aux; };
struct Gemm { const bf16* A; const bf16* Bt; int K; };

struct StaticOrder {
    int nM, nN, nwg, G, c;
    __device__ void init(int M, int N, int G_, int c_) { nM = M / BM; nN = N / BM; nwg = nM * nN; G = G_; c = c_; }
    __device__ __forceinline__ bool next(int i, Unit& u) const {
        const long L = (long)i * G + c; if (L >= nwg) return false;
        int wgid = (int)L; { const int q = nwg / NXCD, r = nwg % NXCD, xcd = wgid % NXCD, off = wgid / NXCD; wgid = (xcd < r ? xcd * (q + 1) : r * (q + 1) + (xcd - r) * q) + off; }
        const int nig = WGM * nN, gid = wgid / nig, fm = gid * WGM, gsz = (nM - fm) < WGM ? (nM - fm) : WGM;
        const int pm = fm + ((wgid % nig) % gsz), pn = (wgid % nig) / gsz;
        u.arow = pm * BM; u.brow = pn * BM; u.orow = pm * BM; u.ocol = pn * BM; u.aux = 0; return true;
    }
};
struct MoeOrder {
    int nN, G, c, TT; int c1, c2, c3, c4, c5, c6, c7;
    int a_estride;
    int b_estride;
    __device__ __forceinline__ bool next(int i, Unit& u) const {
        const int nwg = TT * nN; const long L = (long)i * G + c; if (L >= nwg) return false;
        int wgid = (int)L; { const int q = nwg / NXCD, r = nwg % NXCD, xcd = wgid % NXCD, off = wgid / NXCD; wgid = (xcd < r ? xcd * (q + 1) : r * (q + 1) + (xcd - r) * q) + off; }
        const int nig = WGM * nN, gid = wgid / nig, fm = gid * WGM, gsz = (TT - fm) < WGM ? (TT - fm) : WGM;
        const int g = fm + ((wgid % nig) % gsz), pn = (wgid % nig) / gsz;
        const int e = (g >= c1) + (g >= c2) + (g >= c3) + (g >= c4) + (g >= c5) + (g >= c6) + (g >= c7);
        int cb = 0; cb = e >= 1 ? c1 : cb; cb = e >= 2 ? c2 : cb; cb = e >= 3 ? c3 : cb; cb = e >= 4 ? c4 : cb; cb = e >= 5 ? c5 : cb; cb = e >= 6 ? c6 : cb; cb = e >= 7 ? c7 : cb;
        const int rt = g - cb;
        u.arow = a_estride ? e * a_estride + rt * BM : g * BM; u.brow = e * b_estride + pn * BM; u.orow = g * BM; u.ocol = pn * BM; u.aux = e; return true;
    }
};

__device__ __forceinline__ unsigned cvt_pk_bf16(float lo, float hi) { unsigned r; asm volatile("v_cvt_pk_bf16_f32 %0, %1, %2" : "=v"(r) : "v"(lo), "v"(hi)); return r; }

template <class Epi, class Sched, bool ALIGN_EPI = false, bool SP2 = true>
__device__ __forceinline__ void gemm_phase(LAS unsigned char* lds, const Gemm g, const Sched& S, const Epi& E) {
    const int tid = TID(), wid = __builtin_amdgcn_readfirstlane(tid >> 6), lane = tid & 63, wr = wid >> 2, wc = wid & 3, fr = lane & 15, fq = lane >> 4;
    const int K = g.K, nt = K / BK;
    unsigned voffA[2], voffB[2];
#pragma unroll
    for (int i = 0; i < 2; ++i) { int R, C; stage_rc(tid * 16 + i * 8192, R, C); const int Rb = Epi::PERM ? ((R & ~31) + perm32(R & 31)) : R;
        voffA[i] = (unsigned)(R * K + C) * 2u; voffB[i] = (unsigned)(Rb * K + C) * 2u; }
    const size_t kstep = (size_t)(BK * 2);
    const size_t hstep = (size_t)HALF * K * 2;
    const size_t rstep = (size_t)K * 2;
    const unsigned ldsw = (unsigned)wid * 1024u;
    const int aoff = lds_byte(wr * 64 + fr, fq * 8), boff = lds_byte(wc * 32 + fr, fq * 8);
#define PG8_SA(b, h) (((b) * 2 + (h)) * HTB)
#define PG8_SB(b, h) ((4 + (b) * 2 + (h)) * HTB)
#define PG8_STAGE(bufoff, gbase, voff) do { _Pragma("unroll") for (int _i = 0; _i < 2; ++_i) \
        __builtin_amdgcn_global_load_lds((const unsigned*)((const char*)(gbase) + (voff)[_i]), (LAS unsigned*)(lds + (bufoff) + ldsw + _i * 8192), 16, 0, 0); } while (0)
#define PG8_LDA(dst, b, h) do { _Pragma("unroll") for (int m = 0; m < 4; ++m) _Pragma("unroll") for (int k = 0; k < 2; ++k) dst[m][k] = *(const LAS bf16x8*)(lds + PG8_SA(b, h) + aoff + m * 2048 + k * 1024); } while (0)
#define PG8_LDB(dst, b, h) do { _Pragma("unroll") for (int n = 0; n < 2; ++n) _Pragma("unroll") for (int k = 0; k < 2; ++k) dst[n][k] = *(const LAS bf16x8*)(lds + PG8_SB(b, h) + boff + n * 2048 + k * 1024); } while (0)
#define PG8_MMA(ai, bj, At, Bt) do { __builtin_amdgcn_s_setprio(1); _Pragma("unroll") for (int m = 0; m < 4; ++m) _Pragma("unroll") for (int n = 0; n < 2; ++n) _Pragma("unroll") for (int k = 0; k < 2; ++k) \
        acc[ai][bj][m][n] = __builtin_amdgcn_mfma_f32_16x16x32_bf16(Bt[n][k], At[m][k], acc[ai][bj][m][n], 0, 0, 0); __builtin_amdgcn_s_setprio(0); } while (0)
#define PG8_WAIT_V(n) asm volatile("s_waitcnt vmcnt(" #n ")" ::: "memory")
#define PG8_WAIT_L(n) asm volatile("s_waitcnt lgkmcnt(" #n ")" ::: "memory")
#define PG8_BAR __builtin_amdgcn_s_barrier()
#define PG8_SCHED __builtin_amdgcn_sched_barrier(0)
    Unit cur, nxt; int ui = 0;
    if (!S.next(0, cur)) return;
    f32x4 acc[2][2][4][2];
#pragma unroll
    for (int a = 0; a < 2; ++a)
#pragma unroll
        for (int b = 0; b < 2; ++b)
#pragma unroll
            for (int m = 0; m < 4; ++m)
#pragma unroll
                for (int n = 0; n < 2; ++n) acc[a][b][m][n] = (f32x4){0.f, 0.f, 0.f, 0.f};
    bf16x8 At[4][2], B0[2][2], B1[2][2];
    const char* cA = (const char*)g.A + (size_t)cur.arow * rstep; const char* cB = (const char*)g.Bt + (size_t)cur.brow * rstep;
    if constexpr (SP2) {
        PG8_STAGE(PG8_SB(0, 0), cB, voffB); PG8_STAGE(PG8_SB(0, 1), cB + hstep, voffB); PG8_STAGE(PG8_SA(0, 0), cA, voffA); PG8_STAGE(PG8_SA(0, 1), cA + hstep, voffA);
        if (wr == 1) PG8_BAR;
        PG8_WAIT_V(2); PG8_BAR;
        PG8_STAGE(PG8_SB(1, 0), cB + kstep, voffB); PG8_STAGE(PG8_SA(1, 0), cA + kstep, voffA); PG8_STAGE(PG8_SB(1, 1), cB + hstep + kstep, voffB);
        PG8_WAIT_V(6); PG8_BAR;
    } else {
        PG8_STAGE(PG8_SB(0, 0), cB, voffB); PG8_STAGE(PG8_SA(0, 0), cA, voffA); PG8_STAGE(PG8_SB(0, 1), cB + hstep, voffB); PG8_STAGE(PG8_SA(0, 1), cA + hstep, voffA);
        if (wr == 1) PG8_BAR;
        PG8_WAIT_V(4); PG8_BAR;
        PG8_STAGE(PG8_SB(1, 0), cB + kstep, voffB); PG8_STAGE(PG8_SA(1, 0), cA + kstep, voffA); PG8_STAGE(PG8_SB(1, 1), cB + hstep + kstep, voffB);
        PG8_WAIT_V(6); PG8_BAR;
    }
    for (;;) {
        const bool has_next = S.next(ui + 1, nxt);
        const char* nA = has_next ? (const char*)g.A + (size_t)nxt.arow * rstep : cA; const char* nB = has_next ? (const char*)g.Bt + (size_t)nxt.brow * rstep : cB;
        for (int t = 0; t < nt; t += 2) {
            const bool last = (t == nt - 2);
            const char* a1 = cA + (size_t)(t + 1) * kstep;
            const char* a2 = last ? nA : cA + (size_t)(t + 2) * kstep; const char* b2 = last ? nB : cB + (size_t)(t + 2) * kstep;
            const char* a3 = a2 + kstep; const char* b3 = b2 + kstep;
            if constexpr (SP2) {
            PG8_LDB(B0, 0, 0); PG8_LDB(B1, 0, 1); PG8_SCHED; PG8_LDA(At, 0, 0); PG8_STAGE(PG8_SA(1, 1), a1 + hstep, voffA);
            PG8_WAIT_V(8); PG8_WAIT_L(0); PG8_BAR; PG8_MMA(0, 0, At, B0); PG8_MMA(0, 1, At, B1); PG8_BAR; PG8_SCHED;
            PG8_LDA(At, 0, 1); PG8_STAGE(PG8_SB(0, 0), b2, voffB); PG8_STAGE(PG8_SB(0, 1), b2 + hstep, voffB); PG8_STAGE(PG8_SA(0, 0), a2, voffA);
            PG8_WAIT_V(8); PG8_WAIT_L(0); PG8_BAR; PG8_MMA(1, 0, At, B0); PG8_MMA(1, 1, At, B1); PG8_BAR; PG8_SCHED;
            PG8_LDB(B0, 1, 0); PG8_LDB(B1, 1, 1); PG8_SCHED; PG8_LDA(At, 1, 0); PG8_STAGE(PG8_SA(0, 1), a2 + hstep, voffA);
            PG8_WAIT_V(8); PG8_WAIT_L(0); PG8_BAR; PG8_MMA(0, 0, At, B0); PG8_MMA(0, 1, At, B1); PG8_BAR; PG8_SCHED;
            PG8_LDA(At, 1, 1); PG8_STAGE(PG8_SB(1, 0), b3, voffB); PG8_STAGE(PG8_SB(1, 1), b3 + hstep, voffB); PG8_STAGE(PG8_SA(1, 0), a3, voffA);
            PG8_WAIT_V(8); PG8_WAIT_L(0); PG8_BAR; PG8_MMA(1, 0, At, B0); PG8_MMA(1, 1, At, B1); PG8_BAR; PG8_SCHED;
            } else {
            PG8_LDB(B0, 0, 0); PG8_SCHED; PG8_LDA(At, 0, 0); PG8_STAGE(PG8_SA(1, 1), a1 + hstep, voffA);
            PG8_WAIT_L(8); PG8_BAR; PG8_WAIT_L(0); PG8_MMA(0, 0, At, B0); PG8_BAR; PG8_SCHED;
            PG8_LDB(B1, 0, 1); PG8_STAGE(PG8_SB(0, 0), b2, voffB);
            PG8_BAR; PG8_WAIT_L(0); PG8_MMA(0, 1, At, B1); PG8_BAR;
            PG8_LDA(At, 0, 1); PG8_STAGE(PG8_SA(0, 0), a2, voffA);
            PG8_BAR; PG8_WAIT_L(0); PG8_MMA(1, 0, At, B0); PG8_BAR; PG8_SCHED;
            PG8_STAGE(PG8_SB(0, 1), b2 + hstep, voffB);
            PG8_WAIT_V(6); PG8_BAR; PG8_MMA(1, 1, At, B1); PG8_BAR;
            PG8_LDB(B0, 1, 0); PG8_SCHED; PG8_LDA(At, 1, 0); PG8_STAGE(PG8_SA(0, 1), a2 + hstep, voffA);
            PG8_WAIT_L(8); PG8_BAR; PG8_WAIT_L(0); PG8_MMA(0, 0, At, B0); PG8_BAR; PG8_SCHED;
            PG8_LDB(B1, 1, 1); PG8_STAGE(PG8_SB(1, 0), b3, voffB);
            PG8_BAR; PG8_WAIT_L(0); PG8_MMA(0, 1, At, B1); PG8_BAR;
            PG8_LDA(At, 1, 1); PG8_STAGE(PG8_SA(1, 0), a3, voffA);
            PG8_BAR; PG8_WAIT_L(0); PG8_MMA(1, 0, At, B0); PG8_BAR; PG8_SCHED;
            PG8_STAGE(PG8_SB(1, 1), b3 + hstep, voffB);
            PG8_WAIT_V(6); PG8_BAR; PG8_MMA(1, 1, At, B1); PG8_BAR;
            }
        }
        if constexpr (ALIGN_EPI) { if (wr == 0) PG8_BAR; }
        E(acc, cur, wr, wc, fr, fq);
        if (!has_next) break;
#pragma unroll
        for (int a = 0; a < 2; ++a)
#pragma unroll
            for (int b = 0; b < 2; ++b)
#pragma unroll
                for (int m = 0; m < 4; ++m)
#pragma unroll
                    for (int n = 0; n < 2; ++n) acc[a][b][m][n] = (f32x4){0.f, 0.f, 0.f, 0.f};
        cur = nxt; cA = nA; cB = nB; ++ui;
        if constexpr (ALIGN_EPI) { if (wr == 1) PG8_BAR; }
    }
    PG8_WAIT_V(0);
    if constexpr (!ALIGN_EPI) { if (wr == 0) PG8_BAR; }
    PG8_BAR;
#undef PG8_SA
#undef PG8_SB
#undef PG8_STAGE
#undef PG8_LDA
#undef PG8_LDB
#undef PG8_MMA
#undef PG8_WAIT_V
#undef PG8_WAIT_L
#undef PG8_BAR
#undef PG8_SCHED
}

typedef const f32x4 (&AccRef)[2][2][4][2];
struct EpiG1 {
    static constexpr bool PERM = true;
    bf16* O;
    __device__ __forceinline__ void operator()(AccRef acc, const Unit& u, int wr, int wc, int fr, int fq) const {
        const int t = u.ocol >> 8; const int mode = ((t >= 8 && t < 12) || t >= 24) ? 1 : ((t >= 12 && t < 16) ? 2 : 0);
        const int row0 = u.orow + wr * 64 + fr, col0 = u.ocol + wc * 32 + 8 * fq;
#pragma unroll
        for (int ai = 0; ai < 2; ++ai)
#pragma unroll
            for (int m = 0; m < 4; ++m) { bf16* rowp = O + (size_t)(row0 + ai * HALF + m * 16) * NP + col0;
#pragma unroll
                for (int bj = 0; bj < 2; ++bj) { f32x4 v0 = acc[ai][bj][m][0], v1 = acc[ai][bj][m][1];
                    if (mode == 1) {
#pragma unroll
                        for (int j = 0; j < 4; ++j) { v0[j] = sigmoidf_(v0[j]); v1[j] = sigmoidf_(v1[j]); } }
                    else if (mode == 2) { v0 = v0 * 0.125f; v1 = v1 * 0.125f; }
                    u32x4 w; w.x = cvt_pk_bf16(v0[0], v0[1]); w.y = cvt_pk_bf16(v0[2], v0[3]); w.z = cvt_pk_bf16(v1[0], v1[1]); w.w = cvt_pk_bf16(v1[2], v1[3]);
                    *(u32x4*)(rowp + bj * HALF) = w; } }
    }
};
struct EpiMGa {
    static constexpr bool PERM = true;
    const bf16* P; float* T;
    __device__ __forceinline__ void operator()(AccRef acc, const Unit& u, int wr, int wc, int fr, int fq) const {
        const int row0 = u.orow + wr * 64 + fr, col0 = u.ocol + wc * 32 + 8 * fq;
#pragma unroll
        for (int ai = 0; ai < 2; ++ai)
#pragma unroll
            for (int m = 0; m < 4; ++m) { const size_t r = (size_t)(row0 + ai * HALF + m * 16);
#pragma unroll
                for (int bj = 0; bj < 2; ++bj) { const int c = col0 + bj * HALF;
                    const u32x4 gw = *(const u32x4*)(P + r * NP + PC_GA + c);
                    f32x4 v0 = acc[ai][bj][m][0], v1 = acc[ai][bj][m][1];
                    v0[0] *= bflo(gw.x); v0[1] *= bfhi(gw.x); v0[2] *= bflo(gw.y); v0[3] *= bfhi(gw.y);
                    v1[0] *= bflo(gw.z); v1[1] *= bfhi(gw.z); v1[2] *= bflo(gw.w); v1[3] *= bfhi(gw.w);
                    *(f32x4*)(T + r * D + c) = v0; *(f32x4*)(T + r * D + c + 4) = v1; } }
    }
};
struct EpiMGb {
    static constexpr bool PERM = true;
    const bf16* P; const float* T; bf16* U;
    __device__ __forceinline__ void operator()(AccRef acc, const Unit& u, int wr, int wc, int fr, int fq) const {
        const int row0 = u.orow + wr * 64 + fr, col0 = u.ocol + wc * 32 + 8 * fq;
#pragma unroll
        for (int ai = 0; ai < 2; ++ai)
#pragma unroll
            for (int m = 0; m < 4; ++m) { const size_t r = (size_t)(row0 + ai * HALF + m * 16);
#pragma unroll
                for (int bj = 0; bj < 2; ++bj) { const int c = col0 + bj * HALF;
                    const u32x4 gw = *(const u32x4*)(P + r * NP + PC_GB + c);
                    const f32x4 t0 = *(const f32x4*)(T + r * D + c), t1 = *(const f32x4*)(T + r * D + c + 4);
                    f32x4 v0 = acc[ai][bj][m][0], v1 = acc[ai][bj][m][1];
                    v0[0] = t0[0] + v0[0] * bflo(gw.x); v0[1] = t0[1] + v0[1] * bfhi(gw.x); v0[2] = t0[2] + v0[2] * bflo(gw.y); v0[3] = t0[3] + v0[3] * bfhi(gw.y);
                    v1[0] = t1[0] + v1[0] * bflo(gw.z); v1[1] = t1[1] + v1[1] * bfhi(gw.z); v1[2] = t1[2] + v1[2] * bflo(gw.w); v1[3] = t1[3] + v1[3] * bfhi(gw.w);
                    u32x4 w; w.x = cvt_pk_bf16(v0[0], v0[1]); w.y = cvt_pk_bf16(v0[2], v0[3]); w.z = cvt_pk_bf16(v1[0], v1[1]); w.w = cvt_pk_bf16(v1[2], v1[3]);
                    *(u32x4*)(U + r * D + c) = w; } }
    }
};
struct EpiRes {
    static constexpr bool PERM = false;
    const float* xin_lat; const float* xin_ctx; float* XO; const float* gate;
    __device__ __forceinline__ void operator()(AccRef acc, const Unit& u, int wr, int wc, int fr, int fq) const {
        const int row0 = u.orow + wr * 64 + fr, col0 = u.ocol + wc * 32 + 4 * fq;
        const int mr = u.orow < ML ? (u.orow >> 11) : 8;
        const float* gp = gate + (size_t)mr * 6144 + col0;
        f32x4 gv[2][2];
#pragma unroll
        for (int bj = 0; bj < 2; ++bj)
#pragma unroll
            for (int n = 0; n < 2; ++n) gv[bj][n] = *(const f32x4*)(gp + bj * HALF + n * 16);
        const float* xb = u.orow < ML ? xin_lat : xin_ctx - (size_t)ML * D;
#pragma unroll
        for (int ai = 0; ai < 2; ++ai)
#pragma unroll
            for (int m = 0; m < 4; ++m) { const size_t r = (size_t)(row0 + ai * HALF + m * 16);
#pragma unroll
                for (int bj = 0; bj < 2; ++bj)
#pragma unroll
                    for (int n = 0; n < 2; ++n) { const int c = col0 + bj * HALF + n * 16;
                        const f32x4 xi = *(const f32x4*)(xb + r * D + c);
                        *(f32x4*)(XO + r * D + c) = xi + gv[bj][n] * acc[ai][bj][m][n]; } }
    }
};
struct EpiF32 {
    static constexpr bool PERM = false;
    float* Y;
    __device__ __forceinline__ void operator()(AccRef acc, const Unit& u, int wr, int wc, int fr, int fq) const {
        const int row0 = u.orow + wr * 64 + fr, col0 = u.ocol + wc * 32 + 4 * fq;
#pragma unroll
        for (int ai = 0; ai < 2; ++ai)
#pragma unroll
            for (int m = 0; m < 4; ++m) { const size_t r = (size_t)(row0 + ai * HALF + m * 16);
#pragma unroll
                for (int bj = 0; bj < 2; ++bj)
#pragma unroll
                    for (int n = 0; n < 2; ++n) *(f32x4*)(Y + r * D + col0 + bj * HALF + n * 16) = acc[ai][bj][m][n]; }
    }
};
struct EpiSwiglu {
    static constexpr bool PERM = false;
    bf16* ACT; int ldf;
    __device__ __forceinline__ void operator()(AccRef acc, const Unit& u, int wr, int wc, int fr, int fq) const {
        const int row0 = u.orow + wr * 64 + fr, f0 = (u.ocol >> 1) + wc * 16 + 4 * fq;
#pragma unroll
        for (int ai = 0; ai < 2; ++ai)
#pragma unroll
            for (int m = 0; m < 4; ++m) { const size_t r = (size_t)(row0 + ai * HALF + m * 16);
#pragma unroll
                for (int bj = 0; bj < 2; ++bj) { const f32x4 a = acc[ai][bj][m][0], b = acc[ai][bj][m][1]; f32x4 o;
#pragma unroll
                    for (int j = 0; j < 4; ++j) o[j] = a[j] * sigmoidf_(a[j]) * b[j];
                    u32x2 w; w.x = cvt_pk_bf16(o[0], o[1]); w.y = cvt_pk_bf16(o[2], o[3]);
                    *(u32x2*)(ACT + r * ldf + f0 + bj * 64) = w; } }
    }
};
}

#define XB_TMO      128
#define XB_XCNT(j)  (256  + 64 * (j))
#define XB_XSUB(j)  (1280 + 64 * (j))
#define XB_XGEN(j)  (2304 + 64 * (j))
#define XB_TOP      3328
#define XB_TOPGEN   3392
#define XCD_BAR_WORDS 3456
#define XB_SPIN_CAP (1u << 18)
__device__ __forceinline__ unsigned xb_ld(unsigned* p)              { return __hip_atomic_load(p, __ATOMIC_RELAXED, __HIP_MEMORY_SCOPE_AGENT); }
__device__ __forceinline__ unsigned xb_add(unsigned* p, unsigned v) { return __hip_atomic_fetch_add(p, v, __ATOMIC_RELAXED, __HIP_MEMORY_SCOPE_AGENT); }
__device__ __forceinline__ unsigned xb_xcc_id() { return (unsigned)__builtin_amdgcn_s_getreg((3 << 11) | 20) & 0xFu; }
#define XB_SPIN(cond, bar) do { unsigned _sp = 0; while (cond) { __builtin_amdgcn_s_sleep(1); \
    if ((++_sp & 255u) == 0u) { if (xb_ld(&(bar)[XB_TMO])) break; if (_sp > XB_SPIN_CAP) { atomicAdd(&(bar)[XB_TMO], 1u); break; } } } } while (0)
struct XcdBarrier { unsigned* bar; unsigned x; volatile LAS unsigned* st; };
__device__ __forceinline__ XcdBarrier xcd_barrier_post(unsigned* bar, volatile LAS unsigned* st) {
    XcdBarrier b; b.bar = bar; b.x = xb_xcc_id(); b.st = st;
    if (threadIdx.x == 0) (void)xb_add(&bar[XB_XCNT(b.x)], 1u);
    return b;
}
__device__ __forceinline__ void xcd_barrier_complete(unsigned* bar, unsigned x, unsigned& nloc, unsigned& nx) {
    const unsigned G = gridDim.x * gridDim.y * gridDim.z;
    unsigned sum, cnt, mine, sp = 0u;
    for (;;) {
        sum = 0u; cnt = 0u; mine = 0u;
#pragma unroll
        for (unsigned j = 0; j < 16; ++j) { const unsigned c = xb_ld(&bar[XB_XCNT(j)]); sum += c; cnt += (c > 0u) ? 1u : 0u; mine = (j == x) ? c : mine; }
        if (sum == G) break;
        __builtin_amdgcn_s_sleep(1);
        if ((++sp & 255u) == 0u) { if (xb_ld(&bar[XB_TMO])) break; if (sp > XB_SPIN_CAP) { atomicAdd(&bar[XB_TMO], 1u); break; } }
    }
    nloc = mine > 0u ? mine : 1u; nx = cnt > 0u ? cnt : 1u;
}
__device__ __forceinline__ void xcd_barrier(const XcdBarrier& b) {
    asm volatile("s_waitcnt vmcnt(0)" ::: "memory");
    __syncthreads();
    if (threadIdx.x == 0) {
        unsigned* bar = b.bar;
        __builtin_amdgcn_s_waitcnt(0);
        unsigned nloc = b.st[0], nx = b.st[1];
        if (nloc == 0u) { xcd_barrier_complete(bar, b.x, nloc, nx); b.st[0] = nloc; b.st[1] = nx; }
        const unsigned old = xb_add(&bar[XB_XSUB(b.x)], 1u);
        const unsigned gen = old / nloc;
        if (old + 1u == (gen + 1u) * nloc) {
            __builtin_amdgcn_fence(__ATOMIC_RELEASE, "agent");
            asm volatile("s_waitcnt vmcnt(0)" ::: "memory");
            const unsigned og = xb_add(&bar[XB_TOP], 1u);
            const unsigned tg = og / nx;
            if (og + 1u == (tg + 1u) * nx) xb_add(&bar[XB_TOPGEN], 1u);
            else XB_SPIN(xb_ld(&bar[XB_TOPGEN]) == tg, bar);
            __builtin_amdgcn_fence(__ATOMIC_ACQUIRE, "agent");
            xb_add(&bar[XB_XGEN(b.x)], 1u);
            asm volatile("s_waitcnt vmcnt(0)" ::: "memory");
        } else {
            XB_SPIN(xb_ld(&bar[XB_XGEN(b.x)]) == gen, bar);
            __builtin_amdgcn_fence(__ATOMIC_ACQUIRE, "agent");
            asm volatile("s_waitcnt vmcnt(0)" ::: "memory");
        }
    }
    __syncthreads();
}

struct Args { const float* in[24]; float* out; unsigned char* ws; int ph_lo, ph_hi; };
typedef const __attribute__((address_space(4))) Args* KArgs;
__device__ __forceinline__ KArgs KA() { KArgs p = (KArgs)__builtin_amdgcn_kernarg_segment_ptr(); asm volatile("" : "+s"(p)); return p; }
struct Ctx {
    LAS unsigned char* lds; int tid, lane, wave, G, vcu;
    const float* const* dummy;
};

__device__ __forceinline__ void phase_pre(KArgs a, LAS unsigned char* lds) {
    const int tid = TID(), G = GRD();
    LAS float* sv = (LAS float*)lds;
    LAS float* red = sv + 9 * 1024;
    const float* c = a->in[1]; const float* cc = a->in[3]; const float* w_mod = a->in[4]; const float* b_mod = a->in[5];
    float* MOD = (float*)(a->ws + WS_MOD);
    for (int i = tid; i < 9 * 1024; i += 512) { const int r = i >> 10, k = i & 1023; const float v = r < 8 ? c[r * 1024 + k] : cc[k]; sv[i] = v * sigmoidf_(v); }
    __syncthreads();
    for (int item = BID(); item < DEPTH * 48; item += G) {
        const int l = item / 48, n0 = (item % 48) * 128, kq = tid >> 7, cl = tid & 127;
        float acc[9];
#pragma unroll
        for (int r = 0; r < 9; ++r) acc[r] = 0.f;
        const float* w = w_mod + ((size_t)l * 1024 + kq * 256) * 6144 + n0 + cl;
#pragma unroll 4
        for (int k = 0; k < 256; ++k) { const float wv = w[(size_t)k * 6144];
#pragma unroll
            for (int r = 0; r < 9; ++r) acc[r] += sv[r * 1024 + kq * 256 + k] * wv; }
#pragma unroll
        for (int r = 0; r < 9; ++r) red[(kq * 9 + r) * 128 + cl] = acc[r];
        __syncthreads();
        for (int o = tid; o < 9 * 128; o += 512) { const int r = o >> 7, q = o & 127;
            const float s = red[(0 * 9 + r) * 128 + q] + red[(1 * 9 + r) * 128 + q] + red[(2 * 9 + r) * 128 + q] + red[(3 * 9 + r) * 128 + q] + b_mod[l * 6144 + n0 + q];
            MOD[(size_t)(l * 9 + r) * 6144 + n0 + q] = s; }
        __syncthreads();
    }
}

__device__ __forceinline__ void tr_item(const float* srcA, const float* srcB, int ld, bf16* dst, int K, int drow0, int k0, LAS float* scr, int lane) {
    const int nl = lane & 31; const float* s = nl < 16 ? srcA + nl : srcB + (nl - 16);
#pragma unroll 8
    for (int i = 0; i < 32; ++i) { const int kk = 2 * i + (lane >> 5); scr[kk * 33 + nl] = s[(size_t)(k0 + kk) * ld]; }
    LDS_WAIT(); asm volatile("" ::: "memory");
    const int c = lane & 7;
#pragma unroll
    for (int j = 0; j < 4; ++j) { const int n = (lane >> 3) + 8 * j; const LAS float* p = scr + (8 * c) * 33 + n;
        u32x4 o; o.x = pk2(p[0 * 33], p[1 * 33]); o.y = pk2(p[2 * 33], p[3 * 33]); o.z = pk2(p[4 * 33], p[5 * 33]); o.w = pk2(p[6 * 33], p[7 * 33]);
        *(u32x4*)(dst + (size_t)(drow0 + n) * K + k0 + 8 * c) = o; }
    LDS_WAIT(); asm volatile("" ::: "memory");
}
__device__ __forceinline__ void convert_layer(KArgs a, LAS unsigned char* lds, int l) {
    const int lane = TID() & 63, wave = TID() >> 6;
    LAS float* scr = (LAS float*)(lds + wave * 8704);
    const int gw = BID() * 8 + wave, NGW = GRD() * 8;
    bf16* WIN = (bf16*)(a->ws + WS_WIN); bf16* WBRA = (bf16*)(a->ws + WS_WBRA); bf16* WBRB = (bf16*)(a->ws + WS_WBRB); bf16* WOUT = (bf16*)(a->ws + WS_WOUT);
    bf16* W13 = (bf16*)(a->ws + WS_W13); bf16* W2 = (bf16*)(a->ws + WS_W2);
    const float* w_in = a->in[8] + (size_t)l * D * DIN;
    const float* wbra = a->in[13] + (size_t)l * D * D; const float* wbrb = a->in[14] + (size_t)l * D * D; const float* wout = a->in[15] + (size_t)l * D * D;
    const int j = l >> 1; const bool moe = l & 1;
    constexpr int I_IN = 16 * 256, I_SQ = 16 * 32;
    constexpr int I_D13 = 16 * (2 * FF / 32), I_D2 = (FF / 64) * 32;
    constexpr int I_E13 = 16 * (2 * FFE / 32), I_E2 = (FFE / 64) * 32;
    const int n_ffn = moe ? NE * (I_E13 + I_E2) : (I_D13 + I_D2);
    const int total = I_IN + 3 * I_SQ + n_ffn;
    for (int it = gw; it < total; it += NGW) {
        int r = it;
        if (r < I_IN) { const int kb = r >> 8, nb = r & 255, n0 = nb * 32, sc = n0 < 3072 ? n0 : n0 + 16; tr_item(w_in + sc, w_in + sc + 16, DIN, WIN, D, n0, kb * 64, scr, lane); continue; } r -= I_IN;
        if (r < I_SQ) { const int kb = r >> 5, nb = r & 31; tr_item(wbra + nb * 32, wbra + nb * 32 + 16, D, WBRA, D, nb * 32, kb * 64, scr, lane); continue; } r -= I_SQ;
        if (r < I_SQ) { const int kb = r >> 5, nb = r & 31; tr_item(wbrb + nb * 32, wbrb + nb * 32 + 16, D, WBRB, D, nb * 32, kb * 64, scr, lane); continue; } r -= I_SQ;
        if (r < I_SQ) { const int kb = r >> 5, nb = r & 31; tr_item(wout + nb * 32, wout + nb * 32 + 16, D, WOUT, D, nb * 32, kb * 64, scr, lane); continue; } r -= I_SQ;
        if (!moe) {
            const float* w1 = a->in[16] + (size_t)j * D * FF; const float* w3 = a->in[17] + (size_t)j * D * FF; const float* w2 = a->in[18] + (size_t)j * FF * D;
            if (r < I_D13) { constexpr int NBK = 2 * FF / 32; const int kb = r / NBK, nb = r % NBK; tr_item(w1 + nb * 16, w3 + nb * 16, FF, W13, D, nb * 32, kb * 64, scr, lane); continue; } r -= I_D13;
            { const int kb = r >> 5, nb = r & 31; tr_item(w2 + nb * 32, w2 + nb * 32 + 16, D, W2, FF, nb * 32, kb * 64, scr, lane); }
        } else {
            const int e = r / (I_E13 + I_E2); r -= e * (I_E13 + I_E2);
            const float* w1 = a->in[20] + ((size_t)j * NE + e) * D * FFE; const float* w3 = a->in[21] + ((size_t)j * NE + e) * D * FFE; const float* w2 = a->in[22] + ((size_t)j * NE + e) * FFE * D;
            if (r < I_E13) { constexpr int NBK = 2 * FFE / 32; const int kb = r / NBK, nb = r % NBK; tr_item(w1 + nb * 16, w3 + nb * 16, FFE, W13 + (size_t)e * 2 * FFE * D, D, nb * 32, kb * 64, scr, lane); continue; } r -= I_E13;
            { const int kb = r >> 5, nb = r & 31; tr_item(w2 + nb * 32, w2 + nb * 32 + 16, D, W2 + (size_t)e * D * FFE, FFE, nb * 32, kb * 64, scr, lane); }
        }
    }
}

struct MoeCum { int cum[NE]; };
__device__ __forceinline__ void load_tile_prefix(const unsigned* cnt, int (&cum)[NE + 1]) {
    int acc = 0;
#pragma unroll
    for (int e = 0; e < NE; ++e) { cum[e] = acc; const int c = (int)__hip_atomic_load(cnt + e, __ATOMIC_RELAXED, __HIP_MEMORY_SCOPE_AGENT); acc += (c + 255) >> 8; }
    cum[NE] = acc;
}
__device__ __forceinline__ void moe_combine_row(KArgs a, int lm  , int row, int lane, f32x4 (&v)[4]) {
    const unsigned* cnt = (const unsigned*)(a->ws + WS_CTL) + CW_CNT + (lm >> 1) * 64;
    const int* RTI = (const int*)(a->ws + WS_RTI); const float* RTW = (const float*)(a->ws + WS_RTW); const float* YS = (const float*)(a->ws + WS_YS);
    const float* MOD = (const float*)(a->ws + WS_MOD);
    const int e0 = RTI[row * 4 + 0], r0 = RTI[row * 4 + 1], e1 = RTI[row * 4 + 2], r1 = RTI[row * 4 + 3];
    const float w0 = RTW[row * 2 + 0], w1 = RTW[row * 2 + 1];
    int c0 = 0, c1 = 0, accp = 0;
#pragma unroll
    for (int e = 0; e < NE; ++e) { const int c = (int)__hip_atomic_load(cnt + e, __ATOMIC_RELAXED, __HIP_MEMORY_SCOPE_AGENT); c0 = (e == e0) ? accp : c0; c1 = (e == e1) ? accp : c1; accp += (c + 255) >> 8; }
    const size_t s0 = (size_t)c0 * 256 + r0, s1 = (size_t)c1 * 256 + r1;
    const int mr = row < ML ? (row >> 11) : 8;
    const float* g2 = MOD + (size_t)(lm * 9 + mr) * 6144 + 5120;
#pragma unroll
    for (int j = 0; j < 4; ++j) { const int col = 4 * lane + 256 * j;
        const f32x4 y0 = *(const f32x4*)(YS + s0 * D + col), y1 = *(const f32x4*)(YS + s1 * D + col), g = *(const f32x4*)(g2 + col);
        v[j] = v[j] + g * (y0 * w0 + y1 * w1); }
}

__device__ __forceinline__ void phase_n1(KArgs a, LAS unsigned char* lds, int l) {
    const int tid = TID(), lane = tid & 63, wave = tid >> 6;
    LAS float* gwt = (LAS float*)lds;
    const float* w_in = a->in[8] + (size_t)l * D * DIN;
    __syncthreads();
    for (int i = tid; i < 16 * 1024; i += 512) { const int k = i >> 4, g = i & 15; gwt[g * 1024 + k] = w_in[(size_t)k * DIN + 3072 + g]; }
    __syncthreads();
    const float* MOD = (const float*)(a->ws + WS_MOD); float* XR = (float*)(a->ws + WS_XR); bf16* H = (bf16*)(a->ws + WS_H); float* GPRE = (float*)(a->ws + WS_GPRE);
    const float* g1 = a->in[6] + l * D; const float* gb = a->in[10] + l * 16;
    const bool combine = (l > 0) && ((l - 1) & 1);
    const int gw = BID() * 8 + wave, NGW = GRD() * 8;
    for (int row = gw; row < MROWS; row += NGW) {
        const float* xp = (l == 0) ? (row < ML ? a->in[0] + (size_t)row * D : a->in[2] + (size_t)(row - ML) * D) : XR + (size_t)row * D;
        f32x4 v[4]; float ss = 0.f;
#pragma unroll
        for (int j = 0; j < 4; ++j) v[j] = *(const f32x4*)(xp + 4 * lane + 256 * j);
        if (combine) { moe_combine_row(a, l - 1, row, lane, v);
#pragma unroll
            for (int j = 0; j < 4; ++j) *(f32x4*)(XR + (size_t)row * D + 4 * lane + 256 * j) = v[j]; }
#pragma unroll
        for (int j = 0; j < 4; ++j) ss += (v[j].x * v[j].x + v[j].y * v[j].y) + (v[j].z * v[j].z + v[j].w * v[j].w);
        const float rstd = rsqrtf(wave_sum(ss) * (1.f / D) + EPS);
        const int mr = row < ML ? (row >> 11) : 8; const float* mp = MOD + (size_t)(l * 9 + mr) * 6144;
        f32x4 h[4];
#pragma unroll
        for (int j = 0; j < 4; ++j) { const int col = 4 * lane + 256 * j; const f32x4 g = *(const f32x4*)(g1 + col), sh = *(const f32x4*)(mp + col), sc = *(const f32x4*)(mp + 1024 + col);
            h[j] = (v[j] * rstd * g) * (sc + 1.f) + sh;
            u32x2 w; w.x = pk2(h[j].x, h[j].y); w.y = pk2(h[j].z, h[j].w); *(u32x2*)(H + (size_t)row * D + col) = w; }
        float mine = 0.f;
#pragma unroll 1
        for (int g = 0; g < 16; ++g) { float s = 0.f;
#pragma unroll
            for (int j = 0; j < 4; ++j) { const f32x4 w4 = *(const LAS f32x4*)(gwt + g * 1024 + 256 * j + 4 * lane); s += (h[j].x * w4.x + h[j].y * w4.y) + (h[j].z * w4.z + h[j].w * w4.w); }
            s = wave_sum(s); mine = (lane == g) ? s : mine; }
        if (lane < 16) GPRE[(size_t)row * 16 + lane] = mine + gb[lane];
    }
}

__device__ __forceinline__ void phase_prep(KArgs a, int l) {
    const bf16* P = (const bf16*)(a->ws + WS_P); bf16* QK = (bf16*)(a->ws + WS_QK);
    const float* cw = a->in[9] + (size_t)l * 3 * 1024;
    const int gt = BID() * 512 + TID(), NT = GRD() * 512;
    for (int it = gt; it < MROWS * 64; it += NT) {
        const int row = it >> 6, i = it & 63;
        const bool lat = row < ML; const int t = lat ? (row & (TL - 1)) : ((row - ML) & (TC - 1)); const int T = lat ? TL : TC;
        const int ii = i & 31; const int dbase = (i < 32) ? ii : 64 + ii;
        float cs = 1.f, sn = 0.f;
        if (lat) { const float pos = (i < 32) ? (float)(t >> 6) : (float)(t & 63); const float inv = 1.0f / powf(10000.0f, (float)ii / 32.0f); const float ang = pos * inv; sincosf(ang, &sn, &cs); }
        const bool hp = t > 0, hn = t < T - 1;
#pragma unroll
        for (int qk = 0; qk < 2; ++qk)
#pragma unroll
            for (int h = 0; h < 4; ++h) { const int c1 = qk * 512 + h * 128 + dbase, c2 = c1 + 32;
                float u1 = cw[1024 + c1] * bf2f(P[(size_t)row * NP + c1]), u2 = cw[1024 + c2] * bf2f(P[(size_t)row * NP + c2]);
                if (hp) { u1 += cw[c1] * bf2f(P[(size_t)(row - 1) * NP + c1]); u2 += cw[c2] * bf2f(P[(size_t)(row - 1) * NP + c2]); }
                if (hn) { u1 += cw[2048 + c1] * bf2f(P[(size_t)(row + 1) * NP + c1]); u2 += cw[2048 + c2] * bf2f(P[(size_t)(row + 1) * NP + c2]); }
                u1 = u1 * sigmoidf_(u1); u2 = u2 * sigmoidf_(u2);
                float o1 = u1 * cs - u2 * sn, o2 = u1 * sn + u2 * cs;
                if (qk) { o1 *= 0.08838834764831845f; o2 *= 0.08838834764831845f; }
                QK[(size_t)row * D + c1] = (bf16)f2bf(o1); QK[(size_t)row * D + c2] = (bf16)f2bf(o2); }
    }
}

__device__ __forceinline__ float log_sigmoid_(float x) { return fminf(x, 0.f) - log1pf(__expf(-fabsf(x))); }
__device__ __forceinline__ void phase_scan_naive(KArgs a, LAS unsigned char* lds, int l) {
    const int tid = TID(), lane = tid & 63;
    LAS float* q = (LAS float*)lds;
    LAS float* k = q + 64 * 129;
    LAS float* C = k + 64 * 129;
    LAS float* vv = C + 64 * 129;
    LAS float* S = vv + 64 * 65;
    LAS float* nv = S + 64 * 65;
    LAS float* sc = nv + 128;
    LAS float* bL = sc, *igL = sc + 64, *mrowL = sc + 128, *wintL = sc + 192, *wkL = sc + 256, *denL = sc + 320, *misc = sc + 384;
    const bf16* P = (const bf16*)(a->ws + WS_P); const bf16* QK = (const bf16*)(a->ws + WS_QK); const float* GPRE = (const float*)(a->ws + WS_GPRE);
    float* HS = (float*)(a->ws + WS_HS);
    for (int unit = BID(); unit < 256; unit += GRD()) {
        const int b = unit >> 5, h = (unit >> 3) & 3, dir = (unit >> 2) & 1, vs = unit & 3;
        __syncthreads();
        for (int i = tid; i < 64 * 129; i += 512) C[i] = 0.f;
        if (tid < 128) nv[tid] = 0.f;
        if (tid == 0) misc[0] = 0.f;
        __syncthreads();
        for (int step = 0; step < 36; ++step) {
            const bool isc = step < 4; const int jj = isc ? step : step - 4; const int T = isc ? TC : TL; const int rbase = isc ? ML + b * TC : b * TL;
#define ROWOF(li) (rbase + (dir ? (T - 1 - (64 * jj + (li))) : (64 * jj + (li))))
            for (int i = tid; i < 64 * 128; i += 512) { const int li = i >> 7, d = i & 127; const size_t r = (size_t)ROWOF(li);
                q[li * 129 + d] = bf2f(QK[r * D + h * 128 + d]); k[li * 129 + d] = bf2f(QK[r * D + 512 + h * 128 + d]); }
            for (int i = tid; i < 64 * 64; i += 512) { const int li = i >> 6, v = i & 63; const size_t r = (size_t)ROWOF(li); vv[li * 65 + v] = bf2f(P[r * NP + PC_V + h * 256 + vs * 64 + v]); }
            if (tid < 64) {
                const size_t r = (size_t)ROWOF(lane);
                const float ig = GPRE[r * 16 + (2 * dir) * 4 + h]; const float fg = log_sigmoid_(GPRE[r * 16 + (2 * dir + 1) * 4 + h]);
                float bb = fg;
#pragma unroll
                for (int o = 1; o < 64; o <<= 1) { const float t2 = __shfl_up(bb, o); if (lane >= o) bb += t2; }
                float am = ig - bb;
#pragma unroll
                for (int o = 1; o < 64; o <<= 1) { const float t2 = __shfl_up(am, o); if (lane >= o) am = fmaxf(am, t2); }
                const float m = misc[0];
                const float mrow = bb + fmaxf(m, am);
                const float blast = __shfl(bb, 63);
                const float g = blast - bb + ig;
                const float gmax = wave_max(g);
                const float mnew = fmaxf(blast + m, gmax);
                bL[lane] = bb; igL[lane] = ig; mrowL[lane] = mrow; wintL[lane] = __expf(bb + m - mrow); wkL[lane] = __expf(g - mnew);
                if (lane == 0) { misc[1] = __expf(blast + m - mnew); misc[2] = mnew; }
            }
            __syncthreads();
            for (int it = 0; it < 8; ++it) { const int s = tid & 63, li = (tid >> 6) + 8 * it; float dot = 0.f;
                if (s <= li) {
#pragma unroll 8
                    for (int d = 0; d < 128; ++d) dot += q[li * 129 + d] * k[s * 129 + d];
                    dot *= __expf(bL[li] - bL[s] + igL[s] - mrowL[li]); }
                S[li * 65 + s] = dot; }
            __syncthreads();
            if (tid < 64) { float di = 0.f, dn = 0.f;
                for (int s = 0; s < 64; ++s) di += S[tid * 65 + s];
                for (int d = 0; d < 128; ++d) dn += nv[d] * q[tid * 129 + d];
                const float den = di + wintL[tid] * dn; denL[tid] = fmaxf(fabsf(den), __expf(-mrowL[tid])); }
            __syncthreads();
            for (int it = 0; it < 8; ++it) { const int v = tid & 63, li = (tid >> 6) + 8 * it; float n1 = 0.f, n2 = 0.f;
#pragma unroll 8
                for (int s = 0; s < 64; ++s) n1 += S[li * 65 + s] * vv[s * 65 + v];
#pragma unroll 8
                for (int d = 0; d < 128; ++d) n2 += C[v * 129 + d] * q[li * 129 + d];
                const float num = n1 + wintL[li] * n2;
                HS[((size_t)dir * MROWS + ROWOF(li)) * D + h * 256 + vs * 64 + v] = num / denL[li]; }
            __syncthreads();
            { const float decay = misc[1];
              for (int it = 0; it < 16; ++it) { const int d = tid & 127, v = (tid >> 7) + 4 * it; float s2 = 0.f;
#pragma unroll 8
                  for (int li = 0; li < 64; ++li) s2 += wkL[li] * vv[li * 65 + v] * k[li * 129 + d];
                  C[v * 129 + d] = decay * C[v * 129 + d] + s2; }
              if (tid < 128) { float s2 = 0.f; for (int li = 0; li < 64; ++li) s2 += wkL[li] * k[li * 129 + tid]; nv[tid] = decay * nv[tid] + s2; }
            }
            __syncthreads();
            if (tid == 0) misc[0] = misc[2];
            __syncthreads();
#undef ROWOF
        }
    }
}

typedef short s16x4 __attribute__((ext_vector_type(4)));
__device__ __forceinline__ s16x4 ds_tr(LAS unsigned char* p) { return __builtin_amdgcn_ds_read_tr16_b64_v4i16((LAS s16x4*)p); }
__device__ __forceinline__ bf16x8 cat8(s16x4 a, s16x4 b) { return __builtin_shufflevector(a, b, 0, 1, 2, 3, 4, 5, 6, 7); }
__device__ __forceinline__ f32x4 mfma16(bf16x8 a, bf16x8 b, f32x4 c) { return __builtin_amdgcn_mfma_f32_16x16x32_bf16(a, b, c, 0, 0, 0); }
__device__ __forceinline__ void phase_scan_mfma(KArgs a, LAS unsigned char* lds, int l) {
    const int tid = TID(), lane = tid & 63, w = __builtin_amdgcn_readfirstlane(tid >> 6), c = lane & 15, g = lane >> 4;
    constexpr int QS = 0, KS = 17408, VS = 34816, CB = 46080, SC = 67840, RS = 272, VRS = 176;
    LAS float* uL = (LAS float*)(lds + SC); LAS float* wL = uL + 64; LAS float* wintL = uL + 128; LAS float* wkL = uL + 192; LAS float* emL = uL + 256; LAS float* misc = uL + 320;
    const bf16* P = (const bf16*)(a->ws + WS_P); const bf16* QK = (const bf16*)(a->ws + WS_QK); const float* GPRE = (const float*)(a->ws + WS_GPRE);
    float* HS = (float*)(a->ws + WS_HS);
    const int lt = w & 3, vh = w >> 2;
    for (int unit = BID(); unit < 256; unit += GRD()) {
        const int b = unit >> 5, h = (unit >> 3) & 3, dir = (unit >> 2) & 1, vs = unit & 3;
        __syncthreads();
        for (int i = tid; i < 64 * 16; i += 512) { const int li = i >> 4, cc = i & 15; *(LAS bf16*)(lds + VS + li * VRS + (64 + cc) * 2) = (bf16)(cc == 0 ? 0x3F80 : 0); }
        for (int i = tid; i < 80 * RS / 4; i += 512) ((LAS unsigned*)(lds + CB))[i] = 0u;
        f32x4 Cacc[5];
#pragma unroll
        for (int mt = 0; mt < 5; ++mt) Cacc[mt] = (f32x4){0.f, 0.f, 0.f, 0.f};
        float mcur = 0.f;
        u32x4 pq0, pq1, pk0, pk1, pv; float pig = 0.f, pfg = 0.f;
        const int li_ld = tid >> 3, ch_ld = tid & 7;
#define SC_ROW(step_, li_) (((step_) < 4 ? ML + b * TC : b * TL) + (dir ? (((step_) < 4 ? TC : TL) - 1 - (64 * ((step_) < 4 ? (step_) : (step_) - 4) + (li_))) : (64 * ((step_) < 4 ? (step_) : (step_) - 4) + (li_))))
#define SC_LOAD(step_) do { const size_t r_ = (size_t)SC_ROW(step_, li_ld); \
            const unsigned char* qp_ = (const unsigned char*)(QK + r_ * D + h * 128) + ch_ld * 16; \
            pq0 = *(const u32x4*)qp_; pq1 = *(const u32x4*)(qp_ + 128); pk0 = *(const u32x4*)(qp_ + 1024); pk1 = *(const u32x4*)(qp_ + 1024 + 128); \
            pv = *(const u32x4*)((const unsigned char*)(P + r_ * NP + PC_V + h * 256 + vs * 64) + ch_ld * 16); \
            if (w == 0) { const size_t rg_ = (size_t)SC_ROW(step_, lane); pig = GPRE[rg_ * 16 + (2 * dir) * 4 + h]; pfg = GPRE[rg_ * 16 + (2 * dir + 1) * 4 + h]; } } while (0)
        SC_LOAD(0);
        for (int step = 0; step < 36; ++step) {
            *(LAS u32x4*)(lds + QS + li_ld * RS + ch_ld * 16) = pq0; *(LAS u32x4*)(lds + QS + li_ld * RS + ch_ld * 16 + 128) = pq1;
            *(LAS u32x4*)(lds + KS + li_ld * RS + ch_ld * 16) = pk0; *(LAS u32x4*)(lds + KS + li_ld * RS + ch_ld * 16 + 128) = pk1;
            *(LAS u32x4*)(lds + VS + li_ld * VRS + ch_ld * 16) = pv;
            if (w == 0) {
                const float ig = pig, fg = log_sigmoid_(pfg);
                float bb = fg;
#pragma unroll
                for (int o = 1; o < 64; o <<= 1) { const float t2 = __shfl_up(bb, o); if (lane >= o) bb += t2; }
                float am = ig - bb;
#pragma unroll
                for (int o = 1; o < 64; o <<= 1) { const float t2 = __shfl_up(am, o); if (lane >= o) am = fmaxf(am, t2); }
                const float mrow = bb + fmaxf(mcur, am);
                const float blast = __shfl(bb, 63);
                const float gg = blast - bb + ig;
                const float mnew = fmaxf(blast + mcur, wave_max(gg));
                uL[lane] = bb - mrow; wL[lane] = ig - bb; wintL[lane] = __expf(bb + mcur - mrow); wkL[lane] = __expf(gg - mnew); emL[lane] = __expf(-mrow);
                if (lane == 0) misc[1] = __expf(blast + mcur - mnew);
                mcur = mnew;
            }
            __syncthreads();
            if (step + 1 < 36) SC_LOAD(step + 1);
            bf16x8 qf[4];
#pragma unroll
            for (int ks = 0; ks < 4; ++ks) qf[ks] = *(const LAS bf16x8*)(lds + QS + (16 * lt + c) * RS + (32 * ks + 8 * g) * 2);
            f32x4 acc[3];
#pragma unroll
            for (int nt = 0; nt < 3; ++nt) { acc[nt] = (f32x4){0.f, 0.f, 0.f, 0.f}; const int vrow0 = nt < 2 ? 16 * (2 * vh + nt) : 64;
#pragma unroll
                for (int ks = 0; ks < 4; ++ks) { const bf16x8 bfr = *(const LAS bf16x8*)(lds + CB + (vrow0 + c) * RS + (32 * ks + 8 * g) * 2); acc[nt] = mfma16(qf[ks], bfr, acc[nt]); } }
            { const f32x4 wi = *(const LAS f32x4*)(wintL + 16 * lt + 4 * g);
#pragma unroll
              for (int nt = 0; nt < 3; ++nt) acc[nt] = acc[nt] * wi; }
            const float ul = uL[16 * lt + c];
#pragma unroll
            for (int sc2 = 0; sc2 < 2; ++sc2) {
                if (2 * sc2 <= lt) {
                    unsigned pw[4];
#pragma unroll
                    for (int hh = 0; hh < 2; ++hh) { const int st = 2 * sc2 + hh; float p[4] = {0.f, 0.f, 0.f, 0.f};
                        if (st <= lt) { f32x4 sT = (f32x4){0.f, 0.f, 0.f, 0.f};
#pragma unroll
                            for (int ks = 0; ks < 4; ++ks) { const bf16x8 afr = *(const LAS bf16x8*)(lds + KS + (16 * st + c) * RS + (32 * ks + 8 * g) * 2); sT = mfma16(afr, qf[ks], sT); }
                            const f32x4 ws = *(const LAS f32x4*)(wL + 16 * st + 4 * g);
#pragma unroll
                            for (int r = 0; r < 4; ++r) p[r] = (16 * st + 4 * g + r <= 16 * lt + c) ? sT[r] * __expf(ul + ws[r]) : 0.f; }
                        pw[2 * hh] = pk2(p[0], p[1]); pw[2 * hh + 1] = pk2(p[2], p[3]); }
                    const u32x4 pwv = (u32x4){pw[0], pw[1], pw[2], pw[3]};
                    const bf16x8 pfrag = __builtin_bit_cast(bf16x8, pwv);
#pragma unroll
                    for (int nt = 0; nt < 3; ++nt) { const int ncol0 = nt < 2 ? 16 * (2 * vh + nt) : 64;
                        LAS unsigned char* vp = lds + VS + (32 * sc2 + 4 * g + (c >> 2)) * VRS + (ncol0 + 4 * (c & 3)) * 2;
                        const s16x4 t0 = ds_tr(vp), t1 = ds_tr(vp + 16 * VRS);
                        acc[nt] = mfma16(pfrag, cat8(t0, t1), acc[nt]); }
                }
            }
            { float den[4];
#pragma unroll
              for (int r = 0; r < 4; ++r) den[r] = __shfl(acc[2][r], lane & 48);
              const f32x4 em = *(const LAS f32x4*)(emL + 16 * lt + 4 * g);
#pragma unroll
              for (int r = 0; r < 4; ++r) { const float dn = 1.f / fmaxf(fabsf(den[r]), em[r]); const size_t row = (size_t)SC_ROW(step, 16 * lt + 4 * g + r);
                  float* op = HS + ((size_t)dir * MROWS + row) * D + h * 256 + vs * 64 + c;
                  op[16 * (2 * vh + 0)] = acc[0][r] * dn; op[16 * (2 * vh + 1)] = acc[1][r] * dn; } }
            { const float decay = misc[1];
#pragma unroll
              for (int mt = 0; mt < 5; ++mt) Cacc[mt] = Cacc[mt] * decay;
#pragma unroll
              for (int kc = 0; kc < 2; ++kc) {
                  LAS unsigned char* kp = lds + KS + (32 * kc + 8 * g + (c >> 2)) * RS + (16 * w + 4 * (c & 3)) * 2;
                  const s16x4 t0 = ds_tr(kp), t1 = ds_tr(kp + 4 * RS);
                  const f32x4 wka = *(const LAS f32x4*)(wkL + 32 * kc + 8 * g), wkb = *(const LAS f32x4*)(wkL + 32 * kc + 8 * g + 4);
                  u32x4 bwv;
                  bwv.x = pk2(bf2f((unsigned short)t0[0]) * wka[0], bf2f((unsigned short)t0[1]) * wka[1]); bwv.y = pk2(bf2f((unsigned short)t0[2]) * wka[2], bf2f((unsigned short)t0[3]) * wka[3]);
                  bwv.z = pk2(bf2f((unsigned short)t1[0]) * wkb[0], bf2f((unsigned short)t1[1]) * wkb[1]); bwv.w = pk2(bf2f((unsigned short)t1[2]) * wkb[2], bf2f((unsigned short)t1[3]) * wkb[3]);
                  const bf16x8 bw = __builtin_bit_cast(bf16x8, bwv);
#pragma unroll
                  for (int mt = 0; mt < 5; ++mt) { LAS unsigned char* vp = lds + VS + (32 * kc + 8 * g + (c >> 2)) * VRS + (16 * mt + 4 * (c & 3)) * 2;
                      const s16x4 a0 = ds_tr(vp), a1 = ds_tr(vp + 4 * VRS);
                      Cacc[mt] = mfma16(cat8(a0, a1), bw, Cacc[mt]); } } }
            __syncthreads();
#pragma unroll
            for (int mt = 0; mt < 5; ++mt)
#pragma unroll
                for (int r = 0; r < 4; ++r) *(LAS bf16*)(lds + CB + (16 * mt + 4 * g + r) * RS + (16 * w + c) * 2) = (bf16)f2bf(Cacc[mt][r]);
        }
#undef SC_LOAD
#undef SC_ROW
    }
}

__device__ __forceinline__ void phase_na_naive(KArgs a, int l, bool last) {
    const int lane = TID() & 63, wave = TID() >> 6;
    const bf16* P = (const bf16*)(a->ws + WS_P); bf16* HB = (bf16*)(a->ws + WS_HB);
    const float* rpb = a->in[12] + (size_t)l * 16 * 15 * 31;
    const int gw = BID() * 8 + wave, NGW = GRD() * 8;
    const int nitems = (last ? ML : MROWS) * 16;
    for (int item = gw; item < nitems; item += NGW) {
        int h, row;
        if (item < ML * 16) { h = item >> 14; row = item & (ML - 1); } else { const int r2 = item - ML * 16; h = r2 >> 11; row = ML + (r2 & (MC - 1)); }
        const bool lat = row < ML;
        const int b = lat ? (row >> 11) : ((row - ML) >> 8);
        const int t = lat ? (row & (TL - 1)) : 0;
        const int qr = t >> 6, qc = t & 63;
        const int rs = min(max(qr - 4, 0), 24), cs = min(max(qc - 8, 0), 48);
        float q[64];
        { const u32x4* qp = (const u32x4*)(P + (size_t)row * NP + PC_NQ + h * 64);
#pragma unroll
          for (int i = 0; i < 8; ++i) { const u32x4 w = qp[i]; q[8 * i + 0] = bflo(w.x); q[8 * i + 1] = bfhi(w.x); q[8 * i + 2] = bflo(w.y); q[8 * i + 3] = bfhi(w.y); q[8 * i + 4] = bflo(w.z); q[8 * i + 5] = bfhi(w.z); q[8 * i + 6] = bflo(w.w); q[8 * i + 7] = bfhi(w.w); } }
        float s[6];
#pragma unroll
        for (int i = 0; i < 6; ++i) {
            int krow; float bias = 0.f; bool valid = true;
            if (i < 2) { const int li = lane + 64 * i; const int kr = rs + (li >> 4), kc = cs + (li & 15); krow = b * TL + kr * 64 + kc; valid = lat;
                bias = rpb[(h * 15 + (kr - qr + 7)) * 31 + (kc - qc + 15)]; }
            else { krow = ML + b * TC + lane + 64 * (i - 2); }
            float dot = 0.f;
            if (valid) { const u32x4* kp = (const u32x4*)(P + (size_t)krow * NP + PC_NK + h * 64);
#pragma unroll
                for (int j = 0; j < 8; ++j) { const u32x4 w = kp[j];
                    dot += q[8 * j + 0] * bflo(w.x) + q[8 * j + 1] * bfhi(w.x) + q[8 * j + 2] * bflo(w.y) + q[8 * j + 3] * bfhi(w.y) + q[8 * j + 4] * bflo(w.z) + q[8 * j + 5] * bfhi(w.z) + q[8 * j + 6] * bflo(w.w) + q[8 * j + 7] * bfhi(w.w); }
                s[i] = dot + bias; }
            else s[i] = -3.0e38f;
        }
        float mx = s[0];
#pragma unroll
        for (int i = 1; i < 6; ++i) mx = fmaxf(mx, s[i]);
        mx = wave_max(mx);
        float sum = 0.f;
#pragma unroll
        for (int i = 0; i < 6; ++i) { s[i] = (s[i] > -1.0e38f) ? __expf(s[i] - mx) : 0.f; sum += s[i]; }
        sum = wave_sum(sum);
        float o = 0.f;
        const bf16* vb = P + PC_NV + h * 64 + lane;
        if (lat) {
#pragma unroll
            for (int i = 0; i < 2; ++i)
                for (int src = 0; src < 64; ++src) { const int li = src + 64 * i; const int kr = rs + (li >> 4), kc = cs + (li & 15); const size_t krow = (size_t)b * TL + kr * 64 + kc;
                    o += __shfl(s[i], src) * bf2f(vb[krow * NP]); }
        }
#pragma unroll
        for (int i = 2; i < 6; ++i)
            for (int src = 0; src < 64; ++src) { const size_t krow = (size_t)ML + b * TC + src + 64 * (i - 2); o += __shfl(s[i], src) * bf2f(vb[krow * NP]); }
        HB[(size_t)row * D + h * 64 + lane] = (bf16)f2bf(o / sum);
    }
}

__device__ __forceinline__ void phase_na_mfma(KArgs a, LAS unsigned char* lds, int l, bool last) {
    const int tid = TID(), lane = tid & 63, w = __builtin_amdgcn_readfirstlane(tid >> 6), c = lane & 15, g = lane >> 4;
    constexpr int KRS = 144, SLOT = 2 * 64 * KRS, VOFF = 64 * KRS, RPB_OFF = 2 * SLOT;
    LAS float* rpbL = (LAS float*)(lds + RPB_OFF);
    const bf16* P = (const bf16*)(a->ws + WS_P); bf16* HB = (bf16*)(a->ws + WS_HB);
    const float* rpb = a->in[12] + (size_t)l * 16 * 15 * 31;
    __syncthreads();
    for (int i = tid; i < 16 * 15 * 31; i += 512) rpbL[i] = rpb[i];
    const int nunits = last ? 1024 : 1152;
    const int key_ld = tid >> 3, ch_ld = tid & 7;
    for (int unit = BID(); unit < nunits; unit += GRD()) {
        const bool isctx = unit >= 1024;
        int b, h, qq; if (!isctx) { b = unit >> 7; h = (unit >> 3) & 15; qq = unit & 7; } else { const int u2 = unit - 1024; b = u2 >> 4; h = u2 & 15; qq = 0; }
        const int qr = 4 * qq + (w >> 1), j = w & 1;
        const int rs = min(max(qr - 4, 0), 24);
        const int kr_lo = min(max(4 * qq - 4, 0), 24), kr_hi = min(max(4 * qq - 1, 0), 24) + 7;
        const int nloc = isctx ? 0 : (kr_hi - kr_lo + 1), nsteps = nloc + 4;
        bf16x8 Qf[2][2]; int qc[2], csq[2]; size_t qrow[2];
#pragma unroll
        for (int qs = 0; qs < 2; ++qs) { qc[qs] = 32 * j + 16 * qs + c; csq[qs] = min(max(qc[qs] - 8, 0), 48);
            qrow[qs] = isctx ? (size_t)(ML + b * TC + 32 * w + 16 * qs + c) : (size_t)(b * TL + qr * 64 + qc[qs]);
#pragma unroll
            for (int ks = 0; ks < 2; ++ks) Qf[qs][ks] = *(const bf16x8*)(P + qrow[qs] * NP + PC_NQ + h * 64 + 32 * ks + 8 * g); }
        float mrun[2] = {-1.0e30f, -1.0e30f}, lsum[2] = {0.f, 0.f};
        f32x4 O[2][4];
#pragma unroll
        for (int qs = 0; qs < 2; ++qs)
#pragma unroll
            for (int dt = 0; dt < 4; ++dt) O[qs][dt] = (f32x4){0.f, 0.f, 0.f, 0.f};
        u32x4 pk, pv;
#define NA_LOAD(s_) do { const size_t kr0_ = (s_) < nloc ? (size_t)(b * TL + (kr_lo + (s_)) * 64) : (size_t)(ML + b * TC + ((s_) - nloc) * 64); \
            const unsigned char* kp_ = (const unsigned char*)(P + (kr0_ + key_ld) * NP + PC_NK + h * 64) + ch_ld * 16; \
            pk = *(const u32x4*)kp_; pv = *(const u32x4*)(kp_ + (PC_NV - PC_NK) * 2); } while (0)
        NA_LOAD(0);
        __syncthreads();
        for (int s2 = 0; s2 < nsteps; ++s2) {
            LAS unsigned char* Kb = lds + (s2 & 1) * SLOT; LAS unsigned char* Vb = Kb + VOFF;
            *(LAS u32x4*)(Kb + key_ld * KRS + ch_ld * 16) = pk; *(LAS u32x4*)(Vb + key_ld * KRS + ch_ld * 16) = pv;
            __syncthreads();
            if (s2 + 1 < nsteps) NA_LOAD(s2 + 1);
            const bool loc = s2 < nloc; const int kr = kr_lo + s2;
            const bool active = !loc || (kr >= rs && kr < rs + 8);
            if (active) {
                float sv[2][4][4];
                bool need[2][4];
#pragma unroll
                for (int qs = 0; qs < 2; ++qs) { const int q0 = 32 * j + 16 * qs; const int lo = min(max(q0 - 8, 0), 48), hi = min(max(q0 + 15 - 8, 0), 48) + 15;
#pragma unroll
                    for (int kt = 0; kt < 4; ++kt) need[qs][kt] = !loc || ((16 * kt <= hi) && (16 * kt + 15 >= lo)); }
#pragma unroll
                for (int kt = 0; kt < 4; ++kt) {
                    const bf16x8 kf0 = *(const LAS bf16x8*)(Kb + (16 * kt + c) * KRS + (8 * g) * 2), kf1 = *(const LAS bf16x8*)(Kb + (16 * kt + c) * KRS + (32 + 8 * g) * 2);
#pragma unroll
                    for (int qs = 0; qs < 2; ++qs) {
                        if (need[qs][kt]) { f32x4 t = mfma16(kf0, Qf[qs][0], (f32x4){0.f, 0.f, 0.f, 0.f}); t = mfma16(kf1, Qf[qs][1], t);
#pragma unroll
                            for (int r = 0; r < 4; ++r) { float v = t[r];
                                if (loc) { const int kc = 16 * kt + 4 * g + r; const bool ok = (kc >= csq[qs]) && (kc < csq[qs] + 16);
                                    const int dc = min(max(kc - qc[qs] + 15, 0), 30);
                                    v = ok ? v + rpbL[(h * 15 + (kr - qr + 7)) * 31 + dc] : -1.0e30f; }
                                sv[qs][kt][r] = v; } }
                        else {
#pragma unroll
                            for (int r = 0; r < 4; ++r) sv[qs][kt][r] = -1.0e30f; } } }
                bf16x8 pf[2][2];
#pragma unroll
                for (int qs = 0; qs < 2; ++qs) { float mx = -1.0e30f;
#pragma unroll
                    for (int kt = 0; kt < 4; ++kt)
#pragma unroll
                        for (int r = 0; r < 4; ++r) mx = fmaxf(mx, sv[qs][kt][r]);
                    mx = fmaxf(mx, __shfl_xor(mx, 16)); mx = fmaxf(mx, __shfl_xor(mx, 32));
                    const float mnew = fmaxf(mrun[qs], mx), corr = __expf(mrun[qs] - mnew); mrun[qs] = mnew;
                    float ps = 0.f;
#pragma unroll
                    for (int kt = 0; kt < 4; ++kt)
#pragma unroll
                        for (int r = 0; r < 4; ++r) { const float p = __expf(sv[qs][kt][r] - mnew); sv[qs][kt][r] = p; ps += p; }
                    lsum[qs] = lsum[qs] * corr + ps;
#pragma unroll
                    for (int dt = 0; dt < 4; ++dt) O[qs][dt] = O[qs][dt] * corr;
#pragma unroll
                    for (int ch = 0; ch < 2; ++ch) { u32x4 pw; pw.x = pk2(sv[qs][2 * ch][0], sv[qs][2 * ch][1]); pw.y = pk2(sv[qs][2 * ch][2], sv[qs][2 * ch][3]);
                        pw.z = pk2(sv[qs][2 * ch + 1][0], sv[qs][2 * ch + 1][1]); pw.w = pk2(sv[qs][2 * ch + 1][2], sv[qs][2 * ch + 1][3]); pf[qs][ch] = __builtin_bit_cast(bf16x8, pw); } }
#pragma unroll
                for (int ch = 0; ch < 2; ++ch)
#pragma unroll
                    for (int dt = 0; dt < 4; ++dt) { LAS unsigned char* vp = Vb + (32 * ch + 4 * g + (c >> 2)) * KRS + (16 * dt + 4 * (c & 3)) * 2;
                        const s16x4 t0 = ds_tr(vp), t1 = ds_tr(vp + 16 * KRS); const bf16x8 vf = cat8(t0, t1);
#pragma unroll
                        for (int qs = 0; qs < 2; ++qs) if (need[qs][2 * ch] || need[qs][2 * ch + 1]) O[qs][dt] = mfma16(vf, pf[qs][ch], O[qs][dt]); }
            }
        }
#pragma unroll
        for (int qs = 0; qs < 2; ++qs) { float lt = lsum[qs]; lt += __shfl_xor(lt, 16); lt += __shfl_xor(lt, 32); const float inv = 1.f / lt;
            bf16* op = HB + qrow[qs] * D + h * 64 + 4 * g;
#pragma unroll
            for (int dt = 0; dt < 4; ++dt) { u32x2 ow; ow.x = pk2(O[qs][dt][0] * inv, O[qs][dt][1] * inv); ow.y = pk2(O[qs][dt][2] * inv, O[qs][dt][3] * inv); *(u32x2*)(op + 16 * dt) = ow; } }
        __syncthreads();
#undef NA_LOAD
    }
}

__device__ __forceinline__ void phase_ln(KArgs a, int l, bool last) {
    const int lane = TID() & 63, wave = TID() >> 6;
    const float* HS = (const float*)(a->ws + WS_HS); const bf16* P = (const bf16*)(a->ws + WS_P); bf16* HA = (bf16*)(a->ws + WS_HA);
    const float* gh = a->in[11] + l * D;
    const int gw = BID() * 8 + wave, NGW = GRD() * 8; const int nrows = last ? ML : MROWS;
    for (int row = gw; row < nrows; row += NGW) {
#pragma unroll
        for (int j = 0; j < 4; ++j) { const int col = 4 * lane + 256 * j;
            const f32x4 y = *(const f32x4*)(HS + (size_t)row * D + col) + *(const f32x4*)(HS + ((size_t)MROWS + row) * D + col);
            const float mu = wave_sum((y.x + y.y) + (y.z + y.w)) * (1.f / 256.f);
            const f32x4 dlt = y - mu;
            const float var = wave_sum((dlt.x * dlt.x + dlt.y * dlt.y) + (dlt.z * dlt.z + dlt.w * dlt.w)) * (1.f / 256.f);
            const float rstd = rsqrtf(var + EPS);
            const f32x4 g = *(const f32x4*)(gh + col);
            const u32x2 ow = *(const u32x2*)(P + (size_t)row * NP + PC_O + col);
            const f32x4 so = (f32x4){bflo(ow.x), bfhi(ow.x), bflo(ow.y), bfhi(ow.y)};
            const f32x4 r = dlt * rstd * g * so;
            u32x2 w; w.x = pk2(r.x, r.y); w.y = pk2(r.z, r.w); *(u32x2*)(HA + (size_t)row * D + col) = w; }
    }
}

__device__ __forceinline__ void phase_n2(KArgs a, LAS unsigned char* lds, int l, bool last) {
    const int tid = TID(), lane = tid & 63, wave = tid >> 6;
    const bool moe = l & 1; const int jm = l >> 1;
    LAS float* rt = (LAS float*)lds;
    __syncthreads();
    if (moe) { const float* router = a->in[19] + (size_t)jm * D * NE;
        for (int i = tid; i < NE * 1024; i += 512) { const int k = i >> 3, e = i & 7; rt[e * 1024 + k] = router[(size_t)k * NE + e]; } }
    __syncthreads();
    const float* MOD = (const float*)(a->ws + WS_MOD); const float* XR = (const float*)(a->ws + WS_XR); bf16* H = (bf16*)(a->ws + WS_H); bf16* H2S = (bf16*)(a->ws + WS_H2S);
    int* RTI = (int*)(a->ws + WS_RTI); float* RTW = (float*)(a->ws + WS_RTW);
    unsigned* cnt = (unsigned*)(a->ws + WS_CTL) + CW_CNT + jm * 64;
    const float* g2 = a->in[7] + l * D;
    const int gw = BID() * 8 + wave, NGW = GRD() * 8; const int nrows = last ? ML : MROWS;
    for (int row = gw; row < nrows; row += NGW) {
        const float* xp = XR + (size_t)row * D;
        f32x4 v[4]; float ss = 0.f;
#pragma unroll
        for (int j = 0; j < 4; ++j) { v[j] = *(const f32x4*)(xp + 4 * lane + 256 * j); ss += (v[j].x * v[j].x + v[j].y * v[j].y) + (v[j].z * v[j].z + v[j].w * v[j].w); }
        const float rstd = rsqrtf(wave_sum(ss) * (1.f / D) + EPS);
        const int mr = row < ML ? (row >> 11) : 8; const float* mp = MOD + (size_t)(l * 9 + mr) * 6144;
        f32x4 h[4]; u32x2 hw[4];
#pragma unroll
        for (int j = 0; j < 4; ++j) { const int col = 4 * lane + 256 * j; const f32x4 g = *(const f32x4*)(g2 + col), sh = *(const f32x4*)(mp + 3072 + col), sc = *(const f32x4*)(mp + 4096 + col);
            h[j] = (v[j] * rstd * g) * (sc + 1.f) + sh; hw[j].x = pk2(h[j].x, h[j].y); hw[j].y = pk2(h[j].z, h[j].w); }
        if (!moe) {
#pragma unroll
            for (int j = 0; j < 4; ++j) *(u32x2*)(H + (size_t)row * D + 4 * lane + 256 * j) = hw[j];
        } else {
            float lg[NE];
#pragma unroll
            for (int e = 0; e < NE; ++e) { float s = 0.f;
#pragma unroll
                for (int j = 0; j < 4; ++j) { const f32x4 w4 = *(const LAS f32x4*)(rt + e * 1024 + 256 * j + 4 * lane); s += (h[j].x * w4.x + h[j].y * w4.y) + (h[j].z * w4.z + h[j].w * w4.w); }
                lg[e] = wave_sum(s); }
            int i0 = 0; float v0 = lg[0];
#pragma unroll
            for (int e = 1; e < NE; ++e) if (lg[e] > v0) { v0 = lg[e]; i0 = e; }
            int i1 = -1; float v1 = -3.0e38f;
#pragma unroll
            for (int e = 0; e < NE; ++e) if (e != i0 && lg[e] > v1) { v1 = lg[e]; i1 = e; }
            const float w0 = 1.f / (1.f + __expf(v1 - v0)), w1 = 1.f - w0;
            int r0 = 0, r1 = 0;
            if (lane == 0) { r0 = (int)__hip_atomic_fetch_add(cnt + i0, 1u, __ATOMIC_RELAXED, __HIP_MEMORY_SCOPE_AGENT); r1 = (int)__hip_atomic_fetch_add(cnt + i1, 1u, __ATOMIC_RELAXED, __HIP_MEMORY_SCOPE_AGENT); }
            r0 = __shfl(r0, 0); r1 = __shfl(r1, 0);
            if (lane == 0) { RTI[row * 4 + 0] = i0; RTI[row * 4 + 1] = r0; RTI[row * 4 + 2] = i1; RTI[row * 4 + 3] = r1; RTW[row * 2 + 0] = w0; RTW[row * 2 + 1] = w1; }
            bf16* d0 = H2S + ((size_t)i0 * ECAP + r0) * D; bf16* d1 = H2S + ((size_t)i1 * ECAP + r1) * D;
#pragma unroll
            for (int j = 0; j < 4; ++j) { *(u32x2*)(d0 + 4 * lane + 256 * j) = hw[j]; *(u32x2*)(d1 + 4 * lane + 256 * j) = hw[j]; }
        }
    }
}

__device__ __forceinline__ void phase_final(KArgs a) {
    const int lane = TID() & 63, wave = TID() >> 6;
    const float* XR = (const float*)(a->ws + WS_XR); const float* gf = a->in[23];
    const int gw = BID() * 8 + wave, NGW = GRD() * 8;
    for (int row = gw; row < ML; row += NGW) {
        f32x4 v[4]; float ss = 0.f;
#pragma unroll
        for (int j = 0; j < 4; ++j) v[j] = *(const f32x4*)(XR + (size_t)row * D + 4 * lane + 256 * j);
        moe_combine_row(a, DEPTH - 1, row, lane, v);
#pragma unroll
        for (int j = 0; j < 4; ++j) ss += (v[j].x * v[j].x + v[j].y * v[j].y) + (v[j].z * v[j].z + v[j].w * v[j].w);
        const float rstd = rsqrtf(wave_sum(ss) * (1.f / D) + EPS);
#pragma unroll
        for (int j = 0; j < 4; ++j) { const int col = 4 * lane + 256 * j; *(f32x4*)(a->out + (size_t)row * D + col) = v[j] * rstd * *(const f32x4*)(gf + col); }
    }
}

constexpr int PH_PER_LAYER = 10, N_PHASES = 2 + DEPTH * PH_PER_LAYER;
__global__ void __launch_bounds__(512, 2) fwd(Args args) {
    extern __shared__ __attribute__((aligned(16))) unsigned char lds_raw[];
    LAS unsigned char* lds = (LAS unsigned char*)lds_raw;
    const int tid = TID();
    volatile LAS unsigned* MISC = (volatile LAS unsigned*)(lds + MISC_OFF);
    for (int u = tid; u < (LDS_BYTES - MISC_OFF) / 4; u += 512) ((LAS unsigned*)(lds + MISC_OFF))[u] = 0u;
    __syncthreads();
    unsigned* ctl = (unsigned*)(KA()->ws + WS_CTL);
    const int lo = KA()->ph_lo, hi = KA()->ph_hi;
    XcdBarrier bar; bar.bar = ctl + CW_BAR; bar.x = 0; bar.st = nullptr;
    if (hi - lo > 1) bar = xcd_barrier_post(ctl + CW_BAR, MISC + 8);
#ifndef PH_MASK
#define PH_MASK 0xFFFFFFFFu
#endif
#define PM(b) ((PH_MASK >> (b)) & 1u)
#define IN(k) (lo <= (k) && (k) < hi)
#define SEAM(k) do { if (IN(k) && IN((k) + 1)) xcd_barrier(bar); } while (0)

    if (PM(0) && IN(0)) { phase_pre(KA(), lds); } SEAM(0);

    for (int l = 0; l < DEPTH; ++l) {
        const int pb = 1 + l * PH_PER_LAYER; const bool last = (l == DEPTH - 1); const bool moe = l & 1;
        const int Mrows = last ? ML : MROWS;
        const float* MODl = (const float*)(KA()->ws + WS_MOD) + (size_t)l * 9 * 6144;
        if (IN(pb + 0)) { if (PM(1)) convert_layer(KA(), lds, l); if (PM(2)) phase_n1(KA(), lds, l); } SEAM(pb + 0);
        if (PM(3) && IN(pb + 1)) { pg8::Gemm g{(const bf16*)(KA()->ws + WS_H), (const bf16*)(KA()->ws + WS_WIN), D}; pg8::StaticOrder S; S.init(MROWS, NP, GRD(), BID());
            pg8::EpiG1 E{(bf16*)(KA()->ws + WS_P)}; pg8::gemm_phase<pg8::EpiG1, pg8::StaticOrder, true, true>(lds, g, S, E); } SEAM(pb + 1);
        if (PM(4) && IN(pb + 2)) { phase_prep(KA(), l); } SEAM(pb + 2);
        if (IN(pb + 3)) { if (PM(5)) phase_scan_mfma(KA(), lds, l); if (PM(6)) phase_na_mfma(KA(), lds, l, last); } SEAM(pb + 3);
        if (PM(7) && IN(pb + 4)) { phase_ln(KA(), l, last); } SEAM(pb + 4);
        if (PM(8) && IN(pb + 5)) {
            { pg8::Gemm g{(const bf16*)(KA()->ws + WS_HA), (const bf16*)(KA()->ws + WS_WBRA), D}; pg8::StaticOrder S; S.init(Mrows, D, GRD(), BID());
              pg8::EpiMGa E{(const bf16*)(KA()->ws + WS_P), (float*)(KA()->ws + WS_T32)}; pg8::gemm_phase<pg8::EpiMGa, pg8::StaticOrder, false, true>(lds, g, S, E); }
            { pg8::Gemm g{(const bf16*)(KA()->ws + WS_HB), (const bf16*)(KA()->ws + WS_WBRB), D}; pg8::StaticOrder S; S.init(Mrows, D, GRD(), BID());
              pg8::EpiMGb E{(const bf16*)(KA()->ws + WS_P), (const float*)(KA()->ws + WS_T32), (bf16*)(KA()->ws + WS_U)}; pg8::gemm_phase<pg8::EpiMGb, pg8::StaticOrder, false, true>(lds, g, S, E); }
        } SEAM(pb + 5);
        if (PM(9) && IN(pb + 6)) { pg8::Gemm g{(const bf16*)(KA()->ws + WS_U), (const bf16*)(KA()->ws + WS_WOUT), D}; pg8::StaticOrder S; S.init(Mrows, D, GRD(), BID());
            const float* xl = (l == 0) ? KA()->in[0] : (const float*)(KA()->ws + WS_XR); const float* xc = (l == 0) ? KA()->in[2] : (const float*)(KA()->ws + WS_XR) + (size_t)ML * D;
            pg8::EpiRes E{xl, xc, (float*)(KA()->ws + WS_XR), MODl + 2048}; pg8::gemm_phase<pg8::EpiRes, pg8::StaticOrder, false, true>(lds, g, S, E); } SEAM(pb + 6);
        if (PM(10) && IN(pb + 7)) { phase_n2(KA(), lds, l, last); } SEAM(pb + 7);
        if (!moe) {
            if (PM(11) && IN(pb + 8)) { pg8::Gemm g{(const bf16*)(KA()->ws + WS_H), (const bf16*)(KA()->ws + WS_W13), D}; pg8::StaticOrder S; S.init(Mrows, 2 * FF, GRD(), BID());
                pg8::EpiSwiglu E{(bf16*)(KA()->ws + WS_ACT), FF}; pg8::gemm_phase<pg8::EpiSwiglu, pg8::StaticOrder, true, true>(lds, g, S, E); } SEAM(pb + 8);
            if (PM(12) && IN(pb + 9)) { pg8::Gemm g{(const bf16*)(KA()->ws + WS_ACT), (const bf16*)(KA()->ws + WS_W2), FF}; pg8::StaticOrder S; S.init(Mrows, D, GRD(), BID());
                const float* xr = (const float*)(KA()->ws + WS_XR);
                pg8::EpiRes E{xr, xr + (size_t)ML * D, (float*)(KA()->ws + WS_XR), MODl + 5120}; pg8::gemm_phase<pg8::EpiRes, pg8::StaticOrder, false, true>(lds, g, S, E); } SEAM(pb + 9);
        } else {
            if (PM(13) && (IN(pb + 8) || IN(pb + 9))) {
                int cum[NE + 1]; load_tile_prefix((unsigned*)(KA()->ws + WS_CTL) + CW_CNT + (l >> 1) * 64, cum);
                pg8::MoeOrder S; S.G = GRD(); S.c = BID(); S.TT = __builtin_amdgcn_readfirstlane(cum[8]);
                S.c1 = __builtin_amdgcn_readfirstlane(cum[1]); S.c2 = __builtin_amdgcn_readfirstlane(cum[2]); S.c3 = __builtin_amdgcn_readfirstlane(cum[3]); S.c4 = __builtin_amdgcn_readfirstlane(cum[4]);
                S.c5 = __builtin_amdgcn_readfirstlane(cum[5]); S.c6 = __builtin_amdgcn_readfirstlane(cum[6]); S.c7 = __builtin_amdgcn_readfirstlane(cum[7]);
                if (IN(pb + 8)) { S.nN = 2 * FFE / 256; S.a_estride = ECAP; S.b_estride = 2 * FFE;
                    pg8::Gemm g{(const bf16*)(KA()->ws + WS_H2S), (const bf16*)(KA()->ws + WS_W13), D};
                    pg8::EpiSwiglu E{(bf16*)(KA()->ws + WS_ACT), FFE}; pg8::gemm_phase<pg8::EpiSwiglu, pg8::MoeOrder, true, true>(lds, g, S, E); }
                SEAM(pb + 8);
                if (IN(pb + 9)) { S.nN = D / 256; S.a_estride = 0; S.b_estride = D;
                    pg8::Gemm g{(const bf16*)(KA()->ws + WS_ACT), (const bf16*)(KA()->ws + WS_W2), FFE};
                    pg8::EpiF32 E{(float*)(KA()->ws + WS_YS)}; pg8::gemm_phase<pg8::EpiF32, pg8::MoeOrder, false, true>(lds, g, S, E); }
            }
            SEAM(pb + 9);
        }
    }
    if (PM(14) && IN(N_PHASES - 1)) phase_final(KA());
#undef IN
#undef SEAM
}

extern "C" void kernel_launch(void* const* d_in, const int* in_sizes, int n_in, void* d_out, int out_size, void* d_ws, size_t ws_size, hipStream_t stream) {
    static int grid = 0;
    if (grid == 0) {
        if (n_in != 24 || out_size != ML * D || ws_size < WS_END) { fprintf(stderr, "kernel_launch: unexpected shapes / workspace (%d inputs, out %d, ws %zu < %zu)\n", n_in, out_size, ws_size, (size_t)WS_END); grid = -1; return; }
        int dev = 0, cus = 0;
        if (hipGetDevice(&dev) != hipSuccess || hipDeviceGetAttribute(&cus, hipDeviceAttributeMultiprocessorCount, dev) != hipSuccess) { grid = -1; return; }
        if (hipFuncSetAttribute((const void*)fwd, hipFuncAttributeMaxDynamicSharedMemorySize, LDS_BYTES) != hipSuccess) { fprintf(stderr, "kernel_launch: hipFuncSetAttribute failed\n"); grid = -1; return; }
        int per_cu = 0; (void)hipOccupancyMaxActiveBlocksPerMultiprocessor(&per_cu, (const void*)fwd, 512, LDS_BYTES); (void)hipGetLastError();
        if (per_cu < 1) fprintf(stderr, "kernel_launch: occupancy query reports %d\n", per_cu);
        grid = cus;
    }
    if (grid < 0) return;
    (void)hipMemsetAsync((char*)d_ws + WS_CTL, 0, CTL_ZERO_BYTES, stream);
    Args a{};
    for (int i = 0; i < 24; ++i) a.in[i] = (const float*)d_in[i];
    a.out = (float*)d_out; a.ws = (unsigned char*)d_ws;
#if MK_PER_PHASE
    for (int p = 0; p < N_PHASES; ++p) { a.ph_lo = p; a.ph_hi = p + 1; hipLaunchKernelGGL(fwd, dim3(grid), dim3(512), LDS_BYTES, stream, a); }
#else
    a.ph_lo = 0; a.ph_hi = N_PHASES; hipLaunchKernelGGL(fwd, dim3(grid), dim3(512), LDS_BYTES, stream, a);
#endif
}
```

```cpp
#include <hip/hip_runtime.h>
#include <cstdio>
#include <cstdint>

#ifndef MK_PER_PHASE
#define MK_PER_PHASE 0
#endif

#ifndef REP_MASK
#define REP_MASK 0u
#endif
#define REP(k) ((REP_MASK >> (k)) & 1u)
#ifndef PROBE_SEL
#define PROBE_SEL -1
#endif
#define LAS __attribute__((address_space(3)))
typedef unsigned short bf16;
typedef short bf16x8 __attribute__((ext_vector_type(8)));
typedef float f32x4 __attribute__((ext_vector_type(4)));
typedef float f32x2 __attribute__((ext_vector_type(2)));
typedef unsigned u32x4 __attribute__((ext_vector_type(4)));
typedef unsigned u32x2 __attribute__((ext_vector_type(2)));

constexpr int D = 1024, NB = 8, TL = 2048, TC = 256, DEPTH = 4;
constexpr int ML = NB * TL, MC = NB * TC, MROWS = ML + MC;
constexpr int DIN = 8208, NP = 8192;
constexpr int PC_Q = 0, PC_K = 512, PC_V = 1024, PC_O = 2048, PC_NQ = 3072, PC_NK = 4096, PC_NV = 5120, PC_GA = 6144, PC_GB = 7168;
constexpr int FF = 2816, FFE = 3584, NE = 8;
constexpr int ECAP = MROWS;
constexpr int MOE_ROWS = 38912;
constexpr float EPS = 1e-6f;

constexpr size_t MiB = 1u << 20;
constexpr size_t WS_CTL = 0, CTL_ZERO_BYTES = 1 * MiB;
constexpr size_t WS_MOD = 1 * MiB;
constexpr size_t WS_RTI = 2 * MiB;
constexpr size_t WS_RTW = 2 * MiB + 512 * 1024;
constexpr size_t WS_ROPE = 2 * MiB + 768 * 1024;
constexpr size_t WS_GPRE = 3 * MiB;
constexpr size_t WS_XR = 5 * MiB;
constexpr size_t WS_H = 77 * MiB;
constexpr size_t WS_WIN = 113 * MiB;
constexpr size_t WS_WBRA = 129 * MiB, WS_WBRB = 131 * MiB, WS_WOUT = 133 * MiB;
constexpr size_t WS_W13 = 135 * MiB;
constexpr size_t WS_W2 = 247 * MiB;
constexpr size_t WS_GA = 303 * MiB;
constexpr size_t WS_P = WS_GA;
constexpr size_t WS_QK = WS_GA + 288 * MiB;
constexpr size_t WS_HS = WS_GA + 324 * MiB;
constexpr size_t WS_HB = WS_GA + 468 * MiB;
constexpr size_t WS_HA = WS_GA + 504 * MiB;
constexpr size_t WS_T32 = WS_GA + 540 * MiB;
constexpr size_t WS_U = WS_GA + 612 * MiB;
constexpr size_t WS_ACT = WS_GA;
constexpr size_t WS_H2S = WS_GA + 266 * MiB;
constexpr size_t WS_YS = WS_GA + 554 * MiB;
constexpr size_t WS_END = WS_GA + 706 * MiB;
static_assert((size_t)MOE_ROWS * FFE * 2 <= 266 * MiB && (size_t)NE * ECAP * D * 2 <= 288 * MiB && (size_t)MOE_ROWS * D * 4 <= 152 * MiB, "ffn view");

constexpr int CW_BAR = 4096;
constexpr int CW_CNT = 16384;
constexpr int CW_TS = 32768;

constexpr int RING_BYTES = 131072;
constexpr int LDS_BYTES = 147456;
constexpr int MISC_OFF = LDS_BYTES - 256;

__device__ __forceinline__ unsigned f2bf(float f) { unsigned u = __builtin_bit_cast(unsigned, f); return (u + 0x7fffu + ((u >> 16) & 1u)) >> 16; }
__device__ __forceinline__ unsigned pk2(float lo, float hi) { return f2bf(lo) | (f2bf(hi) << 16); }
__device__ __forceinline__ float bf2f(unsigned b) { return __builtin_bit_cast(float, b << 16); }
__device__ __forceinline__ float bflo(unsigned w) { return __builtin_bit_cast(float, w << 16); }
__device__ __forceinline__ float bfhi(unsigned w) { return __builtin_bit_cast(float, w & 0xffff0000u); }
__device__ __forceinline__ float sigmoidf_(float x) { return 1.f / (1.f + __expf(-x)); }
__device__ __forceinline__ float wave_sum(float v) {
#pragma unroll
    for (int o = 1; o < 64; o <<= 1) v += __shfl_xor(v, o);
    return v;
}
__device__ __forceinline__ float wave_max(float v) {
#pragma unroll
    for (int o = 1; o < 64; o <<= 1) v = fmaxf(v, __shfl_xor(v, o));
    return v;
}
__device__ __forceinline__ int TID() { int t = threadIdx.x; asm volatile("" : "+v"(t)); return t; }
__device__ __forceinline__ int BID() { int b = blockIdx.x; asm volatile("" : "+s"(b)); return b; }
__device__ __forceinline__ int GRD() { int g = gridDim.x; asm volatile("" : "+s"(g)); return g; }
#define LDS_WAIT() asm volatile("s_waitcnt lgkmcnt(0)" ::: "memory")

namespace pg8 {
constexpr int BM = 256, BK = 64, HALF = 128, HTB = HALF * BK * 2, STAGE_BYTES = 8 * HTB, NXCD = 8, WGM = 8;
__host__ __device__ __forceinline__ int lds_byte(int r, int c) { const int st = (r >> 4) * 2 + (c >> 5), rr = r & 15, cc = c & 31, ob = rr * 64 + cc * 2; return st * 1024 + (ob ^ (((ob >> 9) & 1) << 5)); }
__host__ __device__ __forceinline__ void stage_rc(int b, int& R, int& C) { const int st = b / 1024, sb = b % 1024, swz = sb ^ (((sb >> 9) & 1) << 5); R = (st >> 1) * 16 + swz / 64; C = (st & 1) * 32 + (swz % 64) / 2; }
__host__ __device__ __forceinline__ int perm32(int rho) { const int n = rho >> 4, i = rho & 15; return 8 * (i >> 2) + 4 * n + (i & 3); }

struct Unit { int arow, brow, orow, ocol, aux; };
struct Gemm { const bf16* A; const bf16* Bt; int K; };

struct StaticOrder {
    int nM, nN, nwg, G, c;
    __device__ void init(int M, int N, int G_, int c_) { nM = M / BM; nN = N / BM; nwg = nM * nN; G = G_; c = c_; }
    __device__ __forceinline__ bool next(int i, Unit& u) const {
        const long L = (long)i * G + c; if (L >= nwg) return false;
        int wgid = (int)L; { const int q = nwg / NXCD, r = nwg % NXCD, xcd = wgid % NXCD, off = wgid / NXCD; wgid = (xcd < r ? xcd * (q + 1) : r * (q + 1) + (xcd - r) * q) + off; }
        const int nig = WGM * nN, gid = wgid / nig, fm = gid * WGM, gsz = (nM - fm) < WGM ? (nM - fm) : WGM;
        const int pm = fm + ((wgid % nig) % gsz), pn = (wgid % nig) / gsz;
        u.arow = pm * BM; u.brow = pn * BM; u.orow = pm * BM; u.ocol = pn * BM; u.aux = 0; return true;
    }
};
struct MoeOrder {
    int nN, G, c, TT; int c1, c2, c3, c4, c5, c6, c7;
    int a_estride;
    int b_estride;
    __device__ __forceinline__ bool next(int i, Unit& u) const {
        const int nwg = TT * nN; const long L = (long)i * G + c; if (L >= nwg) return false;
        int wgid = (int)L; { const int q = nwg / NXCD, r = nwg % NXCD, xcd = wgid % NXCD, off = wgid / NXCD; wgid = (xcd < r ? xcd * (q + 1) : r * (q + 1) + (xcd - r) * q) + off; }
        const int nig = WGM * nN, gid = wgid / nig, fm = gid * WGM, gsz = (TT - fm) < WGM ? (TT - fm) : WGM;
        const int g = fm + ((wgid % nig) % gsz), pn = (wgid % nig) / gsz;
        const int e = (g >= c1) + (g >= c2) + (g >= c3) + (g >= c4) + (g >= c5) + (g >= c6) + (g >= c7);
        int cb = 0; cb = e >= 1 ? c1 : cb; cb = e >= 2 ? c2 : cb; cb = e >= 3 ? c3 : cb; cb = e >= 4 ? c4 : cb; cb = e >= 5 ? c5 : cb; cb = e >= 6 ? c6 : cb; cb = e >= 7 ? c7 : cb;
        const int rt = g - cb;
        u.arow = a_estride ? e * a_estride + rt * BM : g * BM; u.brow = e * b_estride + pn * BM; u.orow = g * BM; u.ocol = pn * BM; u.aux = e; return true;
    }
};

__device__ __forceinline__ unsigned cvt_pk_bf16(float lo, float hi) { unsigned r; asm volatile("v_cvt_pk_bf16_f32 %0, %1, %2" : "=v"(r) : "v"(lo), "v"(hi)); return r; }

template <class Epi, class Sched, bool ALIGN_EPI = false, bool SP2 = true>
__device__ __forceinline__ void gemm_phase(LAS unsigned char* lds, const Gemm g, const Sched& S, const Epi& E) {
    const int tid = TID(), wid = __builtin_amdgcn_readfirstlane(tid >> 6), lane = tid & 63, wr = wid >> 2, wc = wid & 3, fr = lane & 15, fq = lane >> 4;
    const int K = g.K, nt = K / BK;
    unsigned voffA[2], voffB[2];
#pragma unroll
    for (int i = 0; i < 2; ++i) { int R, C; stage_rc(tid * 16 + i * 8192, R, C); const int Rb = Epi::PERM ? ((R & ~31) + perm32(R & 31)) : R;
        voffA[i] = (unsigned)(R * K + C) * 2u; voffB[i] = (unsigned)(Rb * K + C) * 2u; }
    const size_t kstep = (size_t)(BK * 2);
    const size_t hstep = (size_t)HALF * K * 2;
    const size_t rstep = (size_t)K * 2;
    const unsigned ldsw = (unsigned)wid * 1024u;
    const int aoff = lds_byte(wr * 64 + fr, fq * 8), boff = lds_byte(wc * 32 + fr, fq * 8);
#define PG8_SA(b, h) (((b) * 2 + (h)) * HTB)
#define PG8_SB(b, h) ((4 + (b) * 2 + (h)) * HTB)
#define PG8_STAGE(bufoff, gbase, voff) do { _Pragma("unroll") for (int _i = 0; _i < 2; ++_i) \
        __builtin_amdgcn_global_load_lds((const unsigned*)((const char*)(gbase) + (voff)[_i]), (LAS unsigned*)(lds + (bufoff) + ldsw + _i * 8192), 16, 0, 0); } while (0)
#define PG8_LDA(dst, b, h) do { _Pragma("unroll") for (int m = 0; m < 4; ++m) _Pragma("unroll") for (int k = 0; k < 2; ++k) dst[m][k] = *(const LAS bf16x8*)(lds + PG8_SA(b, h) + aoff + m * 2048 + k * 1024); } while (0)
#define PG8_LDB(dst, b, h) do { _Pragma("unroll") for (int n = 0; n < 2; ++n) _Pragma("unroll") for (int k = 0; k < 2; ++k) dst[n][k] = *(const LAS bf16x8*)(lds + PG8_SB(b, h) + boff + n * 2048 + k * 1024); } while (0)
#define PG8_MMA(ai, bj, At, Bt) do { __builtin_amdgcn_s_setprio(1); _Pragma("unroll") for (int m = 0; m < 4; ++m) _Pragma("unroll") for (int n = 0; n < 2; ++n) _Pragma("unroll") for (int k = 0; k < 2; ++k) \
        acc[ai][bj][m][n] = __builtin_amdgcn_mfma_f32_16x16x32_bf16(Bt[n][k], At[m][k], acc[ai][bj][m][n], 0, 0, 0); __builtin_amdgcn_s_setprio(0); } while (0)
#define PG8_WAIT_V(n) asm volatile("s_waitcnt vmcnt(" #n ")" ::: "memory")
#define PG8_WAIT_L(n) asm volatile("s_waitcnt lgkmcnt(" #n ")" ::: "memory")
#define PG8_BAR __builtin_amdgcn_s_barrier()
#define PG8_SCHED __builtin_amdgcn_sched_barrier(0)
    Unit cur, nxt; int ui = 0;
    if (!S.next(0, cur)) return;
    f32x4 acc[2][2][4][2];
#pragma unroll
    for (int a = 0; a < 2; ++a)
#pragma unroll
        for (int b = 0; b < 2; ++b)
#pragma unroll
            for (int m = 0; m < 4; ++m)
#pragma unroll
                for (int n = 0; n < 2; ++n) acc[a][b][m][n] = (f32x4){0.f, 0.f, 0.f, 0.f};
    bf16x8 At[4][2], B0[2][2], B1[2][2];
    const char* cA = (const char*)g.A + (size_t)cur.arow * rstep; const char* cB = (const char*)g.Bt + (size_t)cur.brow * rstep;
    if constexpr (SP2) {
        PG8_STAGE(PG8_SB(0, 0), cB, voffB); PG8_STAGE(PG8_SB(0, 1), cB + hstep, voffB); PG8_STAGE(PG8_SA(0, 0), cA, voffA); PG8_STAGE(PG8_SA(0, 1), cA + hstep, voffA);
        if (wr == 1) PG8_BAR;
        PG8_WAIT_V(2); PG8_BAR;
        PG8_STAGE(PG8_SB(1, 0), cB + kstep, voffB); PG8_STAGE(PG8_SA(1, 0), cA + kstep, voffA); PG8_STAGE(PG8_SB(1, 1), cB + hstep + kstep, voffB);
        PG8_WAIT_V(6); PG8_BAR;
    } else {
        PG8_STAGE(PG8_SB(0, 0), cB, voffB); PG8_STAGE(PG8_SA(0, 0), cA, voffA); PG8_STAGE(PG8_SB(0, 1), cB + hstep, voffB); PG8_STAGE(PG8_SA(0, 1), cA + hstep, voffA);
        if (wr == 1) PG8_BAR;
        PG8_WAIT_V(4); PG8_BAR;
        PG8_STAGE(PG8_SB(1, 0), cB + kstep, voffB); PG8_STAGE(PG8_SA(1, 0), cA + kstep, voffA); PG8_STAGE(PG8_SB(1, 1), cB + hstep + kstep, voffB);
        PG8_WAIT_V(6); PG8_BAR;
    }
    for (;;) {
        const bool has_next = S.next(ui + 1, nxt);
        const char* nA = has_next ? (const char*)g.A + (size_t)nxt.arow * rstep : cA; const char* nB = has_next ? (const char*)g.Bt + (size_t)nxt.brow * rstep : cB;
        for (int t = 0; t < nt; t += 2) {
            const bool last = (t == nt - 2);
            const char* a1 = cA + (size_t)(t + 1) * kstep;
            const char* a2 = last ? nA : cA + (size_t)(t + 2) * kstep; const char* b2 = last ? nB : cB + (size_t)(t + 2) * kstep;
            const char* a3 = a2 + kstep; const char* b3 = b2 + kstep;
            if constexpr (SP2) {
            PG8_LDB(B0, 0, 0); PG8_LDB(B1, 0, 1); PG8_SCHED; PG8_LDA(At, 0, 0); PG8_STAGE(PG8_SA(1, 1), a1 + hstep, voffA);
            PG8_WAIT_V(8); PG8_WAIT_L(0); PG8_BAR; PG8_MMA(0, 0, At, B0); PG8_MMA(0, 1, At, B1); PG8_BAR; PG8_SCHED;
            PG8_LDA(At, 0, 1); PG8_STAGE(PG8_SB(0, 0), b2, voffB); PG8_STAGE(PG8_SB(0, 1), b2 + hstep, voffB); PG8_STAGE(PG8_SA(0, 0), a2, voffA);
            PG8_WAIT_V(8); PG8_WAIT_L(0); PG8_BAR; PG8_MMA(1, 0, At, B0); PG8_MMA(1, 1, At, B1); PG8_BAR; PG8_SCHED;
            PG8_LDB(B0, 1, 0); PG8_LDB(B1, 1, 1); PG8_SCHED; PG8_LDA(At, 1, 0); PG8_STAGE(PG8_SA(0, 1), a2 + hstep, voffA);
            PG8_WAIT_V(8); PG8_WAIT_L(0); PG8_BAR; PG8_MMA(0, 0, At, B0); PG8_MMA(0, 1, At, B1); PG8_BAR; PG8_SCHED;
            PG8_LDA(At, 1, 1); PG8_STAGE(PG8_SB(1, 0), b3, voffB); PG8_STAGE(PG8_SB(1, 1), b3 + hstep, voffB); PG8_STAGE(PG8_SA(1, 0), a3, voffA);
            PG8_WAIT_V(8); PG8_WAIT_L(0); PG8_BAR; PG8_MMA(1, 0, At, B0); PG8_MMA(1, 1, At, B1); PG8_BAR; PG8_SCHED;
            } else {
            PG8_LDB(B0, 0, 0); PG8_SCHED; PG8_LDA(At, 0, 0); PG8_STAGE(PG8_SA(1, 1), a1 + hstep, voffA);
            PG8_WAIT_L(8); PG8_BAR; PG8_WAIT_L(0); PG8_MMA(0, 0, At, B0); PG8_BAR; PG8_SCHED;
            PG8_LDB(B1, 0, 1); PG8_STAGE(PG8_SB(0, 0), b2, voffB);
            PG8_BAR; PG8_WAIT_L(0); PG8_MMA(0, 1, At, B1); PG8_BAR;
            PG8_LDA(At, 0, 1); PG8_STAGE(PG8_SA(0, 0), a2, voffA);
            PG8_BAR; PG8_WAIT_L(0); PG8_MMA(1, 0, At, B0); PG8_BAR; PG8_SCHED;
            PG8_STAGE(PG8_SB(0, 1), b2 + hstep, voffB);
            PG8_WAIT_V(6); PG8_BAR; PG8_MMA(1, 1, At, B1); PG8_BAR;
            PG8_LDB(B0, 1, 0); PG8_SCHED; PG8_LDA(At, 1, 0); PG8_STAGE(PG8_SA(0, 1), a2 + hstep, voffA);
            PG8_WAIT_L(8); PG8_BAR; PG8_WAIT_L(0); PG8_MMA(0, 0, At, B0); PG8_BAR; PG8_SCHED;
            PG8_LDB(B1, 1, 1); PG8_STAGE(PG8_SB(1, 0), b3, voffB);
            PG8_BAR; PG8_WAIT_L(0); PG8_MMA(0, 1, At, B1); PG8_BAR;
            PG8_LDA(At, 1, 1); PG8_STAGE(PG8_SA(1, 0), a3, voffA);
            PG8_BAR; PG8_WAIT_L(0); PG8_MMA(1, 0, At, B0); PG8_BAR; PG8_SCHED;
            PG8_STAGE(PG8_SB(1, 1), b3 + hstep, voffB);
            PG8_WAIT_V(6); PG8_BAR; PG8_MMA(1, 1, At, B1); PG8_BAR;
            }
        }
        if constexpr (ALIGN_EPI) { if (wr == 0) PG8_BAR; }
        E(acc, cur, wr, wc, fr, fq);
        if (!has_next) break;
#pragma unroll
        for (int a = 0; a < 2; ++a)
#pragma unroll
            for (int b = 0; b < 2; ++b)
#pragma unroll
                for (int m = 0; m < 4; ++m)
#pragma unroll
                    for (int n = 0; n < 2; ++n) acc[a][b][m][n] = (f32x4){0.f, 0.f, 0.f, 0.f};
        cur = nxt; cA = nA; cB = nB; ++ui;
        if constexpr (ALIGN_EPI) { if (wr == 1) PG8_BAR; }
    }
    PG8_WAIT_V(0);
    if constexpr (!ALIGN_EPI) { if (wr == 0) PG8_BAR; }
    PG8_BAR;
#undef PG8_SA
#undef PG8_SB
#undef PG8_STAGE
#undef PG8_LDA
#undef PG8_LDB
#undef PG8_MMA
#undef PG8_WAIT_V
#undef PG8_WAIT_L
#undef PG8_BAR
#undef PG8_SCHED
}

typedef const f32x4 (&AccRef)[2][2][4][2];
struct EpiG1 {
    static constexpr bool PERM = true;
    bf16* O;
    __device__ __forceinline__ void operator()(AccRef acc, const Unit& u, int wr, int wc, int fr, int fq) const {
        const int t = u.ocol >> 8; const int mode = ((t >= 8 && t < 12) || t >= 24) ? 1 : ((t >= 12 && t < 16) ? 2 : 0);
        const int row0 = u.orow + wr * 64 + fr, col0 = u.ocol + wc * 32 + 8 * fq;
#pragma unroll
        for (int ai = 0; ai < 2; ++ai)
#pragma unroll
            for (int m = 0; m < 4; ++m) { bf16* rowp = O + (size_t)(row0 + ai * HALF + m * 16) * NP + col0;
#pragma unroll
                for (int bj = 0; bj < 2; ++bj) { f32x4 v0 = acc[ai][bj][m][0], v1 = acc[ai][bj][m][1];
                    if (mode == 1) {
#pragma unroll
                        for (int j = 0; j < 4; ++j) { v0[j] = sigmoidf_(v0[j]); v1[j] = sigmoidf_(v1[j]); } }
                    else if (mode == 2) { v0 = v0 * 0.125f; v1 = v1 * 0.125f; }
                    u32x4 w; w.x = cvt_pk_bf16(v0[0], v0[1]); w.y = cvt_pk_bf16(v0[2], v0[3]); w.z = cvt_pk_bf16(v1[0], v1[1]); w.w = cvt_pk_bf16(v1[2], v1[3]);
                    *(u32x4*)(rowp + bj * HALF) = w; } }
    }
};
struct EpiMGa {
    static constexpr bool PERM = true;
    const bf16* P; float* T;
    __device__ __forceinline__ void operator()(AccRef acc, const Unit& u, int wr, int wc, int fr, int fq) const {
        const int row0 = u.orow + wr * 64 + fr, col0 = u.ocol + wc * 32 + 8 * fq;
#pragma unroll
        for (int ai = 0; ai < 2; ++ai)
#pragma unroll
            for (int m = 0; m < 4; ++m) { const size_t r = (size_t)(row0 + ai * HALF + m * 16);
#pragma unroll
                for (int bj = 0; bj < 2; ++bj) { const int c = col0 + bj * HALF;
                    const u32x4 gw = *(const u32x4*)(P + r * NP + PC_GA + c);
                    f32x4 v0 = acc[ai][bj][m][0], v1 = acc[ai][bj][m][1];
                    v0[0] *= bflo(gw.x); v0[1] *= bfhi(gw.x); v0[2] *= bflo(gw.y); v0[3] *= bfhi(gw.y);
                    v1[0] *= bflo(gw.z); v1[1] *= bfhi(gw.z); v1[2] *= bflo(gw.w); v1[3] *= bfhi(gw.w);
                    *(f32x4*)(T + r * D + c) = v0; *(f32x4*)(T + r * D + c + 4) = v1; } }
    }
};
struct EpiMGb {
    static constexpr bool PERM = true;
    const bf16* P; const float* T; bf16* U;
    __device__ __forceinline__ void operator()(AccRef acc, const Unit& u, int wr, int wc, int fr, int fq) const {
        const int row0 = u.orow + wr * 64 + fr, col0 = u.ocol + wc * 32 + 8 * fq;
#pragma unroll
        for (int ai = 0; ai < 2; ++ai)
#pragma unroll
            for (int m = 0; m < 4; ++m) { const size_t r = (size_t)(row0 + ai * HALF + m * 16);
#pragma unroll
                for (int bj = 0; bj < 2; ++bj) { const int c = col0 + bj * HALF;
                    const u32x4 gw = *(const u32x4*)(P + r * NP + PC_GB + c);
                    const f32x4 t0 = *(const f32x4*)(T + r * D + c), t1 = *(const f32x4*)(T + r * D + c + 4);
                    f32x4 v0 = acc[ai][bj][m][0], v1 = acc[ai][bj][m][1];
                    v0[0] = t0[0] + v0[0] * bflo(gw.x); v0[1] = t0[1] + v0[1] * bfhi(gw.x); v0[2] = t0[2] + v0[2] * bflo(gw.y); v0[3] = t0[3] + v0[3] * bfhi(gw.y);
                    v1[0] = t1[0] + v1[0] * bflo(gw.z); v1[1] = t1[1] + v1[1] * bfhi(gw.z); v1[2] = t1[2] + v1[2] * bflo(gw.w); v1[3] = t1[3] + v1[3] * bfhi(gw.w);
                    u32x4 w; w.x = cvt_pk_bf16(v0[0], v0[1]); w.y = cvt_pk_bf16(v0[2], v0[3]); w.z = cvt_pk_bf16(v1[0], v1[1]); w.w = cvt_pk_bf16(v1[2], v1[3]);
                    *(u32x4*)(U + r * D + c) = w; } }
    }
};
struct EpiRes {
    static constexpr bool PERM = false;
    const float* xin_lat; const float* xin_ctx; float* XO; const float* gate;
    __device__ __forceinline__ void operator()(AccRef acc, const Unit& u, int wr, int wc, int fr, int fq) const {
        const int row0 = u.orow + wr * 64 + fr, col0 = u.ocol + wc * 32 + 4 * fq;
        const int mr = u.orow < ML ? (u.orow >> 11) : 8;
        const float* gp = gate + (size_t)mr * 6144 + col0;
        f32x4 gv[2][2];
#pragma unroll
        for (int bj = 0; bj < 2; ++bj)
#pragma unroll
            for (int n = 0; n < 2; ++n) gv[bj][n] = *(const f32x4*)(gp + bj * HALF + n * 16);
        const float* xb = u.orow < ML ? xin_lat : xin_ctx - (size_t)ML * D;
#pragma unroll
        for (int ai = 0; ai < 2; ++ai)
#pragma unroll
            for (int m = 0; m < 4; ++m) { const size_t r = (size_t)(row0 + ai * HALF + m * 16);
#pragma unroll
                for (int bj = 0; bj < 2; ++bj)
#pragma unroll
                    for (int n = 0; n < 2; ++n) { const int c = col0 + bj * HALF + n * 16;
                        const f32x4 xi = *(const f32x4*)(xb + r * D + c);
                        *(f32x4*)(XO + r * D + c) = xi + gv[bj][n] * acc[ai][bj][m][n]; } }
    }
};
struct EpiF32 {
    static constexpr bool PERM = false;
    float* Y;
    __device__ __forceinline__ void operator()(AccRef acc, const Unit& u, int wr, int wc, int fr, int fq) const {
        const int row0 = u.orow + wr * 64 + fr, col0 = u.ocol + wc * 32 + 4 * fq;
#pragma unroll
        for (int ai = 0; ai < 2; ++ai)
#pragma unroll
            for (int m = 0; m < 4; ++m) { const size_t r = (size_t)(row0 + ai * HALF + m * 16);
#pragma unroll
                for (int bj = 0; bj < 2; ++bj)
#pragma unroll
                    for (int n = 0; n < 2; ++n) *(f32x4*)(Y + r * D + col0 + bj * HALF + n * 16) = acc[ai][bj][m][n]; }
    }
};
struct EpiSwiglu {
    static constexpr bool PERM = false;
    bf16* ACT; int ldf;
    __device__ __forceinline__ void operator()(AccRef acc, const Unit& u, int wr, int wc, int fr, int fq) const {
        const int row0 = u.orow + wr * 64 + fr, f0 = (u.ocol >> 1) + wc * 16 + 4 * fq;
#pragma unroll
        for (int ai = 0; ai < 2; ++ai)
#pragma unroll
            for (int m = 0; m < 4; ++m) { const size_t r = (size_t)(row0 + ai * HALF + m * 16);
#pragma unroll
                for (int bj = 0; bj < 2; ++bj) { const f32x4 a = acc[ai][bj][m][0], b = acc[ai][bj][m][1]; f32x4 o;
#pragma unroll
                    for (int j = 0; j < 4; ++j) o[j] = a[j] * sigmoidf_(a[j]) * b[j];
                    u32x2 w; w.x = cvt_pk_bf16(o[0], o[1]); w.y = cvt_pk_bf16(o[2], o[3]);
                    *(u32x2*)(ACT + r * ldf + f0 + bj * 64) = w; } }
    }
};
}

#define XB_TMO      128
#define XB_XCNT(j)  (256  + 64 * (j))
#define XB_XSUB(j)  (1280 + 64 * (j))
#define XB_XGEN(j)  (2304 + 64 * (j))
#define XB_TOP      3328
#define XB_TOPGEN   3392
#define XCD_BAR_WORDS 3456
#define XB_SPIN_CAP (1u << 18)
__device__ __forceinline__ unsigned xb_ld(unsigned* p)              { return __hip_atomic_load(p, __ATOMIC_RELAXED, __HIP_MEMORY_SCOPE_AGENT); }
__device__ __forceinline__ unsigned xb_add(unsigned* p, unsigned v) { return __hip_atomic_fetch_add(p, v, __ATOMIC_RELAXED, __HIP_MEMORY_SCOPE_AGENT); }
__device__ __forceinline__ unsigned xb_xcc_id() { return (unsigned)__builtin_amdgcn_s_getreg((3 << 11) | 20) & 0xFu; }
#define XB_SPIN(cond, bar) do { unsigned _sp = 0; while (cond) { __builtin_amdgcn_s_sleep(1); \
    if ((++_sp & 255u) == 0u) { if (xb_ld(&(bar)[XB_TMO])) break; if (_sp > XB_SPIN_CAP) { atomicAdd(&(bar)[XB_TMO], 1u); break; } } } } while (0)
struct XcdBarrier { unsigned* bar; unsigned x; volatile LAS unsigned* st; };
__device__ __forceinline__ XcdBarrier xcd_barrier_post(unsigned* bar, volatile LAS unsigned* st) {
    XcdBarrier b; b.bar = bar; b.x = xb_xcc_id(); b.st = st;
    if (threadIdx.x == 0) (void)xb_add(&bar[XB_XCNT(b.x)], 1u);
    return b;
}
__device__ __forceinline__ void xcd_barrier_complete(unsigned* bar, unsigned x, unsigned& nloc, unsigned& nx) {
    const unsigned G = gridDim.x * gridDim.y * gridDim.z;
    unsigned sum, cnt, mine, sp = 0u;
    for (;;) {
        sum = 0u; cnt = 0u; mine = 0u;
#pragma unroll
        for (unsigned j = 0; j < 16; ++j) { const unsigned c = xb_ld(&bar[XB_XCNT(j)]); sum += c; cnt += (c > 0u) ? 1u : 0u; mine = (j == x) ? c : mine; }
        if (sum == G) break;
        __builtin_amdgcn_s_sleep(1);
        if ((++sp & 255u) == 0u) { if (xb_ld(&bar[XB_TMO])) break; if (sp > XB_SPIN_CAP) { atomicAdd(&bar[XB_TMO], 1u); break; } }
    }
    nloc = mine > 0u ? mine : 1u; nx = cnt > 0u ? cnt : 1u;
}
__device__ __forceinline__ void xcd_barrier(const XcdBarrier& b) {
    asm volatile("s_waitcnt vmcnt(0)" ::: "memory");
    __syncthreads();
    if (threadIdx.x == 0) {
        unsigned* bar = b.bar;
        __builtin_amdgcn_s_waitcnt(0);
        unsigned nloc = b.st[0], nx = b.st[1];
        if (nloc == 0u) { xcd_barrier_complete(bar, b.x, nloc, nx); b.st[0] = nloc; b.st[1] = nx; }
        const unsigned old = xb_add(&bar[XB_XSUB(b.x)], 1u);
        const unsigned gen = old / nloc;
        if (old + 1u == (gen + 1u) * nloc) {
            __builtin_amdgcn_fence(__ATOMIC_RELEASE, "agent");
            asm volatile("s_waitcnt vmcnt(0)" ::: "memory");
            const unsigned og = xb_add(&bar[XB_TOP], 1u);
            const unsigned tg = og / nx;
            if (og + 1u == (tg + 1u) * nx) xb_add(&bar[XB_TOPGEN], 1u);
            else XB_SPIN(xb_ld(&bar[XB_TOPGEN]) == tg, bar);
            __builtin_amdgcn_fence(__ATOMIC_ACQUIRE, "agent");
            xb_add(&bar[XB_XGEN(b.x)], 1u);
            asm volatile("s_waitcnt vmcnt(0)" ::: "memory");
        } else {
            XB_SPIN(xb_ld(&bar[XB_XGEN(b.x)]) == gen, bar);
            __builtin_amdgcn_fence(__ATOMIC_ACQUIRE, "agent");
            asm volatile("s_waitcnt vmcnt(0)" ::: "memory");
        }
    }
    __syncthreads();
}

struct Args { const float* in[24]; float* out; unsigned char* ws; int ph_lo, ph_hi; };
typedef const __attribute__((address_space(4))) Args* KArgs;
__device__ __forceinline__ KArgs KA() { KArgs p = (KArgs)__builtin_amdgcn_kernarg_segment_ptr(); asm volatile("" : "+s"(p)); return p; }
struct Ctx {
    LAS unsigned char* lds; int tid, lane, wave, G, vcu;
    const float* const* dummy;
};

__device__ __forceinline__ void phase_pre(KArgs a, LAS unsigned char* lds) {
    const int tid = TID(), G = GRD();
    LAS float* sv = (LAS float*)lds;
    LAS float* red = sv + 9 * 1024;
    const float* c = a->in[1]; const float* cc = a->in[3]; const float* w_mod = a->in[4]; const float* b_mod = a->in[5];
    float* MOD = (float*)(a->ws + WS_MOD);
    { float* ROPE = (float*)(a->ws + WS_ROPE);
      for (int i = BID() * 512 + tid; i < 64 * 32; i += GRD() * 512) { const int pos = i >> 5, ii = i & 31; const float inv = 1.0f / powf(10000.0f, (float)ii / 32.0f); float sn, cs; sincosf((float)pos * inv, &sn, &cs); ROPE[2 * i] = cs; ROPE[2 * i + 1] = sn; } }
    for (int i = tid; i < 9 * 1024; i += 512) { const int r = i >> 10, k = i & 1023; const float v = r < 8 ? c[r * 1024 + k] : cc[k]; sv[i] = v * sigmoidf_(v); }
    __syncthreads();
    for (int item = BID(); item < DEPTH * 48; item += G) {
        const int l = item / 48, n0 = (item % 48) * 128, kq = tid >> 7, cl = tid & 127;
        float acc[9];
#pragma unroll
        for (int r = 0; r < 9; ++r) acc[r] = 0.f;
        const float* w = w_mod + ((size_t)l * 1024 + kq * 256) * 6144 + n0 + cl;
#pragma unroll 4
        for (int k = 0; k < 256; ++k) { const float wv = w[(size_t)k * 6144];
#pragma unroll
            for (int r = 0; r < 9; ++r) acc[r] += sv[r * 1024 + kq * 256 + k] * wv; }
#pragma unroll
        for (int r = 0; r < 9; ++r) red[(kq * 9 + r) * 128 + cl] = acc[r];
        __syncthreads();
        for (int o = tid; o < 9 * 128; o += 512) { const int r = o >> 7, q = o & 127;
            const float s = red[(0 * 9 + r) * 128 + q] + red[(1 * 9 + r) * 128 + q] + red[(2 * 9 + r) * 128 + q] + red[(3 * 9 + r) * 128 + q] + b_mod[l * 6144 + n0 + q];
            MOD[(size_t)(l * 9 + r) * 6144 + n0 + q] = s; }
        __syncthreads();
    }
}

__device__ __forceinline__ void tr_item(const float* srcA, const float* srcB, int ld, bf16* dst, int K, int drow0, int k0, LAS float* scr, int lane) {
    const int nl = lane & 31; const float* s = nl < 16 ? srcA + nl : srcB + (nl - 16);
#pragma unroll 8
    for (int i = 0; i < 32; ++i) { const int kk = 2 * i + (lane >> 5); scr[kk * 33 + nl] = s[(size_t)(k0 + kk) * ld]; }
    LDS_WAIT(); asm volatile("" ::: "memory");
    const int c = lane & 7;
#pragma unroll
    for (int j = 0; j < 4; ++j) { const int n = (lane >> 3) + 8 * j; const LAS float* p = scr + (8 * c) * 33 + n;
        u32x4 o; o.x = pk2(p[0 * 33], p[1 * 33]); o.y = pk2(p[2 * 33], p[3 * 33]); o.z = pk2(p[4 * 33], p[5 * 33]); o.w = pk2(p[6 * 33], p[7 * 33]);
        *(u32x4*)(dst + (size_t)(drow0 + n) * K + k0 + 8 * c) = o; }
    LDS_WAIT(); asm volatile("" ::: "memory");
}
__device__ __forceinline__ void convert_layer(KArgs a, LAS unsigned char* lds, int l) {
    const int lane = TID() & 63, wave = TID() >> 6;
    LAS float* scr = (LAS float*)(lds + wave * 8704);
    const int gw = BID() * 8 + wave, NGW = GRD() * 8;
    bf16* WIN = (bf16*)(a->ws + WS_WIN); bf16* WBRA = (bf16*)(a->ws + WS_WBRA); bf16* WBRB = (bf16*)(a->ws + WS_WBRB); bf16* WOUT = (bf16*)(a->ws + WS_WOUT);
    bf16* W13 = (bf16*)(a->ws + WS_W13); bf16* W2 = (bf16*)(a->ws + WS_W2);
    const float* w_in = a->in[8] + (size_t)l * D * DIN;
    const float* wbra = a->in[13] + (size_t)l * D * D; const float* wbrb = a->in[14] + (size_t)l * D * D; const float* wout = a->in[15] + (size_t)l * D * D;
    const int j = l >> 1; const bool moe = l & 1;
    constexpr int I_IN = 16 * 256, I_SQ = 16 * 32;
    constexpr int I_D13 = 16 * (2 * FF / 32), I_D2 = (FF / 64) * 32;
    constexpr int I_E13 = 16 * (2 * FFE / 32), I_E2 = (FFE / 64) * 32;
    const int n_ffn = moe ? NE * (I_E13 + I_E2) : (I_D13 + I_D2);
    const int total = I_IN + 3 * I_SQ + n_ffn;
    for (int it = gw; it < total; it += NGW) {
        int r = it;
        if (r < I_IN) { const int kb = r >> 8, nb = r & 255, n0 = nb * 32, sc = n0 < 3072 ? n0 : n0 + 16; tr_item(w_in + sc, w_in + sc + 16, DIN, WIN, D, n0, kb * 64, scr, lane); continue; } r -= I_IN;
        if (r < I_SQ) { const int kb = r >> 5, nb = r & 31; tr_item(wbra + nb * 32, wbra + nb * 32 + 16, D, WBRA, D, nb * 32, kb * 64, scr, lane); continue; } r -= I_SQ;
        if (r < I_SQ) { const int kb = r >> 5, nb = r & 31; tr_item(wbrb + nb * 32, wbrb + nb * 32 + 16, D, WBRB, D, nb * 32, kb * 64, scr, lane); continue; } r -= I_SQ;
        if (r < I_SQ) { const int kb = r >> 5, nb = r & 31; tr_item(wout + nb * 32, wout + nb * 32 + 16, D, WOUT, D, nb * 32, kb * 64, scr, lane); continue; } r -= I_SQ;
        if (!moe) {
            const float* w1 = a->in[16] + (size_t)j * D * FF; const float* w3 = a->in[17] + (size_t)j * D * FF; const float* w2 = a->in[18] + (size_t)j * FF * D;
            if (r < I_D13) { constexpr int NBK = 2 * FF / 32; const int kb = r / NBK, nb = r % NBK; tr_item(w1 + nb * 16, w3 + nb * 16, FF, W13, D, nb * 32, kb * 64, scr, lane); continue; } r -= I_D13;
            { const int kb = r >> 5, nb = r & 31; tr_item(w2 + nb * 32, w2 + nb * 32 + 16, D, W2, FF, nb * 32, kb * 64, scr, lane); }
        } else {
            const int e = r / (I_E13 + I_E2); r -= e * (I_E13 + I_E2);
            const float* w1 = a->in[20] + ((size_t)j * NE + e) * D * FFE; const float* w3 = a->in[21] + ((size_t)j * NE + e) * D * FFE; const float* w2 = a->in[22] + ((size_t)j * NE + e) * FFE * D;
            if (r < I_E13) { constexpr int NBK = 2 * FFE / 32; const int kb = r / NBK, nb = r % NBK; tr_item(w1 + nb * 16, w3 + nb * 16, FFE, W13 + (size_t)e * 2 * FFE * D, D, nb * 32, kb * 64, scr, lane); continue; } r -= I_E13;
            { const int kb = r >> 5, nb = r & 31; tr_item(w2 + nb * 32, w2 + nb * 32 + 16, D, W2 + (size_t)e * D * FFE, FFE, nb * 32, kb * 64, scr, lane); }
        }
    }
}

struct MoeCum { int cum[NE]; };
__device__ __forceinline__ void load_tile_prefix(const unsigned* cnt, int (&cum)[NE + 1]) {
    int acc = 0;
#pragma unroll
    for (int e = 0; e < NE; ++e) { cum[e] = acc; const int c = (int)__hip_atomic_load(cnt + e, __ATOMIC_RELAXED, __HIP_MEMORY_SCOPE_AGENT); acc += (c + 255) >> 8; }
    cum[NE] = acc;
}
__device__ __forceinline__ void moe_combine_row(KArgs a, int lm  , int row, int lane, f32x4 (&v)[4]) {
    const unsigned* cnt = (const unsigned*)(a->ws + WS_CTL) + CW_CNT + (lm >> 1) * 64;
    const int* RTI = (const int*)(a->ws + WS_RTI); const float* RTW = (const float*)(a->ws + WS_RTW); const float* YS = (const float*)(a->ws + WS_YS);
    const float* MOD = (const float*)(a->ws + WS_MOD);
    const int e0 = RTI[row * 4 + 0], r0 = RTI[row * 4 + 1], e1 = RTI[row * 4 + 2], r1 = RTI[row * 4 + 3];
    const float w0 = RTW[row * 2 + 0], w1 = RTW[row * 2 + 1];
    int c0 = 0, c1 = 0, accp = 0;
#pragma unroll
    for (int e = 0; e < NE; ++e) { const int c = (int)__hip_atomic_load(cnt + e, __ATOMIC_RELAXED, __HIP_MEMORY_SCOPE_AGENT); c0 = (e == e0) ? accp : c0; c1 = (e == e1) ? accp : c1; accp += (c + 255) >> 8; }
    const size_t s0 = (size_t)c0 * 256 + r0, s1 = (size_t)c1 * 256 + r1;
    const int mr = row < ML ? (row >> 11) : 8;
    const float* g2 = MOD + (size_t)(lm * 9 + mr) * 6144 + 5120;
#pragma unroll
    for (int j = 0; j < 4; ++j) { const int col = 4 * lane + 256 * j;
        const f32x4 y0 = *(const f32x4*)(YS + s0 * D + col), y1 = *(const f32x4*)(YS + s1 * D + col), g = *(const f32x4*)(g2 + col);
        v[j] = v[j] + g * (y0 * w0 + y1 * w1); }
}

__device__ __forceinline__ void phase_n1(KArgs a, LAS unsigned char* lds, int l, bool dry) {
    const int tid = TID(), lane = tid & 63, wave = tid >> 6;
    LAS float* gwt = (LAS float*)lds;
    const float* w_in = a->in[8] + (size_t)l * D * DIN;
    __syncthreads();
    for (int i = tid; i < 16 * 1024; i += 512) { const int k = i >> 4, g = i & 15; gwt[g * 1024 + k] = w_in[(size_t)k * DIN + 3072 + g]; }
    __syncthreads();
    const float* MOD = (const float*)(a->ws + WS_MOD); float* XR = (float*)(a->ws + WS_XR); bf16* H = (bf16*)(a->ws + WS_H); float* GPRE = (float*)(a->ws + WS_GPRE);
    const float* g1 = a->in[6] + l * D; const float* gb = a->in[10] + l * 16;
    const bool combine = (l > 0) && ((l - 1) & 1);
    const int gw = BID() * 8 + wave, NGW = GRD() * 8;
    for (int row = gw; row < MROWS; row += NGW) {
        const float* xp = (l == 0) ? (row < ML ? a->in[0] + (size_t)row * D : a->in[2] + (size_t)(row - ML) * D) : XR + (size_t)row * D;
        f32x4 v[4]; float ss = 0.f;
#pragma unroll
        for (int j = 0; j < 4; ++j) v[j] = *(const f32x4*)(xp + 4 * lane + 256 * j);
        if (combine) { moe_combine_row(a, l - 1, row, lane, v);
            if (!dry) {
#pragma unroll
            for (int j = 0; j < 4; ++j) *(f32x4*)(XR + (size_t)row * D + 4 * lane + 256 * j) = v[j]; } }
#pragma unroll
        for (int j = 0; j < 4; ++j) ss += (v[j].x * v[j].x + v[j].y * v[j].y) + (v[j].z * v[j].z + v[j].w * v[j].w);
        const float rstd = rsqrtf(wave_sum(ss) * (1.f / D) + EPS);
        const int mr = row < ML ? (row >> 11) : 8; const float* mp = MOD + (size_t)(l * 9 + mr) * 6144;
        f32x4 h[4];
#pragma unroll
        for (int j = 0; j < 4; ++j) { const int col = 4 * lane + 256 * j; const f32x4 g = *(const f32x4*)(g1 + col), sh = *(const f32x4*)(mp + col), sc = *(const f32x4*)(mp + 1024 + col);
            h[j] = (v[j] * rstd * g) * (sc + 1.f) + sh;
            u32x2 w; w.x = pk2(h[j].x, h[j].y); w.y = pk2(h[j].z, h[j].w); *(u32x2*)(H + (size_t)row * D + col) = w; }
        float mine = 0.f;
#pragma unroll 1
        for (int g = 0; g < 16; ++g) { float s = 0.f;
#pragma unroll
            for (int j = 0; j < 4; ++j) { const f32x4 w4 = *(const LAS f32x4*)(gwt + g * 1024 + 256 * j + 4 * lane); s += (h[j].x * w4.x + h[j].y * w4.y) + (h[j].z * w4.z + h[j].w * w4.w); }
            s = wave_sum(s); mine = (lane == g) ? s : mine; }
        if (lane < 16) GPRE[(size_t)row * 16 + lane] = mine + gb[lane];
    }
}

__device__ __forceinline__ void unpack8(const u32x4 w, float (&f)[8]) { f[0] = bflo(w.x); f[1] = bfhi(w.x); f[2] = bflo(w.y); f[3] = bfhi(w.y); f[4] = bflo(w.z); f[5] = bfhi(w.z); f[6] = bflo(w.w); f[7] = bfhi(w.w); }
__device__ __forceinline__ void phase_prep(KArgs a, int l) {
    const bf16* P = (const bf16*)(a->ws + WS_P); bf16* QK = (bf16*)(a->ws + WS_QK); const float* ROPE = (const float*)(a->ws + WS_ROPE);
    const float* cw = a->in[9] + (size_t)l * 3 * 1024;
    const int gt = BID() * 512 + TID(), NT = GRD() * 512;
    for (int it = gt; it < MROWS * 64; it += NT) {
        const int row = it >> 6, slot = it & 63;
        const int hs = slot >> 3, half = (slot >> 2) & 1, oct = slot & 3;
        const bool lat = row < ML; const int t = lat ? (row & (TL - 1)) : ((row - ML) & (TC - 1)); const int T = lat ? TL : TC;
        const int c1 = hs * 128 + half * 64 + oct * 8, c2 = c1 + 32;
        float u1[8], u2[8];
        { float x1[8], x2[8]; unpack8(*(const u32x4*)(P + (size_t)row * NP + c1), x1); unpack8(*(const u32x4*)(P + (size_t)row * NP + c2), x2);
          const f32x4 wa = *(const f32x4*)(cw + 1024 + c1), wb = *(const f32x4*)(cw + 1024 + c1 + 4), wc = *(const f32x4*)(cw + 1024 + c2), wd = *(const f32x4*)(cw + 1024 + c2 + 4);
#pragma unroll
          for (int e = 0; e < 4; ++e) { u1[e] = wa[e] * x1[e]; u1[e + 4] = wb[e] * x1[e + 4]; u2[e] = wc[e] * x2[e]; u2[e + 4] = wd[e] * x2[e + 4]; } }
        if (t > 0) { float x1[8], x2[8]; unpack8(*(const u32x4*)(P + (size_t)(row - 1) * NP + c1), x1); unpack8(*(const u32x4*)(P + (size_t)(row - 1) * NP + c2), x2);
          const f32x4 wa = *(const f32x4*)(cw + c1), wb = *(const f32x4*)(cw + c1 + 4), wc = *(const f32x4*)(cw + c2), wd = *(const f32x4*)(cw + c2 + 4);
#pragma unroll
          for (int e = 0; e < 4; ++e) { u1[e] += wa[e] * x1[e]; u1[e + 4] += wb[e] * x1[e + 4]; u2[e] += wc[e] * x2[e]; u2[e + 4] += wd[e] * x2[e + 4]; } }
        if (t < T - 1) { float x1[8], x2[8]; unpack8(*(const u32x4*)(P + (size_t)(row + 1) * NP + c1), x1); unpack8(*(const u32x4*)(P + (size_t)(row + 1) * NP + c2), x2);
          const f32x4 wa = *(const f32x4*)(cw + 2048 + c1), wb = *(const f32x4*)(cw + 2048 + c1 + 4), wc = *(const f32x4*)(cw + 2048 + c2), wd = *(const f32x4*)(cw + 2048 + c2 + 4);
#pragma unroll
          for (int e = 0; e < 4; ++e) { u1[e] += wa[e] * x1[e]; u1[e + 4] += wb[e] * x1[e + 4]; u2[e] += wc[e] * x2[e]; u2[e + 4] += wd[e] * x2[e + 4]; } }
        float o1[8], o2[8];
        const float sc = (hs >= 4) ? 0.08838834764831845f : 1.f;
        const int pos = half ? (t & 63) : (t >> 6);
        const float* rp = ROPE + (size_t)(pos * 32 + oct * 8) * 2;
#pragma unroll
        for (int e2 = 0; e2 < 4; ++e2) { f32x4 cs4 = (f32x4){1.f, 0.f, 1.f, 0.f}; if (lat) cs4 = *(const f32x4*)(rp + 4 * e2);
#pragma unroll
            for (int q = 0; q < 2; ++q) { const int e = 2 * e2 + q; const float cs = cs4[2 * q], sn = cs4[2 * q + 1];
                const float a1 = u1[e] * sigmoidf_(u1[e]), a2 = u2[e] * sigmoidf_(u2[e]);
                o1[e] = (a1 * cs - a2 * sn) * sc; o2[e] = (a1 * sn + a2 * cs) * sc; } }
        u32x4 w1, w2; w1.x = pk2(o1[0], o1[1]); w1.y = pk2(o1[2], o1[3]); w1.z = pk2(o1[4], o1[5]); w1.w = pk2(o1[6], o1[7]);
        w2.x = pk2(o2[0], o2[1]); w2.y = pk2(o2[2], o2[3]); w2.z = pk2(o2[4], o2[5]); w2.w = pk2(o2[6], o2[7]);
        *(u32x4*)(QK + (size_t)row * D + c1) = w1; *(u32x4*)(QK + (size_t)row * D + c2) = w2;
    }
}

__device__ __forceinline__ float log_sigmoid_(float x) { return fminf(x, 0.f) - log1pf(__expf(-fabsf(x))); }
typedef short s16x4 __attribute__((ext_vector_type(4)));
__device__ __forceinline__ s16x4 ds_tr(LAS unsigned char* p) { return __builtin_amdgcn_ds_read_tr16_b64_v4i16((LAS s16x4*)p); }
__device__ __forceinline__ bf16x8 cat8(s16x4 a, s16x4 b) { return __builtin_shufflevector(a, b, 0, 1, 2, 3, 4, 5, 6, 7); }
__device__ __forceinline__ f32x4 mfma16(bf16x8 a, bf16x8 b, f32x4 c) { return __builtin_amdgcn_mfma_f32_16x16x32_bf16(a, b, c, 0, 0, 0); }
__device__ __forceinline__ void phase_scan_mfma(KArgs a, LAS unsigned char* lds, int l) {
    const int tid = TID(), lane = tid & 63, w = __builtin_amdgcn_readfirstlane(tid >> 6), c = lane & 15, g = lane >> 4;
    constexpr int QS = 0, KS = 17408, VS = 34816, CB = 46080, SC = 67840, RS = 272, VRS = 176;
    LAS float* uL = (LAS float*)(lds + SC); LAS float* wL = uL + 64; LAS float* wintL = uL + 128; LAS float* wkL = uL + 192; LAS float* emL = uL + 256; LAS float* misc = uL + 320;
    const bf16* P = (const bf16*)(a->ws + WS_P); const bf16* QK = (const bf16*)(a->ws + WS_QK); const float* GPRE = (const float*)(a->ws + WS_GPRE);
    bf16* HS = (bf16*)(a->ws + WS_HS);
    const int lt = w & 3, vh = w >> 2;
    for (int unit = BID(); unit < 256; unit += GRD()) {
        const int b = unit >> 5, h = (unit >> 3) & 3, dir = (unit >> 2) & 1, vs = unit & 3;
        __syncthreads();
        for (int i = tid; i < 64 * 16; i += 512) { const int li = i >> 4, cc = i & 15; *(LAS bf16*)(lds + VS + li * VRS + (64 + cc) * 2) = (bf16)(cc == 0 ? 0x3F80 : 0); }
        for (int i = tid; i < 80 * RS / 4; i += 512) ((LAS unsigned*)(lds + CB))[i] = 0u;
        f32x4 Cacc[5];
#pragma unroll
        for (int mt = 0; mt < 5; ++mt) Cacc[mt] = (f32x4){0.f, 0.f, 0.f, 0.f};
        float mcur = 0.f;
        u32x4 pq0, pq1, pk0, pk1, pv; float pig = 0.f, pfg = 0.f;
        const int li_ld = tid >> 3, ch_ld = tid & 7;
#define SC_ROW(step_, li_) (((step_) < 4 ? ML + b * TC : b * TL) + (dir ? (((step_) < 4 ? TC : TL) - 1 - (64 * ((step_) < 4 ? (step_) : (step_) - 4) + (li_))) : (64 * ((step_) < 4 ? (step_) : (step_) - 4) + (li_))))
#define SC_LOAD(step_) do { const size_t r_ = (size_t)SC_ROW(step_, li_ld); \
            const unsigned char* qp_ = (const unsigned char*)(QK + r_ * D + h * 128) + ch_ld * 16; \
            pq0 = *(const u32x4*)qp_; pq1 = *(const u32x4*)(qp_ + 128); pk0 = *(const u32x4*)(qp_ + 1024); pk1 = *(const u32x4*)(qp_ + 1024 + 128); \
            pv = *(const u32x4*)((const unsigned char*)(P + r_ * NP + PC_V + h * 256 + vs * 64) + ch_ld * 16); \
            if (w == 0) { const size_t rg_ = (size_t)SC_ROW(step_, lane); pig = GPRE[rg_ * 16 + (2 * dir) * 4 + h]; pfg = GPRE[rg_ * 16 + (2 * dir + 1) * 4 + h]; } } while (0)
        SC_LOAD(0);
        for (int step = 0; step < 36; ++step) {
            *(LAS u32x4*)(lds + QS + li_ld * RS + ch_ld * 16) = pq0; *(LAS u32x4*)(lds + QS + li_ld * RS + ch_ld * 16 + 128) = pq1;
            *(LAS u32x4*)(lds + KS + li_ld * RS + ch_ld * 16) = pk0; *(LAS u32x4*)(lds + KS + li_ld * RS + ch_ld * 16 + 128) = pk1;
            *(LAS u32x4*)(lds + VS + li_ld * VRS + ch_ld * 16) = pv;
            if (w == 0) {
                const float ig = pig, fg = log_sigmoid_(pfg);
                float bb = fg;
#pragma unroll
                for (int o = 1; o < 64; o <<= 1) { const float t2 = __shfl_up(bb, o); if (lane >= o) bb += t2; }
                float am = ig - bb;
#pragma unroll
                for (int o = 1; o < 64; o <<= 1) { const float t2 = __shfl_up(am, o); if (lane >= o) am = fmaxf(am, t2); }
                const float mrow = bb + fmaxf(mcur, am);
                const float blast = __shfl(bb, 63);
                const float gg = blast - bb + ig;
                const float mnew = fmaxf(blast + mcur, wave_max(gg));
                uL[lane] = bb - mrow; wL[lane] = ig - bb; wintL[lane] = __expf(bb + mcur - mrow); wkL[lane] = __expf(gg - mnew); emL[lane] = __expf(-mrow);
                if (lane == 0) misc[1] = __expf(blast + mcur - mnew);
                mcur = mnew;
            }
            __syncthreads();
            if (step + 1 < 36) SC_LOAD(step + 1);
            bf16x8 qf[4];
#pragma unroll
            for (int ks = 0; ks < 4; ++ks) qf[ks] = *(const LAS bf16x8*)(lds + QS + (16 * lt + c) * RS + (32 * ks + 8 * g) * 2);
            f32x4 acc[3];
#pragma unroll
            for (int nt = 0; nt < 3; ++nt) { acc[nt] = (f32x4){0.f, 0.f, 0.f, 0.f}; const int vrow0 = nt < 2 ? 16 * (2 * vh + nt) : 64;
#pragma unroll
                for (int ks = 0; ks < 4; ++ks) { const bf16x8 bfr = *(const LAS bf16x8*)(lds + CB + (vrow0 + c) * RS + (32 * ks + 8 * g) * 2); acc[nt] = mfma16(qf[ks], bfr, acc[nt]); } }
            { const f32x4 wi = *(const LAS f32x4*)(wintL + 16 * lt + 4 * g);
#pragma unroll
              for (int nt = 0; nt < 3; ++nt) acc[nt] = acc[nt] * wi; }
            const float ul = uL[16 * lt + c];
#pragma unroll
            for (int sc2 = 0; sc2 < 2; ++sc2) {
                if (2 * sc2 <= lt) {
                    unsigned pw[4];
#pragma unroll
                    for (int hh = 0; hh < 2; ++hh) { const int st = 2 * sc2 + hh; float p[4] = {0.f, 0.f, 0.f, 0.f};
                        if (st <= lt) { f32x4 sT = (f32x4){0.f, 0.f, 0.f, 0.f};
#pragma unroll
                            for (int ks = 0; ks < 4; ++ks) { const bf16x8 afr = *(const LAS bf16x8*)(lds + KS + (16 * st + c) * RS + (32 * ks + 8 * g) * 2); sT = mfma16(afr, qf[ks], sT); }
                            const f32x4 ws = *(const LAS f32x4*)(wL + 16 * st + 4 * g);
#pragma unroll
                            for (int r = 0; r < 4; ++r) p[r] = (16 * st + 4 * g + r <= 16 * lt + c) ? sT[r] * __expf(ul + ws[r]) : 0.f; }
                        pw[2 * hh] = pk2(p[0], p[1]); pw[2 * hh + 1] = pk2(p[2], p[3]); }
                    const u32x4 pwv = (u32x4){pw[0], pw[1], pw[2], pw[3]};
                    const bf16x8 pfrag = __builtin_bit_cast(bf16x8, pwv);
#pragma unroll
                    for (int nt = 0; nt < 3; ++nt) { const int ncol0 = nt < 2 ? 16 * (2 * vh + nt) : 64;
                        LAS unsigned char* vp = lds + VS + (32 * sc2 + 4 * g + (c >> 2)) * VRS + (ncol0 + 4 * (c & 3)) * 2;
                        const s16x4 t0 = ds_tr(vp), t1 = ds_tr(vp + 16 * VRS);
                        acc[nt] = mfma16(pfrag, cat8(t0, t1), acc[nt]); }
                }
            }
            { float den[4];
#pragma unroll
              for (int r = 0; r < 4; ++r) den[r] = __shfl(acc[2][r], lane & 48);
              const f32x4 em = *(const LAS f32x4*)(emL + 16 * lt + 4 * g);
#pragma unroll
              for (int r = 0; r < 4; ++r) { const float dn = 1.f / fmaxf(fabsf(den[r]), em[r]); const size_t row = (size_t)SC_ROW(step, 16 * lt + 4 * g + r);
                  bf16* op = HS + ((size_t)dir * MROWS + row) * D + h * 256 + vs * 64 + c;
                  op[16 * (2 * vh + 0)] = (bf16)f2bf(acc[0][r] * dn); op[16 * (2 * vh + 1)] = (bf16)f2bf(acc[1][r] * dn); } }
            { const float decay = misc[1];
#pragma unroll
              for (int mt = 0; mt < 5; ++mt) Cacc[mt] = Cacc[mt] * decay;
#pragma unroll
              for (int kc = 0; kc < 2; ++kc) {
                  LAS unsigned char* kp = lds + KS + (32 * kc + 8 * g + (c >> 2)) * RS + (16 * w + 4 * (c & 3)) * 2;
                  const s16x4 t0 = ds_tr(kp), t1 = ds_tr(kp + 4 * RS);
                  const f32x4 wka = *(const LAS f32x4*)(wkL + 32 * kc + 8 * g), wkb = *(const LAS f32x4*)(wkL + 32 * kc + 8 * g + 4);
                  u32x4 bwv;
                  bwv.x = pk2(bf2f((unsigned short)t0[0]) * wka[0], bf2f((unsigned short)t0[1]) * wka[1]); bwv.y = pk2(bf2f((unsigned short)t0[2]) * wka[2], bf2f((unsigned short)t0[3]) * wka[3]);
                  bwv.z = pk2(bf2f((unsigned short)t1[0]) * wkb[0], bf2f((unsigned short)t1[1]) * wkb[1]); bwv.w = pk2(bf2f((unsigned short)t1[2]) * wkb[2], bf2f((unsigned short)t1[3]) * wkb[3]);
                  const bf16x8 bw = __builtin_bit_cast(bf16x8, bwv);
#pragma unroll
                  for (int mt = 0; mt < 5; ++mt) { LAS unsigned char* vp = lds + VS + (32 * kc + 8 * g + (c >> 2)) * VRS + (16 * mt + 4 * (c & 3)) * 2;
                      const s16x4 a0 = ds_tr(vp), a1 = ds_tr(vp + 4 * VRS);
                      Cacc[mt] = mfma16(cat8(a0, a1), bw, Cacc[mt]); } } }
            __syncthreads();
#pragma unroll
            for (int mt = 0; mt < 5; ++mt)
#pragma unroll
                for (int r = 0; r < 4; ++r) *(LAS bf16*)(lds + CB + (16 * mt + 4 * g + r) * RS + (16 * w + c) * 2) = (bf16)f2bf(Cacc[mt][r]);
        }
#undef SC_LOAD
#undef SC_ROW
    }
}

__device__ __forceinline__ void phase_na_mfma(KArgs a, LAS unsigned char* lds, int l, bool last) {
    const int tid = TID(), lane = tid & 63, w = __builtin_amdgcn_readfirstlane(tid >> 6), c = lane & 15, g = lane >> 4;
    constexpr int KRS = 144, SLOT = 2 * 64 * KRS, VOFF = 64 * KRS, RPB_OFF = 2 * SLOT;
    LAS float* rpbL = (LAS float*)(lds + RPB_OFF);
    const bf16* P = (const bf16*)(a->ws + WS_P); bf16* HB = (bf16*)(a->ws + WS_HB);
    const float* rpb = a->in[12] + (size_t)l * 16 * 15 * 31;
    __syncthreads();
    for (int i = tid; i < 16 * 15 * 31; i += 512) rpbL[i] = rpb[i];
    const int nunits = last ? 1024 : 1152;
    const int key_ld = tid >> 3, ch_ld = tid & 7;
    for (int unit = BID(); unit < nunits; unit += GRD()) {
        const bool isctx = unit >= 1024;
        int b, h, qq; if (!isctx) { b = unit >> 7; h = (unit >> 3) & 15; qq = unit & 7; } else { const int u2 = unit - 1024; b = u2 >> 4; h = u2 & 15; qq = 0; }
        const int qr = 4 * qq + (w >> 1), j = w & 1;
        const int rs = min(max(qr - 4, 0), 24);
        const int kr_lo = min(max(4 * qq - 4, 0), 24), kr_hi = min(max(4 * qq - 1, 0), 24) + 7;
        const int nloc = isctx ? 0 : (kr_hi - kr_lo + 1), nsteps = nloc + 4;
        bf16x8 Qf[2][2]; int qc[2], csq[2]; size_t qrow[2];
#pragma unroll
        for (int qs = 0; qs < 2; ++qs) { qc[qs] = 32 * j + 16 * qs + c; csq[qs] = min(max(qc[qs] - 8, 0), 48);
            qrow[qs] = isctx ? (size_t)(ML + b * TC + 32 * w + 16 * qs + c) : (size_t)(b * TL + qr * 64 + qc[qs]);
#pragma unroll
            for (int ks = 0; ks < 2; ++ks) Qf[qs][ks] = *(const bf16x8*)(P + qrow[qs] * NP + PC_NQ + h * 64 + 32 * ks + 8 * g); }
        float mrun[2] = {-1.0e30f, -1.0e30f}, lsum[2] = {0.f, 0.f};
        f32x4 O[2][4];
#pragma unroll
        for (int qs = 0; qs < 2; ++qs)
#pragma unroll
            for (int dt = 0; dt < 4; ++dt) O[qs][dt] = (f32x4){0.f, 0.f, 0.f, 0.f};
        u32x4 pk, pv;
#define NA_LOAD(s_) do { const size_t kr0_ = (s_) < nloc ? (size_t)(b * TL + (kr_lo + (s_)) * 64) : (size_t)(ML + b * TC + ((s_) - nloc) * 64); \
            const unsigned char* kp_ = (const unsigned char*)(P + (kr0_ + key_ld) * NP + PC_NK + h * 64) + ch_ld * 16; \
            pk = *(const u32x4*)kp_; pv = *(const u32x4*)(kp_ + (PC_NV - PC_NK) * 2); } while (0)
        NA_LOAD(0);
        __syncthreads();
        for (int s2 = 0; s2 < nsteps; ++s2) {
            LAS unsigned char* Kb = lds + (s2 & 1) * SLOT; LAS unsigned char* Vb = Kb + VOFF;
            *(LAS u32x4*)(Kb + key_ld * KRS + ch_ld * 16) = pk; *(LAS u32x4*)(Vb + key_ld * KRS + ch_ld * 16) = pv;
            __syncthreads();
            if (s2 + 1 < nsteps) NA_LOAD(s2 + 1);
            const bool loc = s2 < nloc; const int kr = kr_lo + s2;
            const bool active = !loc || (kr >= rs && kr < rs + 8);
            if (active) {
                float sv[2][4][4];
                bool need[2][4];
#pragma unroll
                for (int qs = 0; qs < 2; ++qs) { const int q0 = 32 * j + 16 * qs; const int lo = min(max(q0 - 8, 0), 48), hi = min(max(q0 + 15 - 8, 0), 48) + 15;
#pragma unroll
                    for (int kt = 0; kt < 4; ++kt) need[qs][kt] = !loc || ((16 * kt <= hi) && (16 * kt + 15 >= lo)); }
#pragma unroll
                for (int kt = 0; kt < 4; ++kt) {
                    const bf16x8 kf0 = *(const LAS bf16x8*)(Kb + (16 * kt + c) * KRS + (8 * g) * 2), kf1 = *(const LAS bf16x8*)(Kb + (16 * kt + c) * KRS + (32 + 8 * g) * 2);
#pragma unroll
                    for (int qs = 0; qs < 2; ++qs) {
                        if (need[qs][kt]) { f32x4 t = mfma16(kf0, Qf[qs][0], (f32x4){0.f, 0.f, 0.f, 0.f}); t = mfma16(kf1, Qf[qs][1], t);
#pragma unroll
                            for (int r = 0; r < 4; ++r) { float v = t[r];
                                if (loc) { const int kc = 16 * kt + 4 * g + r; const bool ok = (kc >= csq[qs]) && (kc < csq[qs] + 16);
                                    const int dc = min(max(kc - qc[qs] + 15, 0), 30);
                                    v = ok ? v + rpbL[(h * 15 + (kr - qr + 7)) * 31 + dc] : -1.0e30f; }
                                sv[qs][kt][r] = v; } }
                        else {
#pragma unroll
                            for (int r = 0; r < 4; ++r) sv[qs][kt][r] = -1.0e30f; } } }
                bf16x8 pf[2][2];
#pragma unroll
                for (int qs = 0; qs < 2; ++qs) { float mx = -1.0e30f;
#pragma unroll
                    for (int kt = 0; kt < 4; ++kt)
#pragma unroll
                        for (int r = 0; r < 4; ++r) mx = fmaxf(mx, sv[qs][kt][r]);
                    mx = fmaxf(mx, __shfl_xor(mx, 16)); mx = fmaxf(mx, __shfl_xor(mx, 32));
                    const float mnew = fmaxf(mrun[qs], mx), corr = __expf(mrun[qs] - mnew); mrun[qs] = mnew;
                    float ps = 0.f;
#pragma unroll
                    for (int kt = 0; kt < 4; ++kt)
#pragma unroll
                        for (int r = 0; r < 4; ++r) { const float p = __expf(sv[qs][kt][r] - mnew); sv[qs][kt][r] = p; ps += p; }
                    lsum[qs] = lsum[qs] * corr + ps;
#pragma unroll
                    for (int dt = 0; dt < 4; ++dt) O[qs][dt] = O[qs][dt] * corr;
#pragma unroll
                    for (int ch = 0; ch < 2; ++ch) { u32x4 pw; pw.x = pk2(sv[qs][2 * ch][0], sv[qs][2 * ch][1]); pw.y = pk2(sv[qs][2 * ch][2], sv[qs][2 * ch][3]);
                        pw.z = pk2(sv[qs][2 * ch + 1][0], sv[qs][2 * ch + 1][1]); pw.w = pk2(sv[qs][2 * ch + 1][2], sv[qs][2 * ch + 1][3]); pf[qs][ch] = __builtin_bit_cast(bf16x8, pw); } }
#pragma unroll
                for (int ch = 0; ch < 2; ++ch)
#pragma unroll
                    for (int dt = 0; dt < 4; ++dt) { LAS unsigned char* vp = Vb + (32 * ch + 4 * g + (c >> 2)) * KRS + (16 * dt + 4 * (c & 3)) * 2;
                        const s16x4 t0 = ds_tr(vp), t1 = ds_tr(vp + 16 * KRS); const bf16x8 vf = cat8(t0, t1);
#pragma unroll
                        for (int qs = 0; qs < 2; ++qs) if (need[qs][2 * ch] || need[qs][2 * ch + 1]) O[qs][dt] = mfma16(vf, pf[qs][ch], O[qs][dt]); }
            }
        }
#pragma unroll
        for (int qs = 0; qs < 2; ++qs) { float lt = lsum[qs]; lt += __shfl_xor(lt, 16); lt += __shfl_xor(lt, 32); const float inv = 1.f / lt;
            bf16* op = HB + qrow[qs] * D + h * 64 + 4 * g;
#pragma unroll
            for (int dt = 0; dt < 4; ++dt) { u32x2 ow; ow.x = pk2(O[qs][dt][0] * inv, O[qs][dt][1] * inv); ow.y = pk2(O[qs][dt][2] * inv, O[qs][dt][3] * inv); *(u32x2*)(op + 16 * dt) = ow; } }
        __syncthreads();
#undef NA_LOAD
    }
}

__device__ __forceinline__ void phase_ln(KArgs a, int l, bool last) {
    const int lane = TID() & 63, wave = TID() >> 6;
    const bf16* HS = (const bf16*)(a->ws + WS_HS); const bf16* P = (const bf16*)(a->ws + WS_P); bf16* HA = (bf16*)(a->ws + WS_HA);
    const float* gh = a->in[11] + l * D;
    const int gw = BID() * 8 + wave, NGW = GRD() * 8; const int nrows = last ? ML : MROWS;
    for (int row = gw; row < nrows; row += NGW) {
#pragma unroll
        for (int j = 0; j < 4; ++j) { const int col = 4 * lane + 256 * j;
            const u32x2 yf = *(const u32x2*)(HS + (size_t)row * D + col), yb = *(const u32x2*)(HS + ((size_t)MROWS + row) * D + col);
            const f32x4 y = (f32x4){bflo(yf.x) + bflo(yb.x), bfhi(yf.x) + bfhi(yb.x), bflo(yf.y) + bflo(yb.y), bfhi(yf.y) + bfhi(yb.y)};
            const float mu = wave_sum((y.x + y.y) + (y.z + y.w)) * (1.f / 256.f);
            const f32x4 dlt = y - mu;
            const float var = wave_sum((dlt.x * dlt.x + dlt.y * dlt.y) + (dlt.z * dlt.z + dlt.w * dlt.w)) * (1.f / 256.f);
            const float rstd = rsqrtf(var + EPS);
            const f32x4 g = *(const f32x4*)(gh + col);
            const u32x2 ow = *(const u32x2*)(P + (size_t)row * NP + PC_O + col);
            const f32x4 so = (f32x4){bflo(ow.x), bfhi(ow.x), bflo(ow.y), bfhi(ow.y)};
            const f32x4 r = dlt * rstd * g * so;
            u32x2 w; w.x = pk2(r.x, r.y); w.y = pk2(r.z, r.w); *(u32x2*)(HA + (size_t)row * D + col) = w; }
    }
}

__device__ __forceinline__ void phase_n2(KArgs a, LAS unsigned char* lds, int l, bool last, bool dry) {
    const int tid = TID(), lane = tid & 63, wave = tid >> 6;
    const bool moe = l & 1; const int jm = l >> 1;
    LAS float* rt = (LAS float*)lds;
    __syncthreads();
    if (moe) { const float* router = a->in[19] + (size_t)jm * D * NE;
        for (int i = tid; i < NE * 1024; i += 512) { const int k = i >> 3, e = i & 7; rt[e * 1024 + k] = router[(size_t)k * NE + e]; } }
    __syncthreads();
    const float* MOD = (const float*)(a->ws + WS_MOD); const float* XR = (const float*)(a->ws + WS_XR); bf16* H = (bf16*)(a->ws + WS_H); bf16* H2S = (bf16*)(a->ws + WS_H2S);
    int* RTI = (int*)(a->ws + WS_RTI); float* RTW = (float*)(a->ws + WS_RTW);
    unsigned* cnt = (unsigned*)(a->ws + WS_CTL) + CW_CNT + jm * 64;
    const float* g2 = a->in[7] + l * D;
    const int gw = BID() * 8 + wave, NGW = GRD() * 8; const int nrows = last ? ML : MROWS;
    for (int row = gw; row < nrows; row += NGW) {
        const float* xp = XR + (size_t)row * D;
        f32x4 v[4]; float ss = 0.f;
#pragma unroll
        for (int j = 0; j < 4; ++j) { v[j] = *(const f32x4*)(xp + 4 * lane + 256 * j); ss += (v[j].x * v[j].x + v[j].y * v[j].y) + (v[j].z * v[j].z + v[j].w * v[j].w); }
        const float rstd = rsqrtf(wave_sum(ss) * (1.f / D) + EPS);
        const int mr = row < ML ? (row >> 11) : 8; const float* mp = MOD + (size_t)(l * 9 + mr) * 6144;
        f32x4 h[4]; u32x2 hw[4];
#pragma unroll
        for (int j = 0; j < 4; ++j) { const int col = 4 * lane + 256 * j; const f32x4 g = *(const f32x4*)(g2 + col), sh = *(const f32x4*)(mp + 3072 + col), sc = *(const f32x4*)(mp + 4096 + col);
            h[j] = (v[j] * rstd * g) * (sc + 1.f) + sh; hw[j].x = pk2(h[j].x, h[j].y); hw[j].y = pk2(h[j].z, h[j].w); }
        if (!moe) {
#pragma unroll
            for (int j = 0; j < 4; ++j) *(u32x2*)(H + (size_t)row * D + 4 * lane + 256 * j) = hw[j];
        } else {
            float lg[NE];
#pragma unroll
            for (int e = 0; e < NE; ++e) { float s = 0.f;
#pragma unroll
                for (int j = 0; j < 4; ++j) { const f32x4 w4 = *(const LAS f32x4*)(rt + e * 1024 + 256 * j + 4 * lane); s += (h[j].x * w4.x + h[j].y * w4.y) + (h[j].z * w4.z + h[j].w * w4.w); }
                lg[e] = wave_sum(s); }
            int i0 = 0; float v0 = lg[0];
#pragma unroll
            for (int e = 1; e < NE; ++e) if (lg[e] > v0) { v0 = lg[e]; i0 = e; }
            int i1 = -1; float v1 = -3.0e38f;
#pragma unroll
            for (int e = 0; e < NE; ++e) if (e != i0 && lg[e] > v1) { v1 = lg[e]; i1 = e; }
            const float w0 = 1.f / (1.f + __expf(v1 - v0)), w1 = 1.f - w0;
            int r0 = 0, r1 = 0;
            if (lane == 0 && !dry) { r0 = (int)__hip_atomic_fetch_add(cnt + i0, 1u, __ATOMIC_RELAXED, __HIP_MEMORY_SCOPE_AGENT); r1 = (int)__hip_atomic_fetch_add(cnt + i1, 1u, __ATOMIC_RELAXED, __HIP_MEMORY_SCOPE_AGENT); }
            r0 = __shfl(r0, 0); r1 = __shfl(r1, 0);
            if (dry) { r0 = ECAP - 1; r1 = ECAP - 1; }
            if (lane == 0 && !dry) { RTI[row * 4 + 0] = i0; RTI[row * 4 + 1] = r0; RTI[row * 4 + 2] = i1; RTI[row * 4 + 3] = r1; RTW[row * 2 + 0] = w0; RTW[row * 2 + 1] = w1; }
            bf16* d0 = H2S + ((size_t)i0 * ECAP + r0) * D; bf16* d1 = H2S + ((size_t)i1 * ECAP + r1) * D;
#pragma unroll
            for (int j = 0; j < 4; ++j) { *(u32x2*)(d0 + 4 * lane + 256 * j) = hw[j]; *(u32x2*)(d1 + 4 * lane + 256 * j) = hw[j]; }
        }
    }
}

__device__ __forceinline__ void phase_final(KArgs a) {
    const int lane = TID() & 63, wave = TID() >> 6;
    const float* XR = (const float*)(a->ws + WS_XR); const float* gf = a->in[23];
    const int gw = BID() * 8 + wave, NGW = GRD() * 8;
    float probe_alpha = 1.f;
#if PROBE_SEL >= 0
    { unsigned long long* ts = (unsigned long long*)((unsigned*)(a->ws + WS_CTL) + CW_TS);
      unsigned long long tend = 0; for (int sp = 0; sp < (1 << 22); ++sp) { tend = __hip_atomic_load(ts + 41, __ATOMIC_RELAXED, __HIP_MEMORY_SCOPE_AGENT); if (tend) break; __builtin_amdgcn_s_sleep(2); }
      const unsigned long long t0 = __hip_atomic_load(ts + 0, __ATOMIC_RELAXED, __HIP_MEMORY_SCOPE_AGENT);
      unsigned long long accp = 0;
      for (int k = 0; k < 41; ++k) { const int lp = (k - 1) / 10, kk = (k - 1) % 10; bool sel = false;
          if (PROBE_SEL == 0) sel = (k == 0);
          else if (PROBE_SEL <= 8) sel = (k >= 1) && (kk == PROBE_SEL - 1);
          else if (PROBE_SEL == 9) sel = (k >= 1) && (kk == 8) && !(lp & 1);
          else if (PROBE_SEL == 10) sel = (k >= 1) && (kk == 9) && !(lp & 1);
          else if (PROBE_SEL == 11) sel = (k >= 1) && (kk == 8) && (lp & 1);
          else if (PROBE_SEL == 12) sel = (k >= 1) && (kk == 9) && (lp & 1);
          if (sel) accp += __hip_atomic_load(ts + k + 1, __ATOMIC_RELAXED, __HIP_MEMORY_SCOPE_AGENT) - __hip_atomic_load(ts + k, __ATOMIC_RELAXED, __HIP_MEMORY_SCOPE_AGENT); }
      if (PROBE_SEL == 13) for (int lq = 0; lq < 4; ++lq) accp += __hip_atomic_load(ts + 64 + lq, __ATOMIC_RELAXED, __HIP_MEMORY_SCOPE_AGENT) - __hip_atomic_load(ts + 1 + lq * 10 + 3, __ATOMIC_RELAXED, __HIP_MEMORY_SCOPE_AGENT);
      const float f = (float)((double)accp / (double)(tend - t0));
      probe_alpha = 1.f - sqrtf(f); }
#endif
    for (int row = gw; row < ML; row += NGW) {
        f32x4 v[4]; float ss = 0.f;
#pragma unroll
        for (int j = 0; j < 4; ++j) v[j] = *(const f32x4*)(XR + (size_t)row * D + 4 * lane + 256 * j);
        moe_combine_row(a, DEPTH - 1, row, lane, v);
#pragma unroll
        for (int j = 0; j < 4; ++j) ss += (v[j].x * v[j].x + v[j].y * v[j].y) + (v[j].z * v[j].z + v[j].w * v[j].w);
        const float rstd = rsqrtf(wave_sum(ss) * (1.f / D) + EPS);
#pragma unroll
        for (int j = 0; j < 4; ++j) { const int col = 4 * lane + 256 * j; *(f32x4*)(a->out + (size_t)row * D + col) = v[j] * (rstd * probe_alpha) * *(const f32x4*)(gf + col); }
    }
}

constexpr int PH_PER_LAYER = 10, N_PHASES = 2 + DEPTH * PH_PER_LAYER;
__global__ void __launch_bounds__(512, 2) fwd(Args args) {
    extern __shared__ __attribute__((aligned(16))) unsigned char lds_raw[];
    LAS unsigned char* lds = (LAS unsigned char*)lds_raw;
    const int tid = TID();
    volatile LAS unsigned* MISC = (volatile LAS unsigned*)(lds + MISC_OFF);
    for (int u = tid; u < (LDS_BYTES - MISC_OFF) / 4; u += 512) ((LAS unsigned*)(lds + MISC_OFF))[u] = 0u;
    __syncthreads();
    unsigned* ctl = (unsigned*)(KA()->ws + WS_CTL);
    const int lo = KA()->ph_lo, hi = KA()->ph_hi;
    XcdBarrier bar; bar.bar = ctl + CW_BAR; bar.x = 0; bar.st = nullptr;
    if (hi - lo > 1) bar = xcd_barrier_post(ctl + CW_BAR, MISC + 8);
#ifndef PH_MASK
#define PH_MASK 0xFFFFFFFFu
#endif
#define PM(b) ((PH_MASK >> (b)) & 1u)
#define IN(k) (lo <= (k) && (k) < hi)
#if PROBE_SEL >= 0
#define STAMP(i) do { if (blockIdx.x == 0 && threadIdx.x == 0) __hip_atomic_store((unsigned long long*)(ctl + CW_TS) + (i), (unsigned long long)wall_clock64(), __ATOMIC_RELAXED, __HIP_MEMORY_SCOPE_AGENT); } while (0)
#define SEAM(k) do { if (IN(k) && IN((k) + 1)) xcd_barrier(bar); STAMP((k) + 1); } while (0)
#else
#define STAMP(i) do { } while (0)
#define SEAM(k) do { if (IN(k) && IN((k) + 1)) { xcd_barrier(bar); if (REP(17)) xcd_barrier(bar); } } while (0)
#endif
    STAMP(0);

    if (PM(0) && IN(0)) { if (REP(15)) phase_pre(KA(), lds); phase_pre(KA(), lds); } SEAM(0);

    for (int l = 0; l < DEPTH; ++l) {
        const int pb = 1 + l * PH_PER_LAYER; const bool last = (l == DEPTH - 1); const bool moe = l & 1;
        const int Mrows = last ? ML : MROWS;
        const float* MODl = (const float*)(KA()->ws + WS_MOD) + (size_t)l * 9 * 6144;
        if (IN(pb + 0)) { if (REP(1)) { convert_layer(KA(), lds, l); phase_n1(KA(), lds, l, true); } if (PM(1)) convert_layer(KA(), lds, l); if (PM(2)) phase_n1(KA(), lds, l, false); } SEAM(pb + 0);
        if (PM(3) && IN(pb + 1)) { for (int rep = REP(2) ? 0 : 1; rep < 2; ++rep) { pg8::Gemm g{(const bf16*)(KA()->ws + WS_H), (const bf16*)(KA()->ws + WS_WIN), D}; pg8::StaticOrder S; S.init(MROWS, NP, GRD(), BID());
            pg8::EpiG1 E{(bf16*)(KA()->ws + WS_P)}; pg8::gemm_phase<pg8::EpiG1, pg8::StaticOrder, true, true>(lds, g, S, E); } } SEAM(pb + 1);
        if (PM(4) && IN(pb + 2)) { for (int rep = REP(3) ? 0 : 1; rep < 2; ++rep) phase_prep(KA(), l); } SEAM(pb + 2);
        if (IN(pb + 3)) { for (int rep = (REP(4) || REP(13)) ? 0 : 1; rep < 2; ++rep) phase_scan_mfma(KA(), lds, l); for (int rep = (REP(4) || REP(14)) ? 0 : 1; rep < 2; ++rep) phase_na_mfma(KA(), lds, l, last); } SEAM(pb + 3);
        if (PM(7) && IN(pb + 4)) { for (int rep = REP(5) ? 0 : 1; rep < 2; ++rep) phase_ln(KA(), l, last); } SEAM(pb + 4);
        if (PM(8) && IN(pb + 5)) { for (int rep = REP(6) ? 0 : 1; rep < 2; ++rep) {
            { pg8::Gemm g{(const bf16*)(KA()->ws + WS_HA), (const bf16*)(KA()->ws + WS_WBRA), D}; pg8::StaticOrder S; S.init(Mrows, D, GRD(), BID());
              pg8::EpiMGa E{(const bf16*)(KA()->ws + WS_P), (float*)(KA()->ws + WS_T32)}; pg8::gemm_phase<pg8::EpiMGa, pg8::StaticOrder, false, true>(lds, g, S, E); }
            { pg8::Gemm g{(const bf16*)(KA()->ws + WS_HB), (const bf16*)(KA()->ws + WS_WBRB), D}; pg8::StaticOrder S; S.init(Mrows, D, GRD(), BID());
              pg8::EpiMGb E{(const bf16*)(KA()->ws + WS_P), (const float*)(KA()->ws + WS_T32), (bf16*)(KA()->ws + WS_U)}; pg8::gemm_phase<pg8::EpiMGb, pg8::StaticOrder, false, true>(lds, g, S, E); }
        } } SEAM(pb + 5);
        if (PM(9) && IN(pb + 6)) { for (int rep = REP(7) ? 0 : 1; rep < 2; ++rep) { pg8::Gemm g{(const bf16*)(KA()->ws + WS_U), (const bf16*)(KA()->ws + WS_WOUT), D}; pg8::StaticOrder S; S.init(Mrows, D, GRD(), BID());
            const float* xl = (l == 0) ? KA()->in[0] : (const float*)(KA()->ws + WS_XR); const float* xc = (l == 0) ? KA()->in[2] : (const float*)(KA()->ws + WS_XR) + (size_t)ML * D;
            pg8::EpiRes E{xl, xc, (float*)(KA()->ws + (rep ? WS_XR : WS_T32)), MODl + 2048}; pg8::gemm_phase<pg8::EpiRes, pg8::StaticOrder, false, true>(lds, g, S, E); } } SEAM(pb + 6);
        if (PM(10) && IN(pb + 7)) { if (REP(8)) phase_n2(KA(), lds, l, last, true); phase_n2(KA(), lds, l, last, false); } SEAM(pb + 7);
        if (!moe) {
            if (PM(11) && IN(pb + 8)) { for (int rep = REP(9) ? 0 : 1; rep < 2; ++rep) { pg8::Gemm g{(const bf16*)(KA()->ws + WS_H), (const bf16*)(KA()->ws + WS_W13), D}; pg8::StaticOrder S; S.init(Mrows, 2 * FF, GRD(), BID());
                pg8::EpiSwiglu E{(bf16*)(KA()->ws + WS_ACT), FF}; pg8::gemm_phase<pg8::EpiSwiglu, pg8::StaticOrder, true, true>(lds, g, S, E); } } SEAM(pb + 8);
            if (PM(12) && IN(pb + 9)) { for (int rep = REP(10) ? 0 : 1; rep < 2; ++rep) { pg8::Gemm g{(const bf16*)(KA()->ws + WS_ACT), (const bf16*)(KA()->ws + WS_W2), FF}; pg8::StaticOrder S; S.init(Mrows, D, GRD(), BID());
                const float* xr = (const float*)(KA()->ws + WS_XR);
                pg8::EpiRes E{xr, xr + (size_t)ML * D, (float*)(KA()->ws + (rep ? WS_XR : WS_T32)), MODl + 5120}; pg8::gemm_phase<pg8::EpiRes, pg8::StaticOrder, false, true>(lds, g, S, E); } } SEAM(pb + 9);
        } else {
            if (PM(13) && (IN(pb + 8) || IN(pb + 9))) {
                int cum[NE + 1]; load_tile_prefix((unsigned*)(KA()->ws + WS_CTL) + CW_CNT + (l >> 1) * 64, cum);
                pg8::MoeOrder S; S.G = GRD(); S.c = BID(); S.TT = __builtin_amdgcn_readfirstlane(cum[8]);
                S.c1 = __builtin_amdgcn_readfirstlane(cum[1]); S.c2 = __builtin_amdgcn_readfirstlane(cum[2]); S.c3 = __builtin_amdgcn_readfirstlane(cum[3]); S.c4 = __builtin_amdgcn_readfirstlane(cum[4]);
                S.c5 = __builtin_amdgcn_readfirstlane(cum[5]); S.c6 = __builtin_amdgcn_readfirstlane(cum[6]); S.c7 = __builtin_amdgcn_readfirstlane(cum[7]);
                if (IN(pb + 8)) for (int rep = REP(11) ? 0 : 1; rep < 2; ++rep) { S.nN = 2 * FFE / 256; S.a_estride = ECAP; S.b_estride = 2 * FFE;
                    pg8::Gemm g{(const bf16*)(KA()->ws + WS_H2S), (const bf16*)(KA()->ws + WS_W13), D};
                    pg8::EpiSwiglu E{(bf16*)(KA()->ws + WS_ACT), FFE}; pg8::gemm_phase<pg8::EpiSwiglu, pg8::MoeOrder, true, true>(lds, g, S, E); }
                SEAM(pb + 8);
                if (IN(pb + 9)) for (int rep = REP(12) ? 0 : 1; rep < 2; ++rep) { S.nN = D / 256; S.a_estride = 0; S.b_estride = D;
                    pg8::Gemm g{(const bf16*)(KA()->ws + WS_ACT), (const bf16*)(KA()->ws + WS_W2), FFE};
                    pg8::EpiF32 E{(float*)(KA()->ws + WS_YS)}; pg8::gemm_phase<pg8::EpiF32, pg8::MoeOrder, false, true>(lds, g, S, E); }
            }
            SEAM(pb + 9);
        }
    }
    if (PM(14) && IN(N_PHASES - 1)) { if (REP(16)) phase_final(KA()); phase_final(KA()); }
#undef IN
#undef SEAM
}

extern "C" void kernel_launch(void* const* d_in, const int* in_sizes, int n_in, void* d_out, int out_size, void* d_ws, size_t ws_size, hipStream_t stream) {
    static int grid = 0;
    if (grid == 0) {
        if (n_in != 24 || out_size != ML * D || ws_size < WS_END) { fprintf(stderr, "kernel_launch: unexpected shapes / workspace (%d inputs, out %d, ws %zu < %zu)\n", n_in, out_size, ws_size, (size_t)WS_END); grid = -1; return; }
        int dev = 0, cus = 0;
        if (hipGetDevice(&dev) != hipSuccess || hipDeviceGetAttribute(&cus, hipDeviceAttributeMultiprocessorCount, dev) != hipSuccess) { grid = -1; return; }
        if (hipFuncSetAttribute((const void*)fwd, hipFuncAttributeMaxDynamicSharedMemorySize, LDS_BYTES) != hipSuccess) { fprintf(stderr, "kernel_launch: hipFuncSetAttribute failed\n"); grid = -1; return; }
        int per_cu = 0; (void)hipOccupancyMaxActiveBlocksPerMultiprocessor(&per_cu, (const void*)fwd, 512, LDS_BYTES); (void)hipGetLastError();
        if (per_cu < 1) fprintf(stderr, "kernel_launch: occupancy query reports %d\n", per_cu);
        grid = cus;
    }
    if (grid < 0) return;
    (void)hipMemsetAsync((char*)d_ws + WS_CTL, 0, CTL_ZERO_BYTES, stream);
    Args a{};
    for (int i = 0; i < 24; ++i) a.in[i] = (const float*)d_in[i];
    a.out = (float*)d_out; a.ws = (unsigned char*)d_ws;
#if MK_PER_PHASE
    for (int p = 0; p < N_PHASES; ++p) { a.ph_lo = p; a.ph_hi = p + 1; hipLaunchKernelGGL(fwd, dim3(grid), dim3(512), LDS_BYTES, stream, a); }
#else
    a.ph_lo = 0; a.ph_hi = N_PHASES; hipLaunchKernelGGL(fwd, dim3(grid), dim3(512), LDS_BYTES, stream, a);
#endif
}
```
